# Optimizing an MI355X kernel written in HIP

```python
import math
import jax
import jax.numpy as jnp
from jax import lax
import numpy as np

D_MODEL = 1024
BATCH = 16
SEQ = 4096
DEPTH = 2

GRID_W = 64
CTX_LEN = 256
HEAD_DIM = 64
ROPE_BASE = 10000.0
RMS_EPS = 1e-6
QBLOCK = 128
NEG_INF = -1e30
N_MOD = 6

NA_HEADS = 8
NA_KR = 8
NA_KC = 16
SWA_HEADS = 8
SWA_KV_HEADS = 2
SWA_GROUP = SWA_HEADS // SWA_KV_HEADS
SWA_WINDOW = 128
MLA_HEADS = 8
MLA_Q_RANK = 256
MLA_KV_RANK = 128
MLA_NOPE = 64
MLA_ROPE = 32
MLA_V = 64
DIFF_HEADS = 4
DIFF_QK = 64
DIFF_V = 2 * DIFF_QK
PEER_HEADS = 8
PEER_NKEYS = 128
PEER_EXPERTS = PEER_NKEYS * PEER_NKEYS
PEER_DQ = 256
PEER_TOPK = 16
PEER_TBLOCK = 128

AB_SPLITS = (NA_HEADS * HEAD_DIM,) * 3 + (SWA_HEADS * HEAD_DIM, SWA_KV_HEADS * HEAD_DIM, SWA_KV_HEADS * HEAD_DIM)
AB_IN = sum(AB_SPLITS)
CD_SPLITS = (MLA_Q_RANK, MLA_KV_RANK, MLA_ROPE, DIFF_HEADS * 2 * DIFF_QK, DIFF_HEADS * 2 * DIFF_QK, DIFF_HEADS * DIFF_V)
CD_IN = sum(CD_SPLITS)
MIX_WIDTH = NA_HEADS * HEAD_DIM + SWA_HEADS * HEAD_DIM

kernel_name = 'hybrid_prefix_na_swa_mla_diff_peer'


def rmsnorm(x, g):
    xf = x.astype(jnp.float32)
    y = xf * lax.rsqrt(jnp.mean(jnp.square(xf), axis=-1, keepdims=True) + RMS_EPS)
    return (y * g.astype(jnp.float32)).astype(x.dtype)


def split_cols(z, sizes):
    out, o = [], 0
    for s in sizes:
        out.append(z[..., o:o + s])
        o += s
    return out


def split_heads(t, n):
    return t.reshape(t.shape[:-1] + (n, t.shape[-1] // n))


def rope1d(x, pos):
    half = x.shape[-1] // 2
    freq = ROPE_BASE ** (-jnp.arange(half, dtype=jnp.float32) / half)
    ang = pos.astype(jnp.float32)[:, None] * freq[None, :]
    bshape = (pos.shape[0],) + (1,) * (x.ndim - 3) + (half,)
    cos = jnp.cos(ang).reshape(bshape).astype(x.dtype)
    sin = jnp.sin(ang).reshape(bshape).astype(x.dtype)
    x1, x2 = x[..., :half], x[..., half:]
    return jnp.concatenate([x1 * cos - x2 * sin, x1 * sin + x2 * cos], axis=-1)


def axial_rope(x, row, col):
    h = x.shape[-1] // 2
    return jnp.concatenate([rope1d(x[..., :h], row), rope1d(x[..., h:], col)], axis=-1)


def map_blocks(fn, q):
    B, T = q.shape[:2]
    nb = T // QBLOCK
    qb = jnp.moveaxis(q.reshape((B, nb, QBLOCK) + q.shape[2:]), 1, 0)
    out = lax.map(lambda a: fn(a[0], a[1]), (jnp.arange(nb, dtype=jnp.int32), qb))
    out = jnp.moveaxis(out, 0, 1)
    return out.reshape((B, T) + out.shape[3:])


def global_attention(q, k, v, scale, sink=None):
    if sink is not None:
        sink_l = sink.astype(jnp.float32).reshape(1, k.shape[2], q.shape[3], 1, 1)

    def blk(i, qb):
        s = jnp.einsum('bqkgd,bskd->bkgqs', qb, k).astype(jnp.float32) * scale
        if sink is not None:
            s = jnp.concatenate([s, jnp.broadcast_to(sink_l, s.shape[:-1] + (1,))], axis=-1)
        p = jax.nn.softmax(s, axis=-1)
        if sink is not None:
            p = p[..., :-1]
        return jnp.einsum('bkgqs,bskd->bqkgd', p.astype(v.dtype), v)

    return map_blocks(blk, q)


def neighbourhood_attention(q, k, v, kc, vc, rpb):
    B, S, H, d = q.shape
    rows = S // GRID_W
    kr = min(NA_KR, rows)
    qg = q.reshape(B, rows, GRID_W, H, d)
    kg = k.reshape(B, rows, GRID_W, H, d)
    vg = v.reshape(B, rows, GRID_W, H, d)
    cols = jnp.arange(GRID_W, dtype=jnp.int32)
    col_start = jnp.clip(cols - NA_KC // 2, 0, GRID_W - NA_KC)
    col_valid = (cols[None, :] >= col_start[:, None]) & (cols[None, :] < col_start[:, None] + NA_KC)
    col_idx = jnp.clip(cols[None, :] - cols[:, None] + NA_KC - 1, 0, 2 * NA_KC - 2)
    rpb_cols = rpb[:, :, col_idx]
    scale = d ** -0.5
    nlat = kr * GRID_W

    def row_fn(r):
        r0 = jnp.clip(r - kr // 2, 0, rows - kr)
        qr = lax.dynamic_index_in_dim(qg, r, axis=1, keepdims=False)
        kw = lax.dynamic_slice_in_dim(kg, r0, kr, axis=1)
        vw = lax.dynamic_slice_in_dim(vg, r0, kr, axis=1)
        bias = jnp.take(rpb_cols, r0 + jnp.arange(kr, dtype=jnp.int32) - r + NA_KR - 1, axis=1)
        bias = jnp.transpose(bias, (0, 2, 1, 3)).astype(jnp.float32)
        s_lat = jnp.einsum('bqhd,brkhd->bhqrk', qr, kw).astype(jnp.float32) * scale + bias
        s_lat = jnp.where(col_valid[:, None, :], s_lat, NEG_INF).reshape(B, H, GRID_W, nlat)
        s_ctx = jnp.einsum('bqhd,bchd->bhqc', qr, kc).astype(jnp.float32) * scale
        p = jax.nn.softmax(jnp.concatenate([s_lat, s_ctx], axis=-1), axis=-1).astype(v.dtype)
        p_lat = p[..., :nlat].reshape(B, H, GRID_W, kr, GRID_W)
        return (jnp.einsum('bhqrk,brkhd->bqhd', p_lat, vw)
                + jnp.einsum('bhqc,bchd->bqhd', p[..., nlat:], vc))

    out = lax.map(row_fn, jnp.arange(rows, dtype=jnp.int32))
    return jnp.moveaxis(out, 0, 1).reshape(B, S, H, d)


def window_attention(q, k, v, kc, vc, sink):
    S = q.shape[1]
    kb = QBLOCK + 2 * SWA_WINDOW
    pad = ((0, 0), (SWA_WINDOW, SWA_WINDOW), (0, 0), (0, 0))
    kp = jnp.pad(k, pad)
    vp = jnp.pad(v, pad)
    scale = q.shape[-1] ** -0.5
    nc = kc.shape[1]
    sink_l = sink.astype(jnp.float32).reshape(1, SWA_KV_HEADS, SWA_GROUP, 1, 1)

    def blk(i, qb):
        start = i * QBLOCK
        kw = lax.dynamic_slice_in_dim(kp, start, kb, axis=1)
        vw = lax.dynamic_slice_in_dim(vp, start, kb, axis=1)
        qpos = start + jnp.arange(QBLOCK, dtype=jnp.int32)
        kpos = start - SWA_WINDOW + jnp.arange(kb, dtype=jnp.int32)
        valid = ((kpos[None, :] >= 0) & (kpos[None, :] < S)
                 & (jnp.abs(kpos[None, :] - qpos[:, None]) <= SWA_WINDOW))
        s_lat = jnp.einsum('bqkgd,bskd->bkgqs', qb, kw).astype(jnp.float32) * scale
        s_lat = jnp.where(valid, s_lat, NEG_INF)
        s_ctx = jnp.einsum('bqkgd,bckd->bkgqc', qb, kc).astype(jnp.float32) * scale
        s_sink = jnp.broadcast_to(sink_l, s_ctx.shape[:-1] + (1,))
        p = jax.nn.softmax(jnp.concatenate([s_lat, s_ctx, s_sink], axis=-1), axis=-1).astype(v.dtype)
        return (jnp.einsum('bkgqs,bskd->bqkgd', p[..., :kb], vw)
                + jnp.einsum('bkgqc,bckd->bqkgd', p[..., kb:kb + nc], vc))

    return map_blocks(blk, q)


def mixer_ab(h, hc, w_in, rpb, sink, w_out, pos, need_ctx):
    B, S, _ = h.shape

    def project(z, rope_pos):
        T = z.shape[1]
        aq, ak, av, bq, bk, bv = split_cols(z, AB_SPLITS)
        aq, ak, av = split_heads(aq, NA_HEADS), split_heads(ak, NA_HEADS), split_heads(av, NA_HEADS)
        bq, bk, bv = split_heads(bq, SWA_HEADS), split_heads(bk, SWA_KV_HEADS), split_heads(bv, SWA_KV_HEADS)
        if rope_pos is not None:
            bq = axial_rope(bq, *rope_pos)
            bk = axial_rope(bk, *rope_pos)
        bq = bq.reshape(B, T, SWA_KV_HEADS, SWA_GROUP, HEAD_DIM)
        return aq, ak, av, bq, bk, bv

    aq, ak, av, bq, bk, bv = project(h @ w_in, pos)
    caq, cak, cav, cbq, cbk, cbv = project(hc @ w_in, None)
    ya = neighbourhood_attention(aq, ak, av, cak, cav, rpb)
    yb = window_attention(bq, bk, bv, cbk, cbv, sink)
    y = jnp.concatenate([ya.reshape(B, S, -1), yb.reshape(B, S, -1)], axis=-1) @ w_out
    yc = None
    if need_ctx:
        C = hc.shape[1]
        yca = global_attention(caq[:, :, :, None], cak, cav, HEAD_DIM ** -0.5)
        ycb = global_attention(cbq, cbk, cbv, HEAD_DIM ** -0.5, sink)
        yc = jnp.concatenate([yca.reshape(B, C, -1), ycb.reshape(B, C, -1)], axis=-1) @ w_out
    return y, yc


def mixer_cd(h, hc, w_in, q_norm_g, w_uq, kv_norm_g, w_ukv, lam_vecs, subln_g, w_out, pos, lam_init, need_ctx):
    B = h.shape[0]
    lv = lam_vecs.astype(jnp.float32)
    lam = jnp.exp(jnp.sum(lv[0] * lv[1])) - jnp.exp(jnp.sum(lv[2] * lv[3])) + lam_init

    def project(z, rope_pos):
        cq, ckv, kr, dq, dk, dv = split_cols(z, CD_SPLITS)
        q = split_heads(rmsnorm(cq, q_norm_g) @ w_uq, MLA_HEADS)
        kv = split_heads(rmsnorm(ckv, kv_norm_g) @ w_ukv, MLA_HEADS)
        q_nope, q_rope = q[..., :MLA_NOPE], q[..., MLA_NOPE:]
        k_nope, v = kv[..., :MLA_NOPE], kv[..., MLA_NOPE:]
        k_rope = kr[:, :, None, :]
        dq = dq.reshape(dq.shape[:2] + (DIFF_HEADS, 2, DIFF_QK))
        dk = dk.reshape(dk.shape[:2] + (DIFF_HEADS, 2, DIFF_QK))
        dv = split_heads(dv, DIFF_HEADS)
        if rope_pos is not None:
            q_rope = axial_rope(q_rope, *rope_pos)
            k_rope = axial_rope(k_rope, *rope_pos)
            dq = axial_rope(dq, *rope_pos)
            dk = axial_rope(dk, *rope_pos)
        q_mla = jnp.concatenate([q_nope, q_rope], axis=-1)
        k_mla = jnp.concatenate([k_nope, jnp.broadcast_to(k_rope, k_nope.shape[:-1] + (MLA_ROPE,))], axis=-1)
        return q_mla, k_mla, v, dq, dk, dv

    def attend(q_mla, dq, k_mla, v_mla, dk, dv):
        T = q_mla.shape[1]
        y_c = global_attention(q_mla[:, :, :, None], k_mla, v_mla, (MLA_NOPE + MLA_ROPE) ** -0.5)[:, :, :, 0]
        o1 = global_attention(dq[:, :, :, 0:1], dk[:, :, :, 0], dv, DIFF_QK ** -0.5)[:, :, :, 0]
        o2 = global_attention(dq[:, :, :, 1:2], dk[:, :, :, 1], dv, DIFF_QK ** -0.5)[:, :, :, 0]
        o = rmsnorm(o1 - lam.astype(o1.dtype) * o2, subln_g) * (1.0 - lam_init)
        return jnp.concatenate([y_c.reshape(B, T, -1), o.reshape(B, T, -1)], axis=-1) @ w_out

    q_l, k_l, v_l, dq_l, dk_l, dv_l = project(h @ w_in, pos)
    q_c, k_c, v_c, dq_c, dk_c, dv_c = project(hc @ w_in, None)
    y = attend(q_l, dq_l,
               jnp.concatenate([k_l, k_c], axis=1), jnp.concatenate([v_l, v_c], axis=1),
               jnp.concatenate([dk_l, dk_c], axis=1), jnp.concatenate([dv_l, dv_c], axis=1))
    yc = attend(q_c, dq_c, k_c, v_c, dk_c, dv_c) if need_ctx else None
    return y, yc


def peer_ffn(hx, wq, sub_keys, u, v):
    n, d = hx.shape
    hb = hx.reshape(n // PEER_TBLOCK, PEER_TBLOCK, d)

    def blk(xb):
        q = (xb @ wq).reshape(PEER_TBLOCK, PEER_HEADS, 2, PEER_DQ // 2)
        s = jnp.einsum('thpd,pnd->thpn', q, sub_keys).astype(jnp.float32)
        sv, si = lax.top_k(s, PEER_TOPK)
        cand = (sv[:, :, 0, :, None] + sv[:, :, 1, None, :]).reshape(PEER_TBLOCK, PEER_HEADS, PEER_TOPK * PEER_TOPK)
        cidx = (si[:, :, 0, :, None] * PEER_NKEYS + si[:, :, 1, None, :]).reshape(PEER_TBLOCK, PEER_HEADS, PEER_TOPK * PEER_TOPK)
        fv, fp = lax.top_k(cand, PEER_TOPK)
        eidx = jnp.take_along_axis(cidx, fp, axis=-1)
        g = jax.nn.softmax(fv, axis=-1)
        ue = jnp.take(u, eidx, axis=0)
        ve = jnp.take(v, eidx, axis=0)
        a = jnp.einsum('thkd,td->thk', ue, xb).astype(jnp.float32)
        wgt = (jax.nn.gelu(a, approximate=False) * g).astype(xb.dtype)
        return jnp.einsum('thk,thkd->td', wgt, ve)

    return lax.map(blk, hb).reshape(n, d)


def diff_lambda_init(layer_idx):
    return 0.8 - 0.6 * math.exp(-0.3 * layer_idx)


def setup_inputs(seed: int = 0) -> dict:
    key = jax.random.key(seed)
    ks = iter(jax.random.split(key, 32))
    n_even = (DEPTH + 1) // 2
    n_odd = DEPTH // 2

    def normal(shape, scale):
        return jax.random.normal(next(ks), shape, jnp.float32) * scale

    def gain(shape):
        return 1.0 + 0.02 * jax.random.normal(next(ks), shape, jnp.float32)

    D = D_MODEL
    return {
        'x': normal((BATCH, SEQ, D), 1.0),
        'c': normal((BATCH, D), 1.0),
        'ctx': normal((BATCH, CTX_LEN, D), 1.0),
        'c_ctx': normal((D,), 1.0),
        'ada_w': normal((DEPTH, D, N_MOD * D), 0.5 * D ** -0.5),
        'ada_b': normal((DEPTH, N_MOD * D), 0.02),
        'norm1_g': gain((DEPTH, D)),
        'norm2_g': gain((DEPTH, D)),
        'w_out': normal((DEPTH, MIX_WIDTH, D), MIX_WIDTH ** -0.5),
        'peer_wq': normal((DEPTH, D, PEER_HEADS * PEER_DQ), D ** -0.5),
        'peer_keys': normal((DEPTH, 2, PEER_NKEYS, PEER_DQ // 2), (PEER_DQ // 2) ** -0.5),
        'peer_u': normal((DEPTH, PEER_EXPERTS, D), D ** -0.5),
        'peer_v': normal((DEPTH, PEER_EXPERTS, D), PEER_HEADS ** -0.5),
        'ab_w_in': normal((n_even, D, AB_IN), D ** -0.5),
        'na_rpb': normal((n_even, NA_HEADS, 2 * NA_KR - 1, 2 * NA_KC - 1), 0.2),
        'swa_sink': normal((n_even, SWA_HEADS), 0.5),
        'cd_w_in': normal((n_odd, D, CD_IN), D ** -0.5),
        'mla_q_norm_g': gain((n_odd, MLA_Q_RANK)),
        'mla_w_uq': normal((n_odd, MLA_Q_RANK, MLA_HEADS * (MLA_NOPE + MLA_ROPE)), MLA_Q_RANK ** -0.5),
        'mla_kv_norm_g': gain((n_odd, MLA_KV_RANK)),
        'mla_w_ukv': normal((n_odd, MLA_KV_RANK, MLA_HEADS * (MLA_NOPE + MLA_V)), MLA_KV_RANK ** -0.5),
        'diff_lambda': normal((n_odd, 4, DIFF_QK), 0.1),
        'diff_subln_g': gain((n_odd, DIFF_V)),
        'final_norm_g': gain((D,)),
    }


def reference(x, c, ctx, c_ctx, ada_w, ada_b, norm1_g, norm2_g, w_out, peer_wq, peer_keys, peer_u, peer_v,
              ab_w_in, na_rpb, swa_sink, cd_w_in, mla_q_norm_g, mla_w_uq, mla_kv_norm_g, mla_w_ukv,
              diff_lambda, diff_subln_g, final_norm_g):
    B, S, D = x.shape
    C = ctx.shape[1]
    t = jnp.arange(S, dtype=jnp.int32)
    pos = (t // GRID_W, t % GRID_W)
    for l in range(DEPTH):
        last = l == DEPTH - 1
        m = jax.nn.silu(c) @ ada_w[l] + ada_b[l]
        mc = jax.nn.silu(c_ctx) @ ada_w[l] + ada_b[l]
        sh1, sc1, g1, sh2, sc2, g2 = split_cols(m[:, None, :], (D,) * N_MOD)
        csh1, csc1, cg1, csh2, csc2, cg2 = split_cols(mc, (D,) * N_MOD)
        h = rmsnorm(x, norm1_g[l]) * (1 + sc1) + sh1
        hc = rmsnorm(ctx, norm1_g[l]) * (1 + csc1) + csh1
        j = l // 2
        if l % 2 == 0:
            y, yc = mixer_ab(h, hc, ab_w_in[j], na_rpb[j], swa_sink[j], w_out[l], pos, not last)
        else:
            y, yc = mixer_cd(h, hc, cd_w_in[j], mla_q_norm_g[j], mla_w_uq[j], mla_kv_norm_g[j], mla_w_ukv[j],
                             diff_lambda[j], diff_subln_g[j], w_out[l], pos, diff_lambda_init(l), not last)
        x = x + g1 * y
        h2 = rmsnorm(x, norm2_g[l]) * (1 + sc2) + sh2
        if last:
            f = peer_ffn(h2.reshape(B * S, D), peer_wq[l], peer_keys[l], peer_u[l], peer_v[l])
            x = x + g2 * f.reshape(B, S, D)
        else:
            ctx = ctx + cg1 * yc
            h2c = rmsnorm(ctx, norm2_g[l]) * (1 + csc2) + csh2
            f = peer_ffn(jnp.concatenate([h2.reshape(B * S, D), h2c.reshape(B * C, D)], axis=0),
                         peer_wq[l], peer_keys[l], peer_u[l], peer_v[l])
            x = x + g2 * f[:B * S].reshape(B, S, D)
            ctx = ctx + cg2 * f[B * S:].reshape(B, C, D)
    return rmsnorm(x, final_norm_g)
```

```cpp
#include <hip/hip_runtime.h>
#include <cstdio>
#include <cstdint>

#define GAS __attribute__((address_space(1)))
#define LAS __attribute__((address_space(3)))
typedef unsigned short bf16;
typedef unsigned u32x4 __attribute__((ext_vector_type(4)));
typedef unsigned u32x2 __attribute__((ext_vector_type(2)));
typedef float f32x4 __attribute__((ext_vector_type(4)));
typedef float f32x2 __attribute__((ext_vector_type(2)));
typedef float f32x16 __attribute__((ext_vector_type(16)));
typedef short bf16x8 __attribute__((ext_vector_type(8)));
typedef short s16x4 __attribute__((ext_vector_type(4)));
typedef __bf16 bf2_t __attribute__((ext_vector_type(2)));

constexpr int NB = 16, SEQ = 4096, DM = 1024, CTX = 256, NLAT = NB * SEQ, NCTX = NB * CTX, NROW = NLAT + NCTX;
constexpr int AB_IN = 2304, CD_IN = 1952, CD_PAD = 2048, PQ_N = 2048, NEXP = 16384;
constexpr float RMS_EPS = 1e-6f, LOG2E = 1.4426950408889634f, NEGBIG = -1e30f;
constexpr float LAM_INIT1 = 0.35550906759f;

constexpr size_t MiB = 1u << 20;
constexpr size_t WS_CTL = 0, CTL_ZERO_BYTES = 1 * MiB;
constexpr size_t WS_MOD = 1 * MiB;
constexpr size_t WS_ROPE = 2 * MiB;
constexpr size_t WS_RSTD = 3 * MiB;
constexpr size_t WS_WIN0 = 4 * MiB;
constexpr size_t WS_WOUT = 9 * MiB;
constexpr size_t WS_WPQ = 13 * MiB;
constexpr size_t WS_WIN1 = 21 * MiB;
constexpr size_t WS_WUQ = 25 * MiB;
constexpr size_t WS_WUKV = 25 * MiB + 512 * 1024;
constexpr size_t WS_CTXRES = 26 * MiB;
constexpr size_t WS_U = 42 * MiB;
constexpr size_t WS_V = 106 * MiB;
constexpr size_t WS_ACT1 = 170 * MiB;
constexpr size_t WS_ACT2 = 306 * MiB;
constexpr size_t WS_Z = 442 * MiB;
constexpr size_t WS_QM = 748 * MiB;
constexpr size_t WS_KV = 844 * MiB;
constexpr size_t WS_END = 980 * MiB;
constexpr int CW_BAR = 4096;

constexpr int NWAVES = 8, NTHREADS = 512;
constexpr int LDS_BYTES = 147456;
constexpr int LDS_MISC = 135168;

__device__ __forceinline__ unsigned cvt_pk_bf16(float lo, float hi) { unsigned r; asm volatile("v_cvt_pk_bf16_f32 %0, %1, %2" : "=v"(r) : "v"(lo), "v"(hi)); return r; }
__device__ __forceinline__ float bf_lo(unsigned w) { return __uint_as_float(w << 16); }
__device__ __forceinline__ float bf_hi(unsigned w) { return __uint_as_float(w & 0xffff0000u); }
__device__ __forceinline__ float wave_sum(float v) {
#pragma unroll
    for (int o = 1; o < 64; o <<= 1) v += __shfl_xor(v, o);
    return v;
}

namespace pg8 {
constexpr int BM = 256, BK = 64, HALF = 128, HTB = HALF * BK * 2, NXCD = 8, WGM = 8;
__host__ __device__ __forceinline__ int lds_byte(int r, int c) { const int st = (r >> 4) * 2 + (c >> 5), rr = r & 15, cc = c & 31, ob = rr * 64 + cc * 2; return st * 1024 + (ob ^ (((ob >> 9) & 1) << 5)); }
__host__ __device__ __forceinline__ void stage_rc(int b, int& R, int& C) { const int st = b / 1024, sb = b % 1024, swz = sb ^ (((sb >> 9) & 1) << 5); R = (st >> 1) * 16 + swz / 64; C = (st & 1) * 32 + (swz % 64) / 2; }
__host__ __device__ __forceinline__ int perm32(int rho) { const int n = rho >> 4, i = rho & 15; return 8 * (i >> 2) + 4 * n + (i & 3); }
struct Unit { int pm, pn; };
struct Gemm { const bf16* A; const bf16* Bt; int M, N, K, lda, ldb; };
struct StaticOrder {
    int nM, nN, nwg, G, c;
    __device__ void init(int M, int N, int G_, int c_) { nM = M / BM; nN = N / BM; nwg = nM * nN; G = G_; c = c_; }
    __device__ bool next(int i, Unit& u) const {
        const long L = (long)i * G + c; if (L >= nwg) return false;
        int wgid = (int)L; { const int q = nwg / NXCD, r = nwg % NXCD, xcd = wgid % NXCD, off = wgid / NXCD; wgid = (xcd < r ? xcd * (q + 1) : r * (q + 1) + (xcd - r) * q) + off; }
        const int nig = WGM * nN, gid = wgid / nig, fm = gid * WGM, gsz = (nM - fm) < WGM ? (nM - fm) : WGM;
        u.pm = fm + ((wgid % nig) % gsz); u.pn = (wgid % nig) / gsz; return true;
    }
    __device__ __forceinline__ void a_ready(const Unit&) const {}
    __device__ __forceinline__ void done(const Unit&) const {}
};
template <class Epi, class Sched, bool ALIGN_EPI = true, bool SP2 = true>
__device__ __forceinline__ void gemm_phase(LAS unsigned char* lds, const Gemm g, const Sched& S, const Epi& E) {
    const int tid = threadIdx.x, wid = __builtin_amdgcn_readfirstlane(tid >> 6), lane = tid & 63, wr = wid >> 2, wc = wid & 3, fr = lane & 15, fq = lane >> 4;
    const int K = g.K, nt = K / BK;
    unsigned voffA[2], voffB[2];
#pragma unroll
    for (int i = 0; i < 2; ++i) { int R, C; stage_rc(tid * 16 + i * 8192, R, C); const int Rb = Epi::PERM ? ((R & ~31) + perm32(R & 31)) : R;
        voffA[i] = (unsigned)(R * g.lda + C) * 2u; voffB[i] = (unsigned)(Rb * g.ldb + C) * 2u; }
    const size_t kstep = (size_t)(BK * 2);
    const size_t hstepA = (size_t)HALF * g.lda * 2, hstepB = (size_t)HALF * g.ldb * 2;
    const size_t tstepA = 2 * hstepA, tstepB = 2 * hstepB;
    const unsigned ldsw = (unsigned)wid * 1024u;
    const int aoff = lds_byte(wr * 64 + fr, fq * 8), boff = lds_byte(wc * 32 + fr, fq * 8);
#define PG8_SA(b, h) (((b) * 2 + (h)) * HTB)
#define PG8_SB(b, h) ((4 + (b) * 2 + (h)) * HTB)
#define PG8_STAGE(bufoff, gbase, voff) do { _Pragma("unroll") for (int _i = 0; _i < 2; ++_i) \
        __builtin_amdgcn_global_load_lds((const unsigned*)((const char*)(gbase) + (voff)[_i]), (LAS unsigned*)(lds + (bufoff) + ldsw + _i * 8192), 16, 0, 0); } while (0)
#define PG8_LDA(dst, b, h) do { _Pragma("unroll") for (int m = 0; m < 4; ++m) _Pragma("unroll") for (int k = 0; k < 2; ++k) dst[m][k] = *(const LAS bf16x8*)(lds + PG8_SA(b, h) + aoff + m * 2048 + k * 1024); } while (0)
#define PG8_LDB(dst, b, h) do { _Pragma("unroll") for (int n = 0; n < 2; ++n) _Pragma("unroll") for (int k = 0; k < 2; ++k) dst[n][k] = *(const LAS bf16x8*)(lds + PG8_SB(b, h) + boff + n * 2048 + k * 1024); } while (0)
#define PG8_MMA(ai, bj, At, Bt) do { __builtin_amdgcn_s_setprio(1); _Pragma("unroll") for (int m = 0; m < 4; ++m) _Pragma("unroll") for (int n = 0; n < 2; ++n) _Pragma("unroll") for (int k = 0; k < 2; ++k) \
        acc[ai][bj][m][n] = __builtin_amdgcn_mfma_f32_16x16x32_bf16(Bt[n][k], At[m][k], acc[ai][bj][m][n], 0, 0, 0); __builtin_amdgcn_s_setprio(0); } while (0)
#define PG8_WAIT_V(n) asm volatile("s_waitcnt vmcnt(" #n ")" ::: "memory")
#define PG8_WAIT_L(n) asm volatile("s_waitcnt lgkmcnt(" #n ")" ::: "memory")
#define PG8_BAR __builtin_amdgcn_s_barrier()
#define PG8_SCHED __builtin_amdgcn_sched_barrier(0)
    Unit cur, nxt; int ui = 0;
    if (!S.next(0, cur)) return;
    f32x4 acc[2][2][4][2];
#pragma unroll
    for (int a = 0; a < 2; ++a)
#pragma unroll
        for (int b = 0; b < 2; ++b)
#pragma unroll
            for (int m = 0; m < 4; ++m)
#pragma unroll
                for (int n = 0; n < 2; ++n) acc[a][b][m][n] = (f32x4){0.f, 0.f, 0.f, 0.f};
    bf16x8 At[4][2], B0[2][2], B1[2][2];
    const char* cA = (const char*)g.A + (size_t)cur.pm * tstepA; const char* cB = (const char*)g.Bt + (size_t)cur.pn * tstepB;
    S.a_ready(cur);
    if constexpr (SP2) {
        PG8_STAGE(PG8_SB(0, 0), cB, voffB); PG8_STAGE(PG8_SB(0, 1), cB + hstepB, voffB); PG8_STAGE(PG8_SA(0, 0), cA, voffA); PG8_STAGE(PG8_SA(0, 1), cA + hstepA, voffA);
        if (wr == 1) PG8_BAR;
        PG8_WAIT_V(2); PG8_BAR;
        PG8_STAGE(PG8_SB(1, 0), cB + kstep, voffB); PG8_STAGE(PG8_SA(1, 0), cA + kstep, voffA); PG8_STAGE(PG8_SB(1, 1), cB + hstepB + kstep, voffB);
        PG8_WAIT_V(6); PG8_BAR;
    } else {
        PG8_STAGE(PG8_SB(0, 0), cB, voffB); PG8_STAGE(PG8_SA(0, 0), cA, voffA); PG8_STAGE(PG8_SB(0, 1), cB + hstepB, voffB); PG8_STAGE(PG8_SA(0, 1), cA + hstepA, voffA);
        if (wr == 1) PG8_BAR;
        PG8_WAIT_V(4); PG8_BAR;
        PG8_STAGE(PG8_SB(1, 0), cB + kstep, voffB); PG8_STAGE(PG8_SA(1, 0), cA + kstep, voffA); PG8_STAGE(PG8_SB(1, 1), cB + hstepB + kstep, voffB);
        PG8_WAIT_V(6); PG8_BAR;
    }
    for (;;) {
        const bool has_next = S.next(ui + 1, nxt);
        const char* nA = has_next ? (const char*)g.A + (size_t)nxt.pm * tstepA : cA; const char* nB = has_next ? (const char*)g.Bt + (size_t)nxt.pn * tstepB : cB;
#pragma unroll 1
        for (int t = 0; t < nt; t += 2) {
            const bool last = (t == nt - 2);
            const char* a1 = cA + (size_t)(t + 1) * kstep;
            const char* a2 = last ? nA : cA + (size_t)(t + 2) * kstep; const char* b2 = last ? nB : cB + (size_t)(t + 2) * kstep;
            const char* a3 = a2 + kstep; const char* b3 = b2 + kstep;
            if (last && has_next) S.a_ready(nxt);
            if constexpr (SP2) {
            PG8_LDB(B0, 0, 0); PG8_LDB(B1, 0, 1); PG8_SCHED; PG8_LDA(At, 0, 0); PG8_STAGE(PG8_SA(1, 1), a1 + hstepA, voffA);
            PG8_WAIT_V(8); PG8_WAIT_L(0); PG8_BAR; PG8_MMA(0, 0, At, B0); PG8_MMA(0, 1, At, B1); PG8_BAR; PG8_SCHED;
            PG8_LDA(At, 0, 1); PG8_STAGE(PG8_SB(0, 0), b2, voffB); PG8_STAGE(PG8_SB(0, 1), b2 + hstepB, voffB); PG8_STAGE(PG8_SA(0, 0), a2, voffA);
            PG8_WAIT_V(8); PG8_WAIT_L(0); PG8_BAR; PG8_MMA(1, 0, At, B0); PG8_MMA(1, 1, At, B1); PG8_BAR; PG8_SCHED;
            PG8_LDB(B0, 1, 0); PG8_LDB(B1, 1, 1); PG8_SCHED; PG8_LDA(At, 1, 0); PG8_STAGE(PG8_SA(0, 1), a2 + hstepA, voffA);
            PG8_WAIT_V(8); PG8_WAIT_L(0); PG8_BAR; PG8_MMA(0, 0, At, B0); PG8_MMA(0, 1, At, B1); PG8_BAR; PG8_SCHED;
            PG8_LDA(At, 1, 1); PG8_STAGE(PG8_SB(1, 0), b3, voffB); PG8_STAGE(PG8_SB(1, 1), b3 + hstepB, voffB); PG8_STAGE(PG8_SA(1, 0), a3, voffA);
            PG8_WAIT_V(8); PG8_WAIT_L(0); PG8_BAR; PG8_MMA(1, 0, At, B0); PG8_MMA(1, 1, At, B1); PG8_BAR; PG8_SCHED;
            } else {
            PG8_LDB(B0, 0, 0); PG8_SCHED; PG8_LDA(At, 0, 0); PG8_STAGE(PG8_SA(1, 1), a1 + hstepA, voffA);
            PG8_WAIT_L(8); PG8_BAR; PG8_WAIT_L(0); PG8_MMA(0, 0, At, B0); PG8_BAR; PG8_SCHED;
            PG8_LDB(B1, 0, 1); PG8_STAGE(PG8_SB(0, 0), b2, voffB);
            PG8_BAR; PG8_WAIT_L(0); PG8_MMA(0, 1, At, B1); PG8_BAR;
            PG8_LDA(At, 0, 1); PG8_STAGE(PG8_SA(0, 0), a2, voffA);
            PG8_BAR; PG8_WAIT_L(0); PG8_MMA(1, 0, At, B0); PG8_BAR; PG8_SCHED;
            PG8_STAGE(PG8_SB(0, 1), b2 + hstepB, voffB);
            PG8_WAIT_V(6); PG8_BAR; PG8_MMA(1, 1, At, B1); PG8_BAR;
            PG8_LDB(B0, 1, 0); PG8_SCHED; PG8_LDA(At, 1, 0); PG8_STAGE(PG8_SA(0, 1), a2 + hstepA, voffA);
            PG8_WAIT_L(8); PG8_BAR; PG8_WAIT_L(0); PG8_MMA(0, 0, At, B0); PG8_BAR; PG8_SCHED;
            PG8_LDB(B1, 1, 1); PG8_STAGE(PG8_SB(1, 0), b3, voffB);
            PG8_BAR; PG8_WAIT_L(0); PG8_MMA(0, 1, At, B1); PG8_BAR;
            PG8_LDA(At, 1, 1); PG8_STAGE(PG8_SA(1, 0), a3, voffA);
            PG8_BAR; PG8_WAIT_L(0); PG8_MMA(1, 0, At, B0); PG8_BAR; PG8_SCHED;
            PG8_STAGE(PG8_SB(1, 1), b3 + hstepB, voffB);
            PG8_WAIT_V(6); PG8_BAR; PG8_MMA(1, 1, At, B1); PG8_BAR;
            }
        }
        if constexpr (ALIGN_EPI) { if (wr == 0) PG8_BAR; }
        E(acc, cur, wr, wc, fr, fq); S.done(cur);
        if (!has_next) break;
#pragma unroll
        for (int a = 0; a < 2; ++a)
#pragma unroll
            for (int b = 0; b < 2; ++b)
#pragma unroll
                for (int m = 0; m < 4; ++m)
#pragma unroll
                    for (int n = 0; n < 2; ++n) acc[a][b][m][n] = (f32x4){0.f, 0.f, 0.f, 0.f};
        cur = nxt; cA = nA; cB = nB; ++ui;
        if constexpr (ALIGN_EPI) { if (wr == 1) PG8_BAR; }
    }
    PG8_WAIT_V(0);
    if constexpr (!ALIGN_EPI) { if (wr == 0) PG8_BAR; }
    PG8_BAR;
#undef PG8_SA
#undef PG8_SB
#undef PG8_STAGE
#undef PG8_LDA
#undef PG8_LDB
#undef PG8_MMA
#undef PG8_WAIT_V
#undef PG8_WAIT_L
#undef PG8_BAR
#undef PG8_SCHED
}
}
template <int MODE> struct EpiRope {
    static constexpr bool PERM = false;
    bf16* O; int ldc; const float* rope;
    __device__ __forceinline__ void operator()(const f32x4 (&acc)[2][2][4][2], const pg8::Unit& u, int wr, int wc, int fr, int fq) const {
        const int row0 = u.pm * 256 + wr * 64 + fr;
#pragma unroll
        for (int ai = 0; ai < 2; ++ai)
#pragma unroll
            for (int m = 0; m < 4; ++m) {
                const int row = row0 + ai * 128 + m * 16; const bool lat = row < NLAT; const int t = row & 4095, prow = t >> 6, pcol = t & 63;
                bf16* rowp = O + (size_t)row * ldc;
#pragma unroll
                for (int bj = 0; bj < 2; ++bj) {
                    const int G = 8 * u.pn + 4 * bj + wc, col = 32 * G + 4 * fq;
                    f32x4 x1 = acc[ai][bj][m][0], x2 = acc[ai][bj][m][1];
                    int kind = 0, par = 0;
                    if (MODE == 0) { kind = (G >= 48 && G < 68) ? 1 : 0; par = G & 1; }
                    if (MODE == 1) { kind = (G == 12) ? 2 : ((G >= 13 && G < 45) ? 1 : 0); par = (G + 1) & 1; }
                    if (MODE == 2) { kind = (G % 3 == 2) ? 2 : 0; }
                    if (lat && kind == 1) {
                        const int pos = par ? pcol : prow;
                        const f32x4 c = *(const f32x4*)(rope + pos * 16 + 4 * fq), s = *(const f32x4*)(rope + 1024 + pos * 16 + 4 * fq);
                        const f32x4 o1 = x1 * c - x2 * s, o2 = x1 * s + x2 * c; x1 = o1; x2 = o2;
                    } else if (lat && kind == 2) {
                        const int pos = (fq < 2) ? prow : pcol;
                        const f32x4 c = *(const f32x4*)(rope + 2048 + pos * 8 + (4 * fq & 7)), s = *(const f32x4*)(rope + 2560 + pos * 8 + (4 * fq & 7));
                        const f32x4 o1 = x1 * c - x2 * s, o2 = x1 * s + x2 * c; x1 = o1; x2 = o2;
                    }
                    u32x2 w0, w1; w0.x = cvt_pk_bf16(x1[0], x1[1]); w0.y = cvt_pk_bf16(x1[2], x1[3]); w1.x = cvt_pk_bf16(x2[0], x2[1]); w1.y = cvt_pk_bf16(x2[2], x2[3]);
                    *(u32x2*)(rowp + col) = w0; *(u32x2*)(rowp + col + 16) = w1;
                }
                __builtin_amdgcn_sched_barrier(0);
            }
    }
};
struct EpiBf16 {
    static constexpr bool PERM = true;
    bf16* O; int ldc; const float* rstd; int ridx;
    __device__ __forceinline__ void operator()(const f32x4 (&acc)[2][2][4][2], const pg8::Unit& u, int wr, int wc, int fr, int fq) const {
        const int row0 = u.pm * 256 + wr * 64 + fr, col0 = u.pn * 256 + wc * 32 + 8 * fq;
#pragma unroll
        for (int ai = 0; ai < 2; ++ai)
#pragma unroll
            for (int m = 0; m < 4; ++m) {
                const int row = row0 + ai * 128 + m * 16; float rs = 1.f; if (rstd) rs = rstd[(size_t)row * 2 + ridx];
                bf16* rowp = O + (size_t)row * ldc + col0;
#pragma unroll
                for (int bj = 0; bj < 2; ++bj) { const f32x4 v0 = acc[ai][bj][m][0] * rs, v1 = acc[ai][bj][m][1] * rs;
                    u32x4 w; w.x = cvt_pk_bf16(v0[0], v0[1]); w.y = cvt_pk_bf16(v0[2], v0[3]); w.z = cvt_pk_bf16(v1[0], v1[1]); w.w = cvt_pk_bf16(v1[2], v1[3]);
                    *(u32x4*)(rowp + bj * 128) = w; }
            }
    }
};
struct EpiResid {
    static constexpr bool PERM = true;
    const float* base_lat; const float* base_ctx; float* out_lat; float* out_ctx; const float* gate;
    __device__ __forceinline__ void operator()(const f32x4 (&acc)[2][2][4][2], const pg8::Unit& u, int wr, int wc, int fr, int fq) const {
        const int row0 = u.pm * 256 + wr * 64 + fr, col0 = u.pn * 256 + wc * 32 + 8 * fq;
#pragma unroll
        for (int ai = 0; ai < 2; ++ai)
#pragma unroll
            for (int m = 0; m < 4; ++m) {
                const int row = row0 + ai * 128 + m * 16; const bool lat = row < NLAT; const int rr = lat ? row : row - NLAT, br = lat ? (row >> 12) : 16;
                const float* bp = (lat ? base_lat : base_ctx) + (size_t)rr * DM + col0; float* op = (lat ? out_lat : out_ctx) + (size_t)rr * DM + col0;
                const float* gp = gate + (size_t)br * 6144 + col0;
#pragma unroll
                for (int bj = 0; bj < 2; ++bj) {
                    const f32x4 g0 = *(const f32x4*)(gp + bj * 128), g1 = *(const f32x4*)(gp + bj * 128 + 4);
                    const f32x4 b0 = *(const f32x4*)(bp + bj * 128), b1 = *(const f32x4*)(bp + bj * 128 + 4);
                    *(f32x4*)(op + bj * 128) = b0 + g0 * acc[ai][bj][m][0]; *(f32x4*)(op + bj * 128 + 4) = b1 + g1 * acc[ai][bj][m][1];
                }
            }
    }
};
__device__ __forceinline__ int crow(int r, int h) { return (r & 3) + 8 * (r >> 2) + 4 * h; }
__device__ __forceinline__ float fexp2(float x) { return __builtin_amdgcn_exp2f(x); }

template <class P>
__device__ __forceinline__ void attn_tile(const LAS unsigned char* Kt, const LAS unsigned char* Vt, const bf16x8 (&qf)[P::DK / 16], f32x16 (&O)[P::DV / 32], float& m, float& l, int lane, const P& p, int t) {
    constexpr int DK = P::DK, DV = P::DV, KRS = DK * 2 + 16, NDB = DV / 32;
    const int r32 = lane & 31, h = lane >> 5;
    f32x16 s0, s1;
#pragma unroll
    for (int i = 0; i < 16; ++i) { s0[i] = 0.f; s1[i] = 0.f; }
#pragma unroll
    for (int s = 0; s < DK / 16; ++s) {
        const bf16x8 k0 = *(const LAS bf16x8*)(Kt + r32 * KRS + (16 * s + 8 * h) * 2);
        const bf16x8 k1 = *(const LAS bf16x8*)(Kt + (32 + r32) * KRS + (16 * s + 8 * h) * 2);
        s0 = __builtin_amdgcn_mfma_f32_32x32x16_bf16(k0, qf[s], s0, 0, 0, 0);
        s1 = __builtin_amdgcn_mfma_f32_32x32x16_bf16(k1, qf[s], s1, 0, 0, 0);
    }
    p.mask(t, s0, s1, lane);
    float mx = fmaxf(s0[0], s1[0]);
#pragma unroll
    for (int i = 1; i < 16; ++i) mx = fmaxf(mx, fmaxf(s0[i], s1[i]));
    mx = fmaxf(mx, __shfl_xor(mx, 32));
    const float mn = fmaxf(m, mx), alpha = fexp2(m - mn); m = mn;
    float ps = 0.f;
#pragma unroll
    for (int i = 0; i < 16; ++i) { const float a = (s0[i] > -1e29f) ? fexp2(s0[i] - mn) : 0.f, b = (s1[i] > -1e29f) ? fexp2(s1[i] - mn) : 0.f; s0[i] = a; s1[i] = b; ps += a + b; }
    l = l * alpha + ps;
#pragma unroll
    for (int db = 0; db < NDB; ++db) O[db] = O[db] * alpha;
    bf16x8 pf[2][2];
#pragma unroll
    for (int s2 = 0; s2 < 2; ++s2) {
        u32x4 w0, w1;
        w0.x = cvt_pk_bf16(s0[8 * s2 + 0], s0[8 * s2 + 1]); w0.y = cvt_pk_bf16(s0[8 * s2 + 2], s0[8 * s2 + 3]); w0.z = cvt_pk_bf16(s0[8 * s2 + 4], s0[8 * s2 + 5]); w0.w = cvt_pk_bf16(s0[8 * s2 + 6], s0[8 * s2 + 7]);
        w1.x = cvt_pk_bf16(s1[8 * s2 + 0], s1[8 * s2 + 1]); w1.y = cvt_pk_bf16(s1[8 * s2 + 2], s1[8 * s2 + 3]); w1.z = cvt_pk_bf16(s1[8 * s2 + 4], s1[8 * s2 + 5]); w1.w = cvt_pk_bf16(s1[8 * s2 + 6], s1[8 * s2 + 7]);
        pf[0][s2] = __builtin_bit_cast(bf16x8, w0); pf[1][s2] = __builtin_bit_cast(bf16x8, w1);
    }
    const int lanebase = ((lane >> 5) * 4 + ((lane >> 2) & 3)) * 64 + ((lane >> 4) & 1) * 32 + (lane & 3) * 8;
#pragma unroll
    for (int db = 0; db < NDB; ++db)
#pragma unroll
        for (int b = 0; b < 2; ++b)
#pragma unroll
            for (int s2 = 0; s2 < 2; ++s2) {
                const s16x4 v0 = __builtin_amdgcn_ds_read_tr16_b64_v4i16((LAS s16x4*)(Vt + ((4 * b + 2 * s2 + 0) * NDB + db) * 512 + lanebase));
                const s16x4 v1 = __builtin_amdgcn_ds_read_tr16_b64_v4i16((LAS s16x4*)(Vt + ((4 * b + 2 * s2 + 1) * NDB + db) * 512 + lanebase));
                const bf16x8 vf = {v0[0], v0[1], v0[2], v0[3], v1[0], v1[1], v1[2], v1[3]};
                O[db] = __builtin_amdgcn_mfma_f32_32x32x16_bf16(vf, pf[b][s2], O[db], 0, 0, 0);
            }
}

template <class P>
__device__ __forceinline__ void attn_unit(LAS unsigned char* lds, const P& p, const bf16* qptr, float m, float l, f32x16 (&O)[P::DV / 32]) {
    constexpr int DK = P::DK, DV = P::DV, KRS = DK * 2 + 16, KBYTES = 64 * KRS, VBYTES = 64 * DV * 2, NDB = DV / 32, NV = DV / 64, VCH = DV / 8;
    const int tid = threadIdx.x, lane = tid & 63, h = lane >> 5;
    bf16x8 qf[DK / 16];
#pragma unroll
    for (int s = 0; s < DK / 16; ++s) qf[s] = *(const bf16x8*)(qptr + 16 * s + 8 * h);
#pragma unroll
    for (int db = 0; db < NDB; ++db)
#pragma unroll
        for (int i = 0; i < 16; ++i) O[db][i] = 0.f;
    const int kkey = tid >> 3, kch = tid & 7, k2key = tid >> 2, k2ch = tid & 3;
    u32x4 kr, kr2 = (u32x4){0u, 0u, 0u, 0u}, vr[NV];
#define AT_LOAD(t_) do { const bf16 *kp_, *k2p_, *vp_; p.src((t_), kp_, k2p_, vp_); kr = *(const u32x4*)(kp_ + (size_t)kkey * p.ldk + kch * 8); \
        if (DK == 96) { if (tid < 256) kr2 = *(const u32x4*)(k2p_ + (size_t)k2key * p.ldk2 + k2ch * 8); } \
        _Pragma("unroll") for (int i_ = 0; i_ < NV; ++i_) { const int c_ = tid + 512 * i_, key_ = c_ / VCH, ch_ = c_ % VCH; vr[i_] = *(const u32x4*)(vp_ + (size_t)key_ * p.ldv + ch_ * 8); } } while (0)
#define AT_STORE(buf_) do { LAS unsigned char* kb_ = lds + (buf_) * KBYTES; LAS unsigned char* vb_ = lds + 2 * KBYTES + (buf_) * VBYTES; \
        *(LAS u32x4*)(kb_ + kkey * KRS + kch * 16) = kr; if (DK == 96) { if (tid < 256) *(LAS u32x4*)(kb_ + k2key * KRS + 128 + k2ch * 16) = kr2; } \
        _Pragma("unroll") for (int i_ = 0; i_ < NV; ++i_) { const int c_ = tid + 512 * i_, key_ = c_ / VCH, ch_ = c_ % VCH; \
            *(LAS u32x4*)(vb_ + ((key_ >> 3) * NDB + (ch_ >> 2)) * 512 + (key_ & 7) * 64 + (ch_ & 3) * 16) = vr[i_]; } } while (0)
    const int nt = p.nt;
    AT_LOAD(0); AT_STORE(0); __syncthreads();
    for (int t = 0; t < nt; ++t) {
        if (t + 1 < nt) AT_LOAD(t + 1);
        if (p.active(t)) attn_tile<P>(lds + (t & 1) * KBYTES, lds + 2 * KBYTES + (t & 1) * VBYTES, qf, O, m, l, lane, p, t);
        if (t + 1 < nt) AT_STORE((t + 1) & 1);
        __syncthreads();
    }
#undef AT_LOAD
#undef AT_STORE
    const float lt = l + __shfl_xor(l, 32), inv = lt > 0.f ? 1.f / lt : 0.f;
#pragma unroll
    for (int db = 0; db < NDB; ++db) O[db] = O[db] * inv;
}
template <int NDB> __device__ __forceinline__ void store_o(bf16* orow, const f32x16 (&O)[NDB], int h) {
#pragma unroll
    for (int db = 0; db < NDB; ++db)
#pragma unroll
        for (int g = 0; g < 4; ++g) { u32x2 w; w.x = cvt_pk_bf16(O[db][4 * g], O[db][4 * g + 1]); w.y = cvt_pk_bf16(O[db][4 * g + 2], O[db][4 * g + 3]); *(u32x2*)(orow + 32 * db + 8 * g + 4 * h) = w; }
}

template <int DK_, int DV_> struct PolPlain {
    static constexpr int DK = DK_, DV = DV_;
    const bf16 *kb, *k2b, *vb; int ldk, ldk2, ldv; int lat0, ctx0, nlat, nt; float c2;
    __device__ __forceinline__ void src(int t, const bf16*& k, const bf16*& k2, const bf16*& v) const {
        const int row = (t < nlat) ? lat0 + 64 * t : ctx0 + 64 * (t - nlat);
        k = kb + (size_t)row * ldk; k2 = k2b + (size_t)row * ldk2; v = vb + (size_t)row * ldv; }
    __device__ __forceinline__ bool active(int) const { return true; }
    __device__ __forceinline__ void mask(int, f32x16& s0, f32x16& s1, int) const { s0 = s0 * c2; s1 = s1 * c2; }
};
struct PolNA {
    static constexpr int DK = 64, DV = 64;
    const bf16 *kb, *k2b, *vb; int ldk, ldk2, ldv; int lat0, ctx0, lo, nt; int qrow, r0, qc, cs; const LAS float* rpb;
    __device__ __forceinline__ void src(int t, const bf16*& k, const bf16*& k2, const bf16*& v) const {
        const int row = (t < 4) ? ctx0 + 64 * t : lat0 + 64 * (lo + t - 4);
        k = kb + (size_t)row * ldk; k2 = k; v = vb + (size_t)row * ldv; }
    __device__ __forceinline__ bool active(int t) const { const int kr = lo + t - 4; return t < 4 || (kr >= r0 && kr < r0 + 8); }
    __device__ __forceinline__ void mask(int t, f32x16& s0, f32x16& s1, int lane) const {
        const float c2 = 0.125f * LOG2E;
        if (t < 4) { s0 = s0 * c2; s1 = s1 * c2; return; }
        const int h = lane >> 5, kr = lo + t - 4; const LAS float* rb = rpb + (kr - qrow + 7) * 31;
#pragma unroll
        for (int i = 0; i < 16; ++i) {
            const int kc0 = crow(i, h), kc1 = 32 + kc0;
            const int d0 = min(max(kc0 - qc + 15, 0), 30), d1 = min(max(kc1 - qc + 15, 0), 30);
            const bool v0 = (kc0 >= cs) && (kc0 < cs + 16), v1 = (kc1 >= cs) && (kc1 < cs + 16);
            s0[i] = v0 ? s0[i] * c2 + rb[d0] : NEGBIG; s1[i] = v1 ? s1[i] * c2 + rb[d1] : NEGBIG;
        }
    }
};
struct PolSWA {
    static constexpr int DK = 64, DV = 64;
    const bf16 *kb, *k2b, *vb; int ldk, ldk2, ldv; int lat0, ctx0, pos0, nt; int qp;
    __device__ __forceinline__ void src(int t, const bf16*& k, const bf16*& k2, const bf16*& v) const {
        const int row = (t < 4) ? ctx0 + 64 * t : lat0 + pos0 + 64 * (t - 4);
        k = kb + (size_t)row * ldk; k2 = k; v = vb + (size_t)row * ldv; }
    __device__ __forceinline__ bool active(int) const { return true; }
    __device__ __forceinline__ void mask(int t, f32x16& s0, f32x16& s1, int lane) const {
        const float c2 = 0.125f * LOG2E;
        if (t < 4) { s0 = s0 * c2; s1 = s1 * c2; return; }
        const int h = lane >> 5, kp0 = pos0 + 64 * (t - 4) - qp;
#pragma unroll
        for (int i = 0; i < 16; ++i) {
            const int d0 = kp0 + crow(i, h), d1 = d0 + 32;
            s0[i] = (d0 >= -128 && d0 <= 128) ? s0[i] * c2 : NEGBIG; s1[i] = (d1 >= -128 && d1 <= 128) ? s1[i] * c2 : NEGBIG;
        }
    }
};
constexpr int PEER_LST = 0, PEER_SEL = 65536, PEER_WG = 98304;
#define TOPK_INSERT(L, v_) do { unsigned v__ = (v_); _Pragma("unroll") for (int q_ = 0; q_ < 16; ++q_) { const unsigned hi_ = max(L[q_], v__); v__ = min(L[q_], v__); L[q_] = hi_; } } while (0)

template <bool LAST>
__device__ __forceinline__ void peer_phase(LAS unsigned char* lds, int nrows, const bf16* SC, const bf16* X, const bf16* U, const bf16* V,
                                           float* res_lat, float* res_ctx, const float* g2mod  , const float* ngain, const float* nmod  , bf16* Hn, int vcu, int G) {
    const int tid = threadIdx.x, lane = tid & 63, wave = __builtin_amdgcn_readfirstlane(tid >> 6);
    LAS u32x2* LST = (LAS u32x2*)(lds + PEER_LST); LAS u32x2* SEL = (LAS u32x2*)(lds + PEER_SEL); LAS float* WG = (LAS float*)(lds + PEER_WG) + wave * 128;
    const int ngroups = nrows / 32;
    for (int grp = vcu; grp < ngroups; grp += G) {
        const int row0 = grp * 32;
        {
            const int tt = tid >> 4, hp = tid & 15, pp = tid & 1;
            const u32x4* sp = (const u32x4*)(SC + (size_t)(row0 + tt) * PQ_N + hp * 128);
            unsigned L[16];
#pragma unroll
            for (int q = 0; q < 16; ++q) L[q] = 0u;
            for (int cc = 0; cc < 4; ++cc) {
                u32x4 w[4];
#pragma unroll
                for (int c = 0; c < 4; ++c) w[c] = sp[cc * 4 + c];
#pragma unroll
                for (int c = 0; c < 4; ++c)
#pragma unroll
                    for (int d = 0; d < 4; ++d)
#pragma unroll
                        for (int hf = 0; hf < 2; ++hf) {
                            const unsigned b = hf ? (w[c][d] >> 16) : (w[c][d] & 0xffffu);
                            const unsigned s = b ^ ((b & 0x8000u) ? 0xffffu : 0x8000u);
                            const unsigned n = (unsigned)(cc * 32 + c * 8 + d * 2 + hf);
                            TOPK_INSERT(L, (s << 16) | (127u - n));
                        }
            }
            float sv[16], pv[16];
#pragma unroll
            for (int q = 0; q < 16; ++q) {
                const unsigned s = L[q] >> 16, b = s ^ ((s & 0x8000u) ? 0x8000u : 0xffffu);
                sv[q] = __uint_as_float(b << 16); const unsigned si = 127u - (L[q] & 0xffffu);
                LST[tid * 16 + q] = (u32x2){b << 16, si};
                pv[q] = __shfl_xor(sv[q], 1);
            }
            unsigned M[16];
#pragma unroll
            for (int q = 0; q < 16; ++q) M[q] = 0u;
#pragma unroll
            for (int i = 0; i < 16; ++i)
#pragma unroll
                for (int j = 0; j < 16; ++j)
                    if ((i + 1) * (j + 1) <= 16) {
                        const float a = pp ? pv[i] : sv[i], b = pp ? sv[j] : pv[j];
                        const unsigned ub = __float_as_uint(a + b), ks = ub ^ ((ub >> 31) ? 0xffffffffu : 0x80000000u);
                        TOPK_INSERT(M, (ks & 0xffffff00u) | (unsigned)(255 - (i * 16 + j)));
                    }
            __syncthreads();
            float fv[16]; unsigned eid[16]; float mx = -3.0e38f;
            const int t0 = tid & ~1;
#pragma unroll
            for (int q = 0; q < 16; ++q) {
                const unsigned code = 255u - (M[q] & 0xffu), i = code >> 4, j = code & 15u;
                const u32x2 e0 = LST[t0 * 16 + i], e1 = LST[(t0 + 1) * 16 + j];
                fv[q] = __uint_as_float(e0.x) + __uint_as_float(e1.x); eid[q] = e0.y * 128u + e1.y; mx = fmaxf(mx, fv[q]);
            }
            float den = 0.f;
#pragma unroll
            for (int q = 0; q < 16; ++q) { fv[q] = __expf(fv[q] - mx); den += fv[q]; }
            const float inv = 1.f / den;
            if (pp == 0) {
                const int hh = hp >> 1;
#pragma unroll
                for (int q = 0; q < 16; ++q) SEL[tt * 128 + hh * 16 + q] = (u32x2){eid[q], __float_as_uint(fv[q] * inv)};
            }
        }
        __syncthreads();
        for (int ti = 0; ti < 4; ++ti) {
            const int tt = wave + 8 * ti, row = row0 + tt;
            const bool lat = row < NLAT; const int rr = lat ? row : row - NLAT, br = lat ? (row >> 12) : 16;
            const bf16* xrow = X + (size_t)row * DM;
            u32x4 xg[8];
#pragma unroll
            for (int c = 0; c < 8; ++c) xg[c] = *(const u32x4*)(xrow + (c * 16 + (lane & 15)) * 8);
            const LAS u32x2* sel = SEL + tt * 128;
#pragma unroll 2
            for (int g4 = 0; g4 < 32; ++g4) {
                const int k = 4 * g4 + (lane >> 4);
                const u32x2 se = sel[k];
                const bf16* up = U + (size_t)se.x * DM + (lane & 15) * 8;
                float acc = 0.f;
#pragma unroll
                for (int c = 0; c < 8; ++c) {
                    const u32x4 uw = *(const u32x4*)(up + c * 128);
#pragma unroll
                    for (int d = 0; d < 4; ++d) { acc = fmaf(bf_lo(uw[d]), bf_lo(xg[c][d]), acc); acc = fmaf(bf_hi(uw[d]), bf_hi(xg[c][d]), acc); }
                }
                acc += __shfl_xor(acc, 1); acc += __shfl_xor(acc, 2); acc += __shfl_xor(acc, 4); acc += __shfl_xor(acc, 8);
                const float ge = 0.5f * acc * (1.f + erff(acc * 0.70710678118654752f));
                if ((lane & 15) == 0) WG[k] = ge * __uint_as_float(se.y);
            }
            asm volatile("s_waitcnt lgkmcnt(0)" ::: "memory");
            float o[16];
#pragma unroll
            for (int i = 0; i < 16; ++i) o[i] = 0.f;
#pragma unroll 8
            for (int k = 0; k < 128; ++k) {
                const unsigned e = __builtin_amdgcn_readfirstlane(sel[k].x); const float wg = WG[k];
                const bf16* vp = V + (size_t)e * DM + lane * 8;
                const u32x4 v0 = *(const u32x4*)vp, v1 = *(const u32x4*)(vp + 512);
#pragma unroll
                for (int d = 0; d < 4; ++d) { o[2 * d] = fmaf(wg, bf_lo(v0[d]), o[2 * d]); o[2 * d + 1] = fmaf(wg, bf_hi(v0[d]), o[2 * d + 1]);
                                              o[8 + 2 * d] = fmaf(wg, bf_lo(v1[d]), o[8 + 2 * d]); o[8 + 2 * d + 1] = fmaf(wg, bf_hi(v1[d]), o[8 + 2 * d + 1]); }
            }
#if defined(DEBUG_CHECK)
            if (!LAST && row < 2048) { float* fd = (float*)((unsigned char*)Hn - WS_ACT2 + WS_QM) + (size_t)row * DM;
                for (int i = 0; i < 8; ++i) { fd[lane * 8 + i] = o[i]; fd[512 + lane * 8 + i] = o[8 + i]; }
                float* sd = (float*)((unsigned char*)Hn - WS_ACT2 + WS_QM) + (size_t)2048 * DM + (size_t)row * 384;
                for (int k = lane; k < 128; k += 64) { sd[k] = (float)sel[k].x; sd[128 + k] = __uint_as_float(sel[k].y); sd[256 + k] = WG[k]; } }
#endif
            float* rp = (lat ? res_lat : res_ctx) + (size_t)rr * DM; const float* gp = g2mod + (size_t)br * 6144;
            float xn[16]; float ss = 0.f;
#pragma unroll
            for (int hf = 0; hf < 2; ++hf)
#pragma unroll
                for (int q = 0; q < 2; ++q) {
                    const int col = hf * 512 + lane * 8 + q * 4;
                    const f32x4 r4 = *(const f32x4*)(rp + col), g4v = *(const f32x4*)(gp + col);
#pragma unroll
                    for (int e = 0; e < 4; ++e) { const float v = r4[e] + g4v[e] * o[hf * 8 + q * 4 + e]; xn[hf * 8 + q * 4 + e] = v; ss += v * v; }
                }
            ss = wave_sum(ss);
            const float rs = 1.0f / sqrtf(ss * (1.0f / DM) + RMS_EPS);
#pragma unroll
            for (int hf = 0; hf < 2; ++hf) {
                const int col = hf * 512 + lane * 8;
                if (LAST) {
                    const f32x4 ga = *(const f32x4*)(ngain + col), gb = *(const f32x4*)(ngain + col + 4); f32x4 oa, ob;
#pragma unroll
                    for (int e = 0; e < 4; ++e) { oa[e] = xn[hf * 8 + e] * rs * ga[e]; ob[e] = xn[hf * 8 + 4 + e] * rs * gb[e]; }
                    *(f32x4*)(rp + col) = oa; *(f32x4*)(rp + col + 4) = ob;
                } else {
                    f32x4 xa, xb;
#pragma unroll
                    for (int e = 0; e < 4; ++e) { xa[e] = xn[hf * 8 + e]; xb[e] = xn[hf * 8 + 4 + e]; }
                    *(f32x4*)(rp + col) = xa; *(f32x4*)(rp + col + 4) = xb;
                    const float* mp = nmod + (size_t)br * 6144 + col; float y[8];
#pragma unroll
                    for (int e = 0; e < 8; ++e) y[e] = xn[hf * 8 + e] * rs * ngain[col + e] * (1.f + mp[1024 + e]) + mp[e];
                    u32x4 w; w.x = cvt_pk_bf16(y[0], y[1]); w.y = cvt_pk_bf16(y[2], y[3]); w.z = cvt_pk_bf16(y[4], y[5]); w.w = cvt_pk_bf16(y[6], y[7]);
                    *(u32x4*)(Hn + (size_t)row * DM + col) = w;
                }
            }
        }
        __syncthreads();
    }
}
#define XB_TMO      128
#define XB_XCNT(j)  (256  + 64 * (j))
#define XB_XSUB(j)  (1280 + 64 * (j))
#define XB_XGEN(j)  (2304 + 64 * (j))
#define XB_TOP      3328
#define XB_TOPGEN   3392
#define XCD_BAR_WORDS 3456
#define XB_SPIN_CAP (1u << 22)
__device__ __forceinline__ unsigned xb_ld(unsigned* p)              { return __hip_atomic_load(p, __ATOMIC_RELAXED, __HIP_MEMORY_SCOPE_AGENT); }
__device__ __forceinline__ unsigned xb_add(unsigned* p, unsigned v) { return __hip_atomic_fetch_add(p, v, __ATOMIC_RELAXED, __HIP_MEMORY_SCOPE_AGENT); }
__device__ __forceinline__ unsigned xb_xcc_id() { return (unsigned)__builtin_amdgcn_s_getreg((3 << 11) | 20) & 0xFu; }
#define XB_SPIN(cond, bar) do { unsigned _sp = 0; while (cond) { __builtin_amdgcn_s_sleep(1); \
    if ((++_sp & 255u) == 0u) { if (xb_ld(&(bar)[XB_TMO])) break; if (_sp > XB_SPIN_CAP) { atomicAdd(&(bar)[XB_TMO], 1u); break; } } } } while (0)
struct XcdBarrier { unsigned* bar; unsigned x; volatile LAS unsigned* st; };
__device__ __forceinline__ XcdBarrier xcd_barrier_post(unsigned* bar, volatile LAS unsigned* st) {
    XcdBarrier b; b.bar = bar; b.x = xb_xcc_id(); b.st = st;
    if (threadIdx.x == 0) (void)xb_add(&bar[XB_XCNT(b.x)], 1u);
    return b;
}
__device__ __forceinline__ void xcd_barrier_complete(unsigned* bar, unsigned x, unsigned& nloc, unsigned& nx) {
    const unsigned G = gridDim.x * gridDim.y * gridDim.z;
    unsigned sum, cnt, mine, sp = 0u;
    for (;;) {
        sum = 0u; cnt = 0u; mine = 0u;
#pragma unroll
        for (unsigned j = 0; j < 16; ++j) { const unsigned c = xb_ld(&bar[XB_XCNT(j)]); sum += c; cnt += (c > 0u) ? 1u : 0u; mine = (j == x) ? c : mine; }
        if (sum == G) break;
        __builtin_amdgcn_s_sleep(1);
        if ((++sp & 255u) == 0u) { if (xb_ld(&bar[XB_TMO])) break; if (sp > XB_SPIN_CAP) { atomicAdd(&bar[XB_TMO], 1u); break; } }
    }
    nloc = mine > 0u ? mine : 1u; nx = cnt > 0u ? cnt : 1u;
}
__device__ __forceinline__ void xcd_barrier(const XcdBarrier& b) {
    asm volatile("s_waitcnt vmcnt(0)" ::: "memory");
    __syncthreads();
    if (threadIdx.x == 0) {
        unsigned* bar = b.bar;
        __builtin_amdgcn_s_waitcnt(0);
        unsigned nloc = b.st[0], nx = b.st[1];
        if (nloc == 0u) { xcd_barrier_complete(bar, b.x, nloc, nx); b.st[0] = nloc; b.st[1] = nx; }
        const unsigned old = xb_add(&bar[XB_XSUB(b.x)], 1u);
        const unsigned gen = old / nloc;
        if (old + 1u == (gen + 1u) * nloc) {
            __builtin_amdgcn_fence(__ATOMIC_RELEASE, "agent");
            asm volatile("s_waitcnt vmcnt(0)" ::: "memory");
            const unsigned og = xb_add(&bar[XB_TOP], 1u);
            const unsigned tg = og / nx;
            if (og + 1u == (tg + 1u) * nx) xb_add(&bar[XB_TOPGEN], 1u);
            else XB_SPIN(xb_ld(&bar[XB_TOPGEN]) == tg, bar);
            __builtin_amdgcn_fence(__ATOMIC_ACQUIRE, "agent");
            xb_add(&bar[XB_XGEN(b.x)], 1u);
            asm volatile("s_waitcnt vmcnt(0)" ::: "memory");
        } else {
            XB_SPIN(xb_ld(&bar[XB_XGEN(b.x)]) == gen, bar);
            __builtin_amdgcn_fence(__ATOMIC_ACQUIRE, "agent");
            asm volatile("s_waitcnt vmcnt(0)" ::: "memory");
        }
    }
    __syncthreads();
}

__device__ __forceinline__ void transpose_item(const float* W, int K, int ldw, bf16* WT, const float* kscale, LAS float* scr, int kb, int nb, int srccol, int lane) {
    const int k0 = 64 * kb, n0 = 32 * nb;
#pragma unroll 8
    for (int i = 0; i < 32; ++i) { const int kk = 2 * i + (lane >> 5); float v = (srccol >= 0) ? W[(size_t)(k0 + kk) * ldw + srccol] : 0.f; if (kscale) v *= kscale[k0 + kk]; scr[kk * 33 + (lane & 31)] = v; }
    asm volatile("s_waitcnt lgkmcnt(0)" ::: "memory");
    const int c = lane & 7;
#pragma unroll
    for (int j = 0; j < 4; ++j) { const int n = (lane >> 3) + 8 * j; const LAS float* s = scr + (8 * c) * 33 + n;
        u32x4 o; o.x = cvt_pk_bf16(s[0 * 33], s[1 * 33]); o.y = cvt_pk_bf16(s[2 * 33], s[3 * 33]); o.z = cvt_pk_bf16(s[4 * 33], s[5 * 33]); o.w = cvt_pk_bf16(s[6 * 33], s[7 * 33]);
        *(u32x4*)(WT + (size_t)(n0 + n) * K + k0 + 8 * c) = o; }
    asm volatile("s_waitcnt lgkmcnt(0)" ::: "memory");
}
__device__ __forceinline__ int rope_perm(int p) { return p < 8 ? p : (p < 16 ? 8 + p : (p < 24 ? p - 8 : p)); }

__device__ __forceinline__ void norm_mod_rows(int nrows, const float* src_lat, const float* src_ctx, const float* gain, const float* mod  , int sh_off, int sc_off, bf16* dst, int gw, int ngw, int lane) {
    for (int row = gw; row < nrows; row += ngw) {
        const bool lat = row < NLAT; const int rr = lat ? row : row - NLAT, br = lat ? (row >> 12) : 16;
        const f32x4* xr = (const f32x4*)((lat ? src_lat : src_ctx) + (size_t)rr * DM) + lane;
        f32x4 v[4]; float s = 0.f;
#pragma unroll
        for (int j = 0; j < 4; ++j) { v[j] = xr[64 * j]; s += (v[j].x * v[j].x + v[j].y * v[j].y) + (v[j].z * v[j].z + v[j].w * v[j].w); }
        const float rs = 1.0f / sqrtf(wave_sum(s) * (1.0f / DM) + RMS_EPS);
        const float* mp = mod + (size_t)br * 6144;
#pragma unroll
        for (int j = 0; j < 4; ++j) {
            const int col = 4 * (lane + 64 * j);
            const f32x4 g = *(const f32x4*)(gain + col), sc = *(const f32x4*)(mp + sc_off + col), sh = *(const f32x4*)(mp + sh_off + col);
            const f32x4 y = v[j] * rs * g * (sc + 1.0f) + sh;
            u32x2 w; w.x = cvt_pk_bf16(y.x, y.y); w.y = cvt_pk_bf16(y.z, y.w);
            *(u32x2*)(dst + (size_t)row * DM + col) = w;
        }
    }
}
__device__ __forceinline__ int iclamp(int v, int lo, int hi) { return v < lo ? lo : (v > hi ? hi : v); }
__device__ __forceinline__ void attn_l0_phase(LAS unsigned char* lds, const bf16* Z, bf16* OUT, const float* rpb_g, const float* sink_g, int vcu, int G) {
    const int tid = threadIdx.x, lane = tid & 63, w = __builtin_amdgcn_readfirstlane(tid >> 6), r32 = lane & 31, h = lane >> 5;
    LAS float* rpbL = (LAS float*)(lds + 65536);
    for (int u = vcu; u < 4352; u += G) {
        f32x16 O[2];
        if (u < 2048) {
            const int rg = u & 15, hd = (u >> 4) & 7, b = u >> 7;
            for (int i = tid; i < 465; i += NTHREADS) rpbL[i] = rpb_g[hd * 465 + i] * LOG2E;
            PolNA p; p.kb = Z + 512 + hd * 64; p.k2b = p.kb; p.vb = Z + 1024 + hd * 64; p.ldk = p.ldk2 = p.ldv = AB_IN; p.lat0 = b * SEQ; p.ctx0 = NLAT + b * CTX;
            const int lo = iclamp(4 * rg - 4, 0, 56), hi = iclamp(4 * rg - 1, 0, 56) + 7; p.lo = lo; p.nt = 4 + hi - lo + 1;
            const int qrow = 4 * rg + (w >> 1), half = w & 1; p.qrow = qrow; p.r0 = iclamp(qrow - 4, 0, 56); p.qc = 32 * half + r32; p.cs = iclamp(p.qc - 8, 0, 48); p.rpb = rpbL;
            const size_t row = (size_t)b * SEQ + qrow * 64 + p.qc;
            attn_unit<PolNA>(lds, p, Z + row * AB_IN + hd * 64, NEGBIG, 0.f, O);
            store_o<2>(OUT + row * DM + hd * 64, O, h);
        } else if (u < 4096) {
            const int u2 = u - 2048, qb = u2 & 63, kvh = (u2 >> 6) & 1, b = u2 >> 7, P0 = 64 * qb;
            const int i0 = P0 >= 128 ? 0 : (128 - P0) / 64; int i1 = (4160 - P0) / 64; i1 = i1 > 4 ? 4 : i1;
            PolSWA p; p.kb = Z + 2048 + kvh * 64; p.k2b = p.kb; p.vb = Z + 2176 + kvh * 64; p.ldk = p.ldk2 = p.ldv = AB_IN; p.lat0 = b * SEQ; p.ctx0 = NLAT + b * CTX;
            p.pos0 = P0 - 128 + 64 * i0; p.nt = 4 + (i1 - i0 + 1);
            const int g = w >> 1, half = w & 1, qp = P0 + 32 * half + r32, qh = kvh * 4 + g; p.qp = qp;
            const size_t row = (size_t)b * SEQ + qp;
            attn_unit<PolSWA>(lds, p, Z + row * AB_IN + 1536 + qh * 64, sink_g[qh] * LOG2E, h == 0 ? 1.f : 0.f, O);
            store_o<2>(OUT + row * DM + 512 + qh * 64, O, h);
        } else {
            const int u3 = u - 4096, ty = u3 >> 7, hd = u3 & 7, b = (u3 >> 3) & 15;
            PolPlain<64, 64> p; p.ldk = p.ldk2 = p.ldv = AB_IN; p.lat0 = 0; p.nlat = 0; p.ctx0 = NLAT + b * CTX; p.nt = 4; p.c2 = 0.125f * LOG2E;
            int qcol, ocol; float m0 = NEGBIG, l0 = 0.f;
            if (ty == 0) { p.kb = Z + 512 + hd * 64; p.vb = Z + 1024 + hd * 64; qcol = hd * 64; ocol = hd * 64; }
            else { p.kb = Z + 2048 + (hd >> 2) * 64; p.vb = Z + 2176 + (hd >> 2) * 64; qcol = 1536 + hd * 64; ocol = 512 + hd * 64; m0 = sink_g[hd] * LOG2E; l0 = h == 0 ? 1.f : 0.f; }
            p.k2b = p.kb;
            const size_t row = (size_t)NLAT + b * CTX + 32 * w + r32;
            attn_unit<PolPlain<64, 64>>(lds, p, Z + row * AB_IN + qcol, m0, l0, O);
            store_o<2>(OUT + row * DM + ocol, O, h);
        }
    }
}
__device__ __forceinline__ void attn_l1_phase(LAS unsigned char* lds, const bf16* Z, const bf16* QM, const bf16* KV, bf16* OUT, const float* lamv, const float* subln, const float* rstd, int vcu, int G) {
    const int tid = threadIdx.x, lane = tid & 63, w = __builtin_amdgcn_readfirstlane(tid >> 6), r32 = lane & 31, h = lane >> 5;
    const float lam = expf(wave_sum(lamv[lane] * lamv[64 + lane])) - expf(wave_sum(lamv[128 + lane] * lamv[192 + lane])) + LAM_INIT1;
    for (int u = vcu; u < 3072; u += G) {
        if (u < 2048) {
            const int qb = u & 15, hd = (u >> 4) & 7, b = u >> 7;
            PolPlain<96, 64> p; p.kb = KV + hd * 128; p.ldk = DM; p.k2b = Z + 384; p.ldk2 = AB_IN; p.vb = KV + hd * 128 + 64; p.ldv = DM;
            p.lat0 = b * SEQ; p.ctx0 = NLAT + b * CTX; p.nlat = 64; p.nt = 68;
            const size_t row = (size_t)b * SEQ + 256 * qb + 32 * w + r32;
            p.c2 = 0.10206207261596577f * LOG2E * rstd[row * 2];
            f32x16 O[2];
            attn_unit<PolPlain<96, 64>>(lds, p, QM + row * 768 + hd * 96, NEGBIG, 0.f, O);
            store_o<2>(OUT + row * DM + hd * 64, O, h);
        } else {
            const int u2 = u - 2048, qb = u2 & 15, hh = (u2 >> 4) & 3, b = u2 >> 6;
            PolPlain<64, 128> p; p.ldk = p.ldk2 = p.ldv = AB_IN; p.vb = Z + 1440 + hh * 128; p.lat0 = b * SEQ; p.ctx0 = NLAT + b * CTX; p.nlat = 64; p.nt = 68; p.c2 = 0.125f * LOG2E;
            const size_t row = (size_t)b * SEQ + 256 * qb + 32 * w + r32;
            f32x16 O[4]; LAS unsigned* o1s = (LAS unsigned*)(lds + 65536 + w * 8192) + lane;
            p.kb = Z + 928 + (hh * 2) * 64; p.k2b = p.kb;
            attn_unit<PolPlain<64, 128>>(lds, p, Z + row * AB_IN + 416 + (hh * 2) * 64, NEGBIG, 0.f, O);
#pragma unroll
            for (int db = 0; db < 4; ++db)
#pragma unroll
                for (int i = 0; i < 8; ++i) o1s[(db * 8 + i) * 64] = cvt_pk_bf16(O[db][2 * i], O[db][2 * i + 1]);
            p.kb = Z + 928 + (hh * 2 + 1) * 64; p.k2b = p.kb;
            attn_unit<PolPlain<64, 128>>(lds, p, Z + row * AB_IN + 416 + (hh * 2 + 1) * 64, NEGBIG, 0.f, O);
            float ss = 0.f;
#pragma unroll
            for (int db = 0; db < 4; ++db)
#pragma unroll
                for (int i = 0; i < 8; ++i) { const unsigned pw = o1s[(db * 8 + i) * 64]; const float d0 = bf_lo(pw) - lam * O[db][2 * i], d1 = bf_hi(pw) - lam * O[db][2 * i + 1]; O[db][2 * i] = d0; O[db][2 * i + 1] = d1; ss += d0 * d0 + d1 * d1; }
            ss += __shfl_xor(ss, 32);
            const float rs = (1.f - LAM_INIT1) / sqrtf(ss * (1.0f / 128.0f) + RMS_EPS);
#pragma unroll
            for (int db = 0; db < 4; ++db)
#pragma unroll
                for (int g = 0; g < 4; ++g) { const f32x4 sg = *(const f32x4*)(subln + 32 * db + 8 * g + 4 * h);
#pragma unroll
                    for (int e = 0; e < 4; ++e) O[db][4 * g + e] *= rs * sg[e]; }
            store_o<4>(OUT + row * DM + 512 + hh * 128, O, h);
        }
    }
}
#ifndef STOP_AFTER
#define STOP_AFTER 15
#endif
#ifndef ONE_LAUNCH
#define ONE_LAUNCH 0
#endif
struct Args { const float* in[24]; float* out; unsigned char* ws; int ph_lo, ph_hi; };
__global__ void __launch_bounds__(NTHREADS, 2) fwd(Args a) {
    extern __shared__ __attribute__((aligned(16))) unsigned char lds_raw[];
    LAS unsigned char* lds = (LAS unsigned char*)lds_raw;
    const int tid = threadIdx.x, lane = tid & 63, wave = __builtin_amdgcn_readfirstlane(tid >> 6);
    const int G = gridDim.x, bx = blockIdx.x, vcu = (G % 8 == 0) ? (bx % 8) * (G / 8) + bx / 8 : bx;
    const int gw = vcu * NWAVES + wave, ngw = G * NWAVES;
    unsigned char* ws = a.ws;
    unsigned* ctl = (unsigned*)(ws + WS_CTL);
    float* MOD = (float*)(ws + WS_MOD); float* ROPE = (float*)(ws + WS_ROPE); float* RSTD = (float*)(ws + WS_RSTD);
    bf16* WIN0 = (bf16*)(ws + WS_WIN0); bf16* WOUT = (bf16*)(ws + WS_WOUT); bf16* WPQ = (bf16*)(ws + WS_WPQ); bf16* WIN1 = (bf16*)(ws + WS_WIN1);
    bf16* WUQ = (bf16*)(ws + WS_WUQ); bf16* WUKV = (bf16*)(ws + WS_WUKV); float* CTXRES = (float*)(ws + WS_CTXRES);
    bf16* UB = (bf16*)(ws + WS_U); bf16* VB = (bf16*)(ws + WS_V); bf16* ACT1 = (bf16*)(ws + WS_ACT1); bf16* ACT2 = (bf16*)(ws + WS_ACT2);
    bf16* Z = (bf16*)(ws + WS_Z); bf16* QM = (bf16*)(ws + WS_QM); bf16* KV = (bf16*)(ws + WS_KV);
    const float* x_in = a.in[0]; const float* c_in = a.in[1]; const float* ctx_in = a.in[2]; const float* cctx_in = a.in[3]; const float* ada_w = a.in[4]; const float* ada_b = a.in[5];
    const float* norm1_g = a.in[6]; const float* norm2_g = a.in[7]; const float* w_out = a.in[8]; const float* peer_wq = a.in[9]; const float* peer_keys = a.in[10];
    const float* peer_u = a.in[11]; const float* peer_v = a.in[12]; const float* ab_w_in = a.in[13]; const float* na_rpb = a.in[14]; const float* swa_sink = a.in[15];
    const float* cd_w_in = a.in[16]; const float* q_norm_g = a.in[17]; const float* w_uq = a.in[18]; const float* kv_norm_g = a.in[19]; const float* w_ukv = a.in[20];
    const float* diff_lambda = a.in[21]; const float* subln_g = a.in[22]; const float* final_g = a.in[23];
    float* out = a.out;

    volatile LAS unsigned* MISC = (volatile LAS unsigned*)(lds + LDS_MISC);
    if (tid < 16) MISC[tid] = 0u;
    __syncthreads();
    const int lo = a.ph_lo, hi = a.ph_hi;
    XcdBarrier bar; bar.bar = ctl + CW_BAR; bar.x = 0; bar.st = MISC + 8;
    if (hi - lo > 1) bar = xcd_barrier_post(ctl + CW_BAR, MISC + 8);
#ifndef PHASE_MASK
#define PHASE_MASK 0xffff
#endif
#define IN(k) ((((PHASE_MASK) >> (k)) & 1) && lo <= (k) && (k) < hi)
#define SEAM(k) do { if (IN(k) && IN((k) + 1)) xcd_barrier(bar); } while (0)

    if (IN(0)) {
        if (bx < 192) {
            const int l = bx / 96, n0 = (bx % 96) * 64;
            LAS float* sil = (LAS float*)lds;
            for (int idx = tid; idx < 17 * 1024; idx += NTHREADS) { const int r = idx >> 10, k = idx & 1023; const float cv = r < 16 ? c_in[idx] : cctx_in[k]; sil[idx] = cv / (1.f + expf(-cv)); }
            __syncthreads();
            float acc[17];
#pragma unroll
            for (int r = 0; r < 17; ++r) acc[r] = 0.f;
            const float* wp = ada_w + (size_t)l * 1024 * 6144 + n0 + lane;
            for (int k = wave * 128; k < wave * 128 + 128; k += 4) {
                const float w0 = wp[(size_t)k * 6144], w1 = wp[(size_t)(k + 1) * 6144], w2 = wp[(size_t)(k + 2) * 6144], w3 = wp[(size_t)(k + 3) * 6144];
#pragma unroll
                for (int r = 0; r < 17; ++r) { const f32x4 s4 = *(const LAS f32x4*)(sil + r * 1024 + k); acc[r] += (s4.x * w0 + s4.y * w1) + (s4.z * w2 + s4.w * w3); }
            }
            LAS float* part = (LAS float*)(lds + 69632);
#pragma unroll
            for (int r = 0; r < 17; ++r) part[(wave * 17 + r) * 64 + lane] = acc[r];
            __syncthreads();
            for (int idx = tid; idx < 17 * 64; idx += NTHREADS) { const int r = idx >> 6, ln = idx & 63; float s = 0.f;
#pragma unroll
                for (int w8 = 0; w8 < 8; ++w8) s += part[(w8 * 17 + r) * 64 + ln];
                MOD[((size_t)l * 17 + r) * 6144 + n0 + ln] = s + ada_b[l * 6144 + n0 + ln]; }
            __syncthreads();
        }
        LAS float* scr = (LAS float*)(lds + wave * 16384);
        constexpr int T0 = 1152, T1 = T0 + 1024, T2 = T1 + 1024, T3 = T2 + 96, T4 = T3 + 64, T5 = T4 + 4096, T6 = T5 + 4096, T7 = T6 + 24;
        for (int it = gw; it < T7; it += ngw) {
            if (it < T0) { const int kb = it / 72, nb = it % 72; transpose_item(ab_w_in, 1024, AB_IN, WIN0, nullptr, scr, kb, nb, 32 * nb + (lane & 31), lane); }
            else if (it < T1) { const int r = it - T0, l = r >> 9, kb = (r & 511) >> 5, nb = r & 31; transpose_item(w_out + (size_t)l * DM * DM, 1024, DM, WOUT + (size_t)l * DM * DM, nullptr, scr, kb, nb, 32 * nb + (lane & 31), lane); }
            else if (it < T2) { const int r = it - T1, kb = r >> 6, nb = r & 63, n = 32 * nb + (lane & 31);
                const int src = n < CD_IN ? (nb == 12 ? 384 + rope_perm(lane & 31) : n) : -1;
                transpose_item(cd_w_in, 1024, CD_IN, WIN1, nullptr, scr, kb, nb, src, lane); }
            else if (it < T3) { const int r = it - T2, kb = r / 24, nb = r % 24; const int src = (nb % 3 == 2) ? 32 * nb + rope_perm(lane & 31) : 32 * nb + (lane & 31);
                transpose_item(w_uq, 256, 768, WUQ, q_norm_g, scr, kb, nb, src, lane); }
            else if (it < T4) { const int r = it - T3, kb = r >> 5, nb = r & 31; transpose_item(w_ukv, 128, 1024, WUKV, kv_norm_g, scr, kb, nb, 32 * nb + (lane & 31), lane); }
            else if (it < T5) {
                const int r = it - T4, l = r >> 11, hp = (r >> 7) & 15, kb = (r >> 2) & 31, nb = r & 3, i32 = lane & 31, hh = lane >> 5;
                const float* ap = peer_wq + (size_t)l * DM * PQ_N + (size_t)(32 * kb + i32) * PQ_N + hp * 128 + 64 * hh;
                const float* bp = peer_keys + (size_t)l * 2 * 128 * 128 + (size_t)(hp & 1) * 128 * 128 + (size_t)(32 * nb + i32) * 128 + 64 * hh;
                f32x16 acc;
#pragma unroll
                for (int i = 0; i < 16; ++i) acc[i] = 0.f;
                for (int s4 = 0; s4 < 16; ++s4) {
                    const f32x4 av = *(const f32x4*)(ap + 4 * s4), bv = *(const f32x4*)(bp + 4 * s4);
#pragma unroll
                    for (int e = 0; e < 4; ++e) acc = __builtin_amdgcn_mfma_f32_32x32x2f32(av[e], bv[e], acc, 0, 0, 0);
                }
                bf16* op = WPQ + (size_t)l * PQ_N * DM + (size_t)(hp * 128 + 32 * nb + i32) * DM + 32 * kb + 4 * hh;
#pragma unroll
                for (int g = 0; g < 4; ++g) { u32x2 wv; wv.x = cvt_pk_bf16(acc[4 * g], acc[4 * g + 1]); wv.y = cvt_pk_bf16(acc[4 * g + 2], acc[4 * g + 3]); *(u32x2*)(op + 8 * g) = wv; }
            }
            else if (it < T6) {
                const int r = it - T5; const float* src = (r < 2048 ? peer_u : peer_v) + (size_t)(r & 2047) * 16384; bf16* dst = (r < 2048 ? UB : VB) + (size_t)(r & 2047) * 16384;
#pragma unroll 4
                for (int i = 0; i < 32; ++i) { const f32x4 v0 = *(const f32x4*)(src + i * 512 + lane * 8), v1 = *(const f32x4*)(src + i * 512 + lane * 8 + 4);
                    u32x4 o; o.x = cvt_pk_bf16(v0.x, v0.y); o.y = cvt_pk_bf16(v0.z, v0.w); o.z = cvt_pk_bf16(v1.x, v1.y); o.w = cvt_pk_bf16(v1.z, v1.w); *(u32x4*)(dst + i * 512 + lane * 8) = o; }
            }
            else {
                const int idx = (it - T6) * 64 + lane;
                if (idx < 1024) { const int pos = idx >> 4, i = idx & 15; const float ang = (float)pos * powf(10000.f, -(float)i / 16.f); ROPE[idx] = cosf(ang); ROPE[1024 + idx] = sinf(ang); }
                else { const int j = idx - 1024, pos = j >> 3, i = j & 7; const float ang = (float)pos * powf(10000.f, -(float)i / 8.f); ROPE[2048 + j] = cosf(ang); ROPE[2560 + j] = sinf(ang); }
            }
        }
    }
    SEAM(0);
    if (IN(1)) norm_mod_rows(NROW, x_in, ctx_in, norm1_g, MOD, 0, 1024, ACT1, gw, ngw, lane);
    SEAM(1);
    if (IN(2)) { pg8::Gemm g{ACT1, WIN0, NROW, AB_IN, 1024, 1024, 1024}; pg8::StaticOrder S; S.init(NROW, AB_IN, G, bx); EpiRope<0> E{Z, AB_IN, ROPE};
        pg8::gemm_phase<EpiRope<0>, pg8::StaticOrder>(lds, g, S, E); }
    SEAM(2);
    if (IN(3)) attn_l0_phase(lds, Z, ACT2, na_rpb, swa_sink, vcu, G);
    SEAM(3);
    if (IN(4)) { pg8::Gemm g{ACT2, WOUT, NROW, DM, 1024, 1024, 1024}; pg8::StaticOrder S; S.init(NROW, DM, G, bx); EpiResid E{x_in, ctx_in, out, CTXRES, MOD + 2048};
        pg8::gemm_phase<EpiResid, pg8::StaticOrder>(lds, g, S, E); }
    SEAM(4);
    if (IN(5)) norm_mod_rows(NROW, out, CTXRES, norm2_g, MOD, 3072, 4096, ACT1, gw, ngw, lane);
    SEAM(5);
    if (IN(6)) { pg8::Gemm g{ACT1, WPQ, NROW, PQ_N, 1024, 1024, 1024}; pg8::StaticOrder S; S.init(NROW, PQ_N, G, bx); EpiBf16 E{Z, PQ_N, nullptr, 0};
        pg8::gemm_phase<EpiBf16, pg8::StaticOrder>(lds, g, S, E); }
    SEAM(6);
    if (IN(7)) peer_phase<false>(lds, NROW, Z, ACT1, UB, VB, out, CTXRES, MOD + 5120, norm1_g + DM, MOD + 17 * 6144, ACT2, vcu, G);
    SEAM(7);
    if (IN(8)) { pg8::Gemm g{ACT2, WIN1, NROW, CD_PAD, 1024, 1024, 1024}; pg8::StaticOrder S; S.init(NROW, CD_PAD, G, bx); EpiRope<1> E{Z, AB_IN, ROPE};
        pg8::gemm_phase<EpiRope<1>, pg8::StaticOrder>(lds, g, S, E); }
    SEAM(8);
    if (IN(9)) {
        for (int row = gw; row < NROW; row += ngw) {
            const bf16* zr = Z + (size_t)row * AB_IN; const u32x2 qa = *(const u32x2*)(zr + lane * 4); const unsigned kb2 = *(const unsigned*)(zr + 256 + lane * 2);
            float sq = bf_lo(qa.x) * bf_lo(qa.x) + bf_hi(qa.x) * bf_hi(qa.x) + bf_lo(qa.y) * bf_lo(qa.y) + bf_hi(qa.y) * bf_hi(qa.y), sk = bf_lo(kb2) * bf_lo(kb2) + bf_hi(kb2) * bf_hi(kb2);
            sq = wave_sum(sq); sk = wave_sum(sk);
            if (lane == 0) { RSTD[(size_t)row * 2] = 1.0f / sqrtf(sq * (1.0f / 256.0f) + RMS_EPS); RSTD[(size_t)row * 2 + 1] = 1.0f / sqrtf(sk * (1.0f / 128.0f) + RMS_EPS); }
        }
    }
    SEAM(9);
    if (IN(10)) {
        { pg8::Gemm g{Z, WUQ, NLAT, 768, 256, AB_IN, 256}; pg8::StaticOrder S; S.init(NLAT, 768, G, bx); EpiRope<2> E{QM, 768, ROPE};
          pg8::gemm_phase<EpiRope<2>, pg8::StaticOrder>(lds, g, S, E); }
        __syncthreads();
        { pg8::Gemm g{Z + 256, WUKV, NROW, 1024, 128, AB_IN, 128}; pg8::StaticOrder S; S.init(NROW, 1024, G, bx); EpiBf16 E{KV, DM, RSTD, 1};
          pg8::gemm_phase<EpiBf16, pg8::StaticOrder>(lds, g, S, E); }
    }
    SEAM(10);
    if (IN(11)) attn_l1_phase(lds, Z, QM, KV, ACT1, diff_lambda, subln_g, RSTD, vcu, G);
    SEAM(11);
    if (IN(12)) { pg8::Gemm g{ACT1, WOUT + (size_t)DM * DM, NLAT, DM, 1024, 1024, 1024}; pg8::StaticOrder S; S.init(NLAT, DM, G, bx); EpiResid E{out, CTXRES, out, CTXRES, MOD + 17 * 6144 + 2048};
        pg8::gemm_phase<EpiResid, pg8::StaticOrder>(lds, g, S, E); }
    SEAM(12);
    if (IN(13)) norm_mod_rows(NLAT, out, CTXRES, norm2_g + DM, MOD + 17 * 6144, 3072, 4096, ACT2, gw, ngw, lane);
    SEAM(13);
    if (IN(14)) { pg8::Gemm g{ACT2, WPQ + (size_t)PQ_N * DM, NLAT, PQ_N, 1024, 1024, 1024}; pg8::StaticOrder S; S.init(NLAT, PQ_N, G, bx); EpiBf16 E{Z, PQ_N, nullptr, 0};
        pg8::gemm_phase<EpiBf16, pg8::StaticOrder>(lds, g, S, E); }
    SEAM(14);
    if (IN(15)) peer_phase<true>(lds, NLAT, Z, ACT2, UB + (size_t)NEXP * DM, VB + (size_t)NEXP * DM, out, CTXRES, MOD + 17 * 6144 + 5120, final_g, MOD, ACT1, vcu, G);
#if STOP_AFTER < 15
    if (lo <= 16 && 16 < hi) {
        for (int row = gw; row < NLAT; row += ngw) {
            f32x4* xr = (f32x4*)(out + (size_t)row * DM) + lane; f32x4 v[4]; float s = 0.f;
#pragma unroll
            for (int j = 0; j < 4; ++j) { v[j] = xr[64 * j]; s += (v[j].x * v[j].x + v[j].y * v[j].y) + (v[j].z * v[j].z + v[j].w * v[j].w); }
            const float rs = 1.0f / sqrtf(wave_sum(s) * (1.0f / DM) + RMS_EPS);
#pragma unroll
            for (int j = 0; j < 4; ++j) xr[64 * j] = v[j] * rs * ((const f32x4*)final_g)[lane + 64 * j];
        }
    }
#endif
#undef IN
#undef SEAM
}

#if defined(DEBUG_CHECK)
constexpr size_t WS_DBG = 980 * MiB;
__device__ __forceinline__ float bf2f(bf16 v) { return __uint_as_float((unsigned)v << 16); }
__device__ __forceinline__ float wave_max(float v) {
#pragma unroll
    for (int o = 1; o < 64; o <<= 1) v = fmaxf(v, __shfl_xor(v, o));
    return v;
}
__device__ __forceinline__ void wave_argmax(float& v, int& i) {
#pragma unroll
    for (int o = 1; o < 64; o <<= 1) { const float ov = __shfl_xor(v, o); const int oi = __shfl_xor(i, o); if (ov > v || (ov == v && oi < i)) { v = ov; i = oi; } }
}
__global__ void __launch_bounds__(64) dbg_check(Args a, int check) {
    __shared__ float sh[4096]; __shared__ float sv[16][16]; __shared__ int si[16][16];
    const int b = blockIdx.x, lane = threadIdx.x;
    unsigned char* ws = a.ws; float* DBG = (float*)(ws + WS_DBG);
    const float* MOD = (const float*)(ws + WS_MOD);
    const bf16* ACT1 = (const bf16*)(ws + WS_ACT1); const bf16* ACT2 = (const bf16*)(ws + WS_ACT2); const bf16* Z = (const bf16*)(ws + WS_Z);
    const float* FDBG = (const float*)(ws + WS_QM);
    float err = 0.f;
    if (check == 8 || check == 9) return;
    if (check == 1) {
        const int l = b & 1, r = (b >> 1) % 17, n = (b * 97) % 6144; float s = 0.f;
        for (int k = lane; k < 1024; k += 64) { const float cv = r < 16 ? a.in[1][r * 1024 + k] : a.in[3][k]; s += cv / (1.f + expf(-cv)) * a.in[4][((size_t)l * 1024 + k) * 6144 + n]; }
        s = wave_sum(s) + a.in[5][l * 6144 + n]; const float got = MOD[((size_t)l * 17 + r) * 6144 + n]; err = fabsf(got - s) / (fabsf(s) + 0.05f);
    } else if (check == 2) {
        const int row = (b * 1031 + 7) % NROW; const bool lat = row < NLAT; const int br = lat ? row >> 12 : 16;
        const float* xr = lat ? a.in[0] + (size_t)row * DM : a.in[2] + (size_t)(row - NLAT) * DM; float ss = 0.f;
        for (int k = lane; k < 1024; k += 64) ss += xr[k] * xr[k];
        ss = wave_sum(ss); const float rs = 1.f / sqrtf(ss / 1024.f + RMS_EPS); float md = 0.f, mr = 0.f;
        for (int k = lane; k < 1024; k += 64) { const float ref = xr[k] * rs * a.in[6][k] * (1.f + MOD[(size_t)br * 6144 + 1024 + k]) + MOD[(size_t)br * 6144 + k]; md = fmaxf(md, fabsf(ref - bf2f(ACT1[(size_t)row * DM + k]))); mr = fmaxf(mr, fabsf(ref)); }
        err = wave_max(md) / wave_max(mr);
    } else if (check == 3) {
        const int row = (b * 1031 + 7) % NROW; const bool lat = row < NLAT; const int t = row & 4095; float md = 0.f, mr = 0.f;
        for (int j = 0; j < 24; ++j) {
            const int col = (b * 37 + j * 149) % AB_IN; const bool rope = lat && col >= 1536 && col < 2176; const int d = col & 63, first = (d & 31) < 16, pc = rope ? (first ? col + 16 : col - 16) : col;
            float s0 = 0.f, s1 = 0.f;
            for (int k = lane; k < 1024; k += 64) { const float hv = bf2f(ACT1[(size_t)row * DM + k]); s0 += hv * a.in[13][(size_t)k * AB_IN + col]; s1 += hv * a.in[13][(size_t)k * AB_IN + pc]; }
            s0 = wave_sum(s0); s1 = wave_sum(s1); float ref = s0;
            if (rope) { const int pos = d < 32 ? t >> 6 : t & 63, i = d & 15; const float ang = (float)pos * powf(10000.f, -(float)i / 16.f), c = cosf(ang), s = sinf(ang); ref = first ? s0 * c - s1 * s : s1 * s + s0 * c; }
            md = fmaxf(md, fabsf(ref - bf2f(Z[(size_t)row * AB_IN + col]))); mr = fmaxf(mr, fabsf(ref));
        }
        err = md / fmaxf(mr, 0.5f);
    } else if (check == 4) {
        const int hs = b & 15; const int row = (b < 48) ? (((b * 2657 + 11) % NLAT)) : (NLAT + (b * 613) % NCTX); const bool lat = row < NLAT; const int bb = lat ? row >> 12 : (row - NLAT) >> 8, t = row & 4095;
        const int qcol = hs < 8 ? hs * 64 : 1536 + (hs - 8) * 64, kcol = hs < 8 ? 512 + hs * 64 : 2048 + ((hs - 8) >> 2) * 64, vcol = hs < 8 ? 1024 + hs * 64 : 2176 + ((hs - 8) >> 2) * 64;
        const bf16* q = Z + (size_t)row * AB_IN + qcol;
        const int qr = t >> 6, qc = t & 63;
        float* lg = sh; int nk = 0;
        int* kr = (int*)(sh + 1024);
        if (lane == 0) {
            if (lat && hs < 8) { const int r0 = min(max(qr - 4, 0), 56), cs = min(max(qc - 8, 0), 48);
                for (int r = r0; r < r0 + 8; ++r) for (int c = cs; c < cs + 16; ++c) kr[nk++] = bb * 4096 + r * 64 + c; }
            else if (lat) { for (int p = max(t - 128, 0); p <= min(t + 128, 4095); ++p) kr[nk++] = bb * 4096 + p; }
            for (int c = 0; c < 256; ++c) kr[nk++] = NLAT + bb * 256 + c;
            ((int*)sh)[3000] = nk;
        }
        __syncthreads(); nk = ((int*)sh)[3000];
        float mx = -1e30f;
        for (int k = lane; k < nk; k += 64) { const bf16* kp = Z + (size_t)kr[k] * AB_IN + kcol; float s = 0.f; for (int d = 0; d < 64; ++d) s += bf2f(q[d]) * bf2f(kp[d]); s *= 0.125f;
            if (lat && hs < 8 && kr[k] < NLAT) { const int kt = kr[k] & 4095, r = kt >> 6, c = kt & 63; s += a.in[14][hs * 465 + (r - qr + 7) * 31 + min(max(c - qc + 15, 0), 30)]; }
            lg[k] = s; mx = fmaxf(mx, s); }
        if (hs >= 8) mx = fmaxf(mx, a.in[15][hs - 8]);
        mx = wave_max(mx); __syncthreads(); float den = 0.f;
        for (int k = lane; k < nk; k += 64) { lg[k] = expf(lg[k] - mx); den += lg[k]; }
        den = wave_sum(den); if (hs >= 8) den += expf(a.in[15][hs - 8] - mx);
        __syncthreads();
        float o = 0.f; for (int k = 0; k < nk; ++k) o += lg[k] * bf2f(Z[(size_t)kr[k] * AB_IN + vcol + lane]);
        o /= den; const float got = bf2f(ACT2[(size_t)row * DM + (hs < 8 ? hs * 64 : 512 + (hs - 8) * 64) + lane]);
        err = wave_max(fabsf(got - o)) / fmaxf(wave_max(fabsf(o)), 0.02f);
    } else if (check == 5) {
        const int row = (b * 1031 + 7) % NROW; const bool lat = row < NLAT; const int br = lat ? row >> 12 : 16; float md = 0.f;
        for (int j = 0; j < 16; ++j) { const int col = (b * 37 + j * 149) % DM; float s = 0.f;
            for (int k = lane; k < 1024; k += 64) s += bf2f(ACT2[(size_t)row * DM + k]) * a.in[8][(size_t)k * DM + col];
            s = wave_sum(s); const float base = lat ? a.in[0][(size_t)row * DM + col] : a.in[2][(size_t)(row - NLAT) * DM + col];
            const float ref = base + MOD[(size_t)br * 6144 + 2048 + col] * s, got = lat ? a.out[(size_t)row * DM + col] : ((const float*)(ws + WS_CTXRES))[(size_t)(row - NLAT) * DM + col];
            md = fmaxf(md, fabsf(ref - got) / fmaxf(fabsf(MOD[(size_t)br * 6144 + 2048 + col] * s), 0.02f)); }
        err = md;
    } else if (check == 6) {
        const int row = (b * 1031 + 7) % NROW, hp = b & 15; const bf16* h2 = ACT1 + (size_t)row * DM;
        for (int dd = 0; dd < 2; ++dd) { const int d = lane + 64 * dd; float s = 0.f; for (int k = 0; k < 1024; ++k) s += bf2f(h2[k]) * a.in[9][(size_t)k * PQ_N + hp * 128 + d]; sh[d] = s; }
        __syncthreads(); float md = 0.f, mr = 0.f;
        for (int nn = 0; nn < 2; ++nn) { const int n = lane + 64 * nn; float s = 0.f; for (int d = 0; d < 128; ++d) s += sh[d] * a.in[10][((size_t)(hp & 1) * 128 + n) * 128 + d];
            md = fmaxf(md, fabsf(s - bf2f(Z[(size_t)row * PQ_N + hp * 128 + n]))); mr = fmaxf(mr, fabsf(s)); }
        err = wave_max(md) / wave_max(mr);
    } else if (check == 7) {
        const int row = (b * 31 + 3) % 2048; const bf16* h2 = ACT1 + (size_t)row * DM;
        for (int hp = 0; hp < 16; ++hp) {
            float v0 = bf2f(Z[(size_t)row * PQ_N + hp * 128 + lane]), v1 = bf2f(Z[(size_t)row * PQ_N + hp * 128 + 64 + lane]);
            for (int it = 0; it < 16; ++it) { float v = v0; int i = lane; if (v1 > v0) { v = v1; i = lane + 64; } wave_argmax(v, i); if (lane == 0) { sv[hp][it] = v; si[hp][it] = i; } if (i == lane) v0 = -3e38f; if (i == lane + 64) v1 = -3e38f; }
        }
        __syncthreads();
        float f[16]; for (int m = 0; m < 16; ++m) f[m] = 0.f;
        for (int h = 0; h < 8; ++h) {
            float cv[4]; for (int r = 0; r < 4; ++r) { const int c = lane * 4 + r; cv[r] = sv[2 * h][c >> 4] + sv[2 * h + 1][c & 15]; }
            float fv[16]; int fe[16];
            for (int it = 0; it < 16; ++it) { float v = cv[0]; int i = lane * 4; for (int r = 1; r < 4; ++r) if (cv[r] > v) { v = cv[r]; i = lane * 4 + r; } wave_argmax(v, i); fv[it] = v; fe[it] = si[2 * h][i >> 4] * 128 + si[2 * h + 1][i & 15]; if ((i >> 2) == lane) cv[i & 3] = -3e38f; }
            float den = 0.f; for (int it = 0; it < 16; ++it) den += expf(fv[it] - fv[0]);
            const float* sd = FDBG + (size_t)2048 * DM + (size_t)row * 384;
            if (h == 0 && lane == 0) { sh[4000] = 0.f; sh[4001] = 0.f; }
            for (int it = 0; it < 16; ++it) { const int e = fe[it]; float s = 0.f; for (int k = lane; k < 1024; k += 64) s += a.in[11][(size_t)e * DM + k] * bf2f(h2[k]);
                s = wave_sum(s); const float wgt = 0.5f * s * (1.f + erff(s * 0.70710678f)) * expf(fv[it] - fv[0]) / den;
                if (lane == 0) { float best = 1e9f, bw = 1e9f; for (int q = 0; q < 16; ++q) if ((int)sd[h * 16 + q] == e) { best = fabsf(sd[128 + h * 16 + q] - expf(fv[it] - fv[0]) / den); bw = fabsf(sd[256 + h * 16 + q] - wgt) / fmaxf(fabsf(wgt), 1e-3f); }
                    sh[4000] = fmaxf(sh[4000], best); sh[4001] = fmaxf(sh[4001], bw); }
                for (int m = 0; m < 16; ++m) f[m] += wgt * a.in[12][(size_t)e * DM + lane + 64 * m]; }
        }
        float md = 0.f, mr = 0.f; for (int m = 0; m < 16; ++m) { md = fmaxf(md, fabsf(f[m] - FDBG[(size_t)row * DM + lane + 64 * m])); mr = fmaxf(mr, fabsf(f[m])); }
        const float e9 = wave_max(md) / wave_max(mr);
        if (lane == 0) { DBG[9 * 64 + b] = e9; DBG[7 * 64 + b] = sh[4000]; DBG[8 * 64 + b] = sh[4001]; }
        return;
    }
    err = wave_max(err);
    if (lane == 0) DBG[check * 64 + b] = err;
}
__global__ void __launch_bounds__(256) dbg_report(Args a, unsigned mask) {
    const size_t n = (size_t)NLAT * DM; float* out = a.out;
    for (size_t i = (size_t)blockIdx.x * 256 + threadIdx.x; i < n; i += (size_t)gridDim.x * 256) out[i] = 0.f;
    if (blockIdx.x == 0 && threadIdx.x == 0) {
        const float* DBG = (const float*)(a.ws + WS_DBG); int id = 0; float e = 0.f, eall = 0.f;
        for (int c = 1; c < 32 && id == 0; ++c) if (mask >> c & 1) { float m = 0.f; for (int b = 0; b < 64; ++b) { const float v = DBG[c * 64 + b]; m = (v == v) ? fmaxf(m, v) : 1e9f; } eall = fmaxf(eall, m); if (m > 0.03f) { id = c; e = m; } }
        if (id == 0) e = eall;
        float mm = 1.f + 2.2f * (log10f(fmaxf(e, 1e-4f)) + 4.f); mm = fminf(fmaxf(mm, 1.f), 9.8f);
        out[0] = mm * powf(10.f, 3.f + (float)id);
    }
}
#endif
extern "C" void kernel_launch(void* const* d_in, const int* in_sizes, int n_in, void* d_out, int out_size, void* d_ws, size_t ws_size, hipStream_t stream) {
    static int grid = 0;
    if (grid == 0) {
        if (n_in != 24 || out_size != NLAT * DM || ws_size < WS_END) { fprintf(stderr, "kernel_launch: unexpected shapes (n_in %d, out %d, ws %zu)\n", n_in, out_size, ws_size); grid = -1; return; }
        int dev = 0, cus = 0, per_cu = 0;
        if (hipGetDevice(&dev) != hipSuccess || hipDeviceGetAttribute(&cus, hipDeviceAttributeMultiprocessorCount, dev) != hipSuccess) { grid = -1; return; }
        if (hipFuncSetAttribute((const void*)fwd, hipFuncAttributeMaxDynamicSharedMemorySize, LDS_BYTES) != hipSuccess) { fprintf(stderr, "kernel_launch: hipFuncSetAttribute failed\n"); grid = -1; return; }
        if (hipOccupancyMaxActiveBlocksPerMultiprocessor(&per_cu, (const void*)fwd, NTHREADS, LDS_BYTES) != hipSuccess || per_cu < 1) { fprintf(stderr, "kernel_launch: occupancy query says %d blocks per CU\n", per_cu); }
        (void)hipGetLastError();
        grid = cus;
    }
    if (grid < 0) return;
    (void)hipMemsetAsync((char*)d_ws + WS_CTL, 0, CTL_ZERO_BYTES, stream);
    Args a{};
    for (int i = 0; i < 24; ++i) a.in[i] = (const float*)d_in[i];
    a.out = (float*)d_out; a.ws = (unsigned char*)d_ws;
#if ONE_LAUNCH
    a.ph_lo = 0; a.ph_hi = 16;
    hipLaunchKernelGGL(fwd, dim3(grid), dim3(NTHREADS), LDS_BYTES, stream, a);
#else
    for (int p = 0; p <= STOP_AFTER; ++p) { a.ph_lo = p; a.ph_hi = p + 1; hipLaunchKernelGGL(fwd, dim3(grid), dim3(NTHREADS), LDS_BYTES, stream, a); }
#if defined(DEBUG_CHECK)
    for (int c = 1; c < 32; ++c) if ((unsigned)(DEBUG_CHECK) >> c & 1) hipLaunchKernelGGL(dbg_check, dim3(64), dim3(64), 0, stream, a, c);
    hipLaunchKernelGGL(dbg_report, dim3(2048), dim3(256), 0, stream, a, (unsigned)(DEBUG_CHECK));
#elif STOP_AFTER < 15
    a.ph_lo = 16; a.ph_hi = 17; hipLaunchKernelGGL(fwd, dim3(grid), dim3(NTHREADS), LDS_BYTES, stream, a);
#endif
#endif
}
```

```cpp
#include <hip/hip_runtime.h>
#include <cstdio>
#include <cstdint>

#define GAS __attribute__((address_space(1)))
#define LAS __attribute__((address_space(3)))
typedef unsigned short bf16;
typedef unsigned u32x4 __attribute__((ext_vector_type(4)));
typedef unsigned u32x2 __attribute__((ext_vector_type(2)));
typedef float f32x4 __attribute__((ext_vector_type(4)));
typedef float f32x2 __attribute__((ext_vector_type(2)));
typedef float f32x16 __attribute__((ext_vector_type(16)));
typedef short bf16x8 __attribute__((ext_vector_type(8)));
typedef short s16x4 __attribute__((ext_vector_type(4)));
typedef __bf16 bf2_t __attribute__((ext_vector_type(2)));

constexpr int NB = 16, SEQ = 4096, DM = 1024, CTX = 256, NLAT = NB * SEQ, NCTX = NB * CTX, NROW = NLAT + NCTX;
constexpr int AB_IN = 2304, CD_IN = 1952, CD_PAD = 2048, PQ_N = 2048, NEXP = 16384;
constexpr float RMS_EPS = 1e-6f, LOG2E = 1.4426950408889634f, NEGBIG = -1e30f;
constexpr float LAM_INIT1 = 0.35550906759f;

constexpr size_t MiB = 1u << 20;
constexpr size_t WS_CTL = 0, CTL_ZERO_BYTES = 1 * MiB;
constexpr size_t WS_MOD = 1 * MiB;
constexpr size_t WS_ROPE = 2 * MiB;
constexpr size_t WS_RSTD = 3 * MiB;
constexpr size_t WS_WIN0 = 4 * MiB;
constexpr size_t WS_WOUT = 9 * MiB;
constexpr size_t WS_WPQ = 13 * MiB;
constexpr size_t WS_WIN1 = 21 * MiB;
constexpr size_t WS_WUQ = 25 * MiB;
constexpr size_t WS_WUKV = 25 * MiB + 512 * 1024;
constexpr size_t WS_CTXRES = 26 * MiB;
constexpr size_t WS_U = 42 * MiB;
constexpr size_t WS_V = 106 * MiB;
constexpr size_t WS_ACT1 = 170 * MiB;
constexpr size_t WS_ACT2 = 306 * MiB;
constexpr size_t WS_Z = 442 * MiB;
constexpr size_t WS_QM = 748 * MiB;
constexpr size_t WS_KV = 844 * MiB;
constexpr size_t WS_END = 980 * MiB;
constexpr int CW_BAR = 4096;

constexpr int NWAVES = 8, NTHREADS = 512;
constexpr int LDS_BYTES = 147456;
constexpr int LDS_MISC = 135168;

__device__ __forceinline__ unsigned cvt_pk_bf16(float lo, float hi) { unsigned r; asm volatile("v_cvt_pk_bf16_f32 %0, %1, %2" : "=v"(r) : "v"(lo), "v"(hi)); return r; }
__device__ __forceinline__ float bf_lo(unsigned w) { return __uint_as_float(w << 16); }
__device__ __forceinline__ float bf_hi(unsigned w) { return __uint_as_float(w & 0xffff0000u); }
__device__ __forceinline__ float wave_sum(float v) {
#pragma unroll
    for (int o = 1; o < 64; o <<= 1) v += __shfl_xor(v, o);
    return v;
}

namespace pg8 {
constexpr int BM = 256, BK = 64, HALF = 128, HTB = HALF * BK * 2, NXCD = 8, WGM = 8;
__host__ __device__ __forceinline__ int lds_byte(int r, int c) { const int st = (r >> 4) * 2 + (c >> 5), rr = r & 15, cc = c & 31, ob = rr * 64 + cc * 2; return st * 1024 + (ob ^ (((ob >> 9) & 1) << 5)); }
__host__ __device__ __forceinline__ void stage_rc(int b, int& R, int& C) { const int st = b / 1024, sb = b % 1024, swz = sb ^ (((sb >> 9) & 1) << 5); R = (st >> 1) * 16 + swz / 64; C = (st & 1) * 32 + (swz % 64) / 2; }
__host__ __device__ __forceinline__ int perm32(int rho) { const int n = rho >> 4, i = rho & 15; return 8 * (i >> 2) + 4 * n + (i & 3); }
struct Unit { int pm, pn; };
struct Gemm { const bf16* A; const bf16* Bt; int M, N, K, lda, ldb; };
struct StaticOrder {
    int nM, nN, nwg, G, c;
    __device__ void init(int M, int N, int G_, int c_) { nM = M / BM; nN = N / BM; nwg = nM * nN; G = G_; c = c_; }
    __device__ bool next(int i, Unit& u) const {
        const long L = (long)i * G + c; if (L >= nwg) return false;
        int wgid = (int)L; { const int q = nwg / NXCD, r = nwg % NXCD, xcd = wgid % NXCD, off = wgid / NXCD; wgid = (xcd < r ? xcd * (q + 1) : r * (q + 1) + (xcd - r) * q) + off; }
        const int nig = WGM * nN, gid = wgid / nig, fm = gid * WGM, gsz = (nM - fm) < WGM ? (nM - fm) : WGM;
        u.pm = fm + ((wgid % nig) % gsz); u.pn = (wgid % nig) / gsz; return true;
    }
    __device__ __forceinline__ void a_ready(const Unit&) const {}
    __device__ __forceinline__ void done(const Unit&) const {}
};
template <class Epi, class Sched, bool ALIGN_EPI = true, bool SP2 = true>
__device__ __forceinline__ void gemm_phase(LAS unsigned char* lds, const Gemm g, const Sched& S, const Epi& E) {
    const int tid = threadIdx.x, wid = __builtin_amdgcn_readfirstlane(tid >> 6), lane = tid & 63, wr = wid >> 2, wc = wid & 3, fr = lane & 15, fq = lane >> 4;
    const int K = g.K, nt = K / BK;
    unsigned voffA[2], voffB[2];
#pragma unroll
    for (int i = 0; i < 2; ++i) { int R, C; stage_rc(tid * 16 + i * 8192, R, C); const int Rb = Epi::PERM ? ((R & ~31) + perm32(R & 31)) : R;
        voffA[i] = (unsigned)(R * g.lda + C) * 2u; voffB[i] = (unsigned)(Rb * g.ldb + C) * 2u; }
    const size_t kstep = (size_t)(BK * 2);
    const size_t hstepA = (size_t)HALF * g.lda * 2, hstepB = (size_t)HALF * g.ldb * 2;
    const size_t tstepA = 2 * hstepA, tstepB = 2 * hstepB;
    const unsigned ldsw = (unsigned)wid * 1024u;
    const int aoff = lds_byte(wr * 64 + fr, fq * 8), boff = lds_byte(wc * 32 + fr, fq * 8);
#define PG8_SA(b, h) (((b) * 2 + (h)) * HTB)
#define PG8_SB(b, h) ((4 + (b) * 2 + (h)) * HTB)
#define PG8_STAGE(bufoff, gbase, voff) do { _Pragma("unroll") for (int _i = 0; _i < 2; ++_i) \
        __builtin_amdgcn_global_load_lds((const unsigned*)((const char*)(gbase) + (voff)[_i]), (LAS unsigned*)(lds + (bufoff) + ldsw + _i * 8192), 16, 0, 0); } while (0)
#define PG8_LDA(dst, b, h) do { _Pragma("unroll") for (int m = 0; m < 4; ++m) _Pragma("unroll") for (int k = 0; k < 2; ++k) dst[m][k] = *(const LAS bf16x8*)(lds + PG8_SA(b, h) + aoff + m * 2048 + k * 1024); } while (0)
#define PG8_LDB(dst, b, h) do { _Pragma("unroll") for (int n = 0; n < 2; ++n) _Pragma("unroll") for (int k = 0; k < 2; ++k) dst[n][k] = *(const LAS bf16x8*)(lds + PG8_SB(b, h) + boff + n * 2048 + k * 1024); } while (0)
#define PG8_MMA(ai, bj, At, Bt) do { __builtin_amdgcn_s_setprio(1); _Pragma("unroll") for (int m = 0; m < 4; ++m) _Pragma("unroll") for (int n = 0; n < 2; ++n) _Pragma("unroll") for (int k = 0; k < 2; ++k) \
        acc[ai][bj][m][n] = __builtin_amdgcn_mfma_f32_16x16x32_bf16(Bt[n][k], At[m][k], acc[ai][bj][m][n], 0, 0, 0); __builtin_amdgcn_s_setprio(0); } while (0)
#define PG8_WAIT_V(n) asm volatile("s_waitcnt vmcnt(" #n ")" ::: "memory")
#define PG8_WAIT_L(n) asm volatile("s_waitcnt lgkmcnt(" #n ")" ::: "memory")
#define PG8_BAR __builtin_amdgcn_s_barrier()
#define PG8_SCHED __builtin_amdgcn_sched_barrier(0)
    Unit cur, nxt; int ui = 0;
    if (!S.next(0, cur)) return;
    f32x4 acc[2][2][4][2];
#pragma unroll
    for (int a = 0; a < 2; ++a)
#pragma unroll
        for (int b = 0; b < 2; ++b)
#pragma unroll
            for (int m = 0; m < 4; ++m)
#pragma unroll
                for (int n = 0; n < 2; ++n) acc[a][b][m][n] = (f32x4){0.f, 0.f, 0.f, 0.f};
    bf16x8 At[4][2], B0[2][2], B1[2][2];
    const char* cA = (const char*)g.A + (size_t)cur.pm * tstepA; const char* cB = (const char*)g.Bt + (size_t)cur.pn * tstepB;
    S.a_ready(cur);
    if constexpr (SP2) {
        PG8_STAGE(PG8_SB(0, 0), cB, voffB); PG8_STAGE(PG8_SB(0, 1), cB + hstepB, voffB); PG8_STAGE(PG8_SA(0, 0), cA, voffA); PG8_STAGE(PG8_SA(0, 1), cA + hstepA, voffA);
        if (wr == 1) PG8_BAR;
        PG8_WAIT_V(2); PG8_BAR;
        PG8_STAGE(PG8_SB(1, 0), cB + kstep, voffB); PG8_STAGE(PG8_SA(1, 0), cA + kstep, voffA); PG8_STAGE(PG8_SB(1, 1), cB + hstepB + kstep, voffB);
        PG8_WAIT_V(6); PG8_BAR;
    } else {
        PG8_STAGE(PG8_SB(0, 0), cB, voffB); PG8_STAGE(PG8_SA(0, 0), cA, voffA); PG8_STAGE(PG8_SB(0, 1), cB + hstepB, voffB); PG8_STAGE(PG8_SA(0, 1), cA + hstepA, voffA);
        if (wr == 1) PG8_BAR;
        PG8_WAIT_V(4); PG8_BAR;
        PG8_STAGE(PG8_SB(1, 0), cB + kstep, voffB); PG8_STAGE(PG8_SA(1, 0), cA + kstep, voffA); PG8_STAGE(PG8_SB(1, 1), cB + hstepB + kstep, voffB);
        PG8_WAIT_V(6); PG8_BAR;
    }
    for (;;) {
        const bool has_next = S.next(ui + 1, nxt);
        const char* nA = has_next ? (const char*)g.A + (size_t)nxt.pm * tstepA : cA; const char* nB = has_next ? (const char*)g.Bt + (size_t)nxt.pn * tstepB : cB;
#pragma unroll 1
        for (int t = 0; t < nt; t += 2) {
            const bool last = (t == nt - 2);
            const char* a1 = cA + (size_t)(t + 1) * kstep;
            const char* a2 = last ? nA : cA + (size_t)(t + 2) * kstep; const char* b2 = last ? nB : cB + (size_t)(t + 2) * kstep;
            const char* a3 = a2 + kstep; const char* b3 = b2 + kstep;
            if (last && has_next) S.a_ready(nxt);
            if constexpr (SP2) {
            PG8_LDB(B0, 0, 0); PG8_LDB(B1, 0, 1); PG8_SCHED; PG8_LDA(At, 0, 0); PG8_STAGE(PG8_SA(1, 1), a1 + hstepA, voffA);
            PG8_WAIT_V(8); PG8_WAIT_L(0); PG8_BAR; PG8_MMA(0, 0, At, B0); PG8_MMA(0, 1, At, B1); PG8_BAR; PG8_SCHED;
            PG8_LDA(At, 0, 1); PG8_STAGE(PG8_SB(0, 0), b2, voffB); PG8_STAGE(PG8_SB(0, 1), b2 + hstepB, voffB); PG8_STAGE(PG8_SA(0, 0), a2, voffA);
            PG8_WAIT_V(8); PG8_WAIT_L(0); PG8_BAR; PG8_MMA(1, 0, At, B0); PG8_MMA(1, 1, At, B1); PG8_BAR; PG8_SCHED;
            PG8_LDB(B0, 1, 0); PG8_LDB(B1, 1, 1); PG8_SCHED; PG8_LDA(At, 1, 0); PG8_STAGE(PG8_SA(0, 1), a2 + hstepA, voffA);
            PG8_WAIT_V(8); PG8_WAIT_L(0); PG8_BAR; PG8_MMA(0, 0, At, B0); PG8_MMA(0, 1, At, B1); PG8_BAR; PG8_SCHED;
            PG8_LDA(At, 1, 1); PG8_STAGE(PG8_SB(1, 0), b3, voffB); PG8_STAGE(PG8_SB(1, 1), b3 + hstepB, voffB); PG8_STAGE(PG8_SA(1, 0), a3, voffA);
            PG8_WAIT_V(8); PG8_WAIT_L(0); PG8_BAR; PG8_MMA(1, 0, At, B0); PG8_MMA(1, 1, At, B1); PG8_BAR; PG8_SCHED;
            } else {
            PG8_LDB(B0, 0, 0); PG8_SCHED; PG8_LDA(At, 0, 0); PG8_STAGE(PG8_SA(1, 1), a1 + hstepA, voffA);
            PG8_WAIT_L(8); PG8_BAR; PG8_WAIT_L(0); PG8_MMA(0, 0, At, B0); PG8_BAR; PG8_SCHED;
            PG8_LDB(B1, 0, 1); PG8_STAGE(PG8_SB(0, 0), b2, voffB);
            PG8_BAR; PG8_WAIT_L(0); PG8_MMA(0, 1, At, B1); PG8_BAR;
            PG8_LDA(At, 0, 1); PG8_STAGE(PG8_SA(0, 0), a2, voffA);
            PG8_BAR; PG8_WAIT_L(0); PG8_MMA(1, 0, At, B0); PG8_BAR; PG8_SCHED;
            PG8_STAGE(PG8_SB(0, 1), b2 + hstepB, voffB);
            PG8_WAIT_V(6); PG8_BAR; PG8_MMA(1, 1, At, B1); PG8_BAR;
            PG8_LDB(B0, 1, 0); PG8_SCHED; PG8_LDA(At, 1, 0); PG8_STAGE(PG8_SA(0, 1), a2 + hstepA, voffA);
            PG8_WAIT_L(8); PG8_BAR; PG8_WAIT_L(0); PG8_MMA(0, 0, At, B0); PG8_BAR; PG8_SCHED;
            PG8_LDB(B1, 1, 1); PG8_STAGE(PG8_SB(1, 0), b3, voffB);
            PG8_BAR; PG8_WAIT_L(0); PG8_MMA(0, 1, At, B1); PG8_BAR;
            PG8_LDA(At, 1, 1); PG8_STAGE(PG8_SA(1, 0), a3, voffA);
            PG8_BAR; PG8_WAIT_L(0); PG8_MMA(1, 0, At, B0); PG8_BAR; PG8_SCHED;
            PG8_STAGE(PG8_SB(1, 1), b3 + hstepB, voffB);
            PG8_WAIT_V(6); PG8_BAR; PG8_MMA(1, 1, At, B1); PG8_BAR;
            }
        }
        if constexpr (ALIGN_EPI) { if (wr == 0) PG8_BAR; }
        E(acc, cur, wr, wc, fr, fq); S.done(cur);
        if (!has_next) break;
#pragma unroll
        for (int a = 0; a < 2; ++a)
#pragma unroll
            for (int b = 0; b < 2; ++b)
#pragma unroll
                for (int m = 0; m < 4; ++m)
#pragma unroll
                    for (int n = 0; n < 2; ++n) acc[a][b][m][n] = (f32x4){0.f, 0.f, 0.f, 0.f};
        cur = nxt; cA = nA; cB = nB; ++ui;
        if constexpr (ALIGN_EPI) { if (wr == 1) PG8_BAR; }
    }
    PG8_WAIT_V(0);
    if constexpr (!ALIGN_EPI) { if (wr == 0) PG8_BAR; }
    PG8_BAR;
#undef PG8_SA
#undef PG8_SB
#undef PG8_STAGE
#undef PG8_LDA
#undef PG8_LDB
#undef PG8_MMA
#undef PG8_WAIT_V
#undef PG8_WAIT_L
#undef PG8_BAR
#undef PG8_SCHED
}
}
template <int MODE> struct EpiRope {
    static constexpr bool PERM = false;
    bf16* O; int ldc; const float* rope;
    __device__ __forceinline__ void operator()(const f32x4 (&acc)[2][2][4][2], const pg8::Unit& u, int wr, int wc, int fr, int fq) const {
        const int row0 = u.pm * 256 + wr * 64 + fr;
#pragma unroll
        for (int ai = 0; ai < 2; ++ai)
#pragma unroll
            for (int m = 0; m < 4; ++m) {
                const int row = row0 + ai * 128 + m * 16; const bool lat = row < NLAT; const int t = row & 4095, prow = t >> 6, pcol = t & 63;
                bf16* rowp = O + (size_t)row * ldc;
#pragma unroll
                for (int bj = 0; bj < 2; ++bj) {
                    const int G = 8 * u.pn + 4 * bj + wc, col = 32 * G + 4 * fq;
                    f32x4 x1 = acc[ai][bj][m][0], x2 = acc[ai][bj][m][1];
                    int kind = 0, par = 0;
                    if (MODE == 0) { kind = (G >= 48 && G < 68) ? 1 : 0; par = G & 1; }
                    if (MODE == 1) { kind = (G == 12) ? 2 : ((G >= 13 && G < 45) ? 1 : 0); par = (G + 1) & 1; }
                    if (MODE == 2) { kind = (G % 3 == 2) ? 2 : 0; }
                    if (lat && kind == 1) {
                        const int pos = par ? pcol : prow;
                        const f32x4 c = *(const f32x4*)(rope + pos * 16 + 4 * fq), s = *(const f32x4*)(rope + 1024 + pos * 16 + 4 * fq);
                        const f32x4 o1 = x1 * c - x2 * s, o2 = x1 * s + x2 * c; x1 = o1; x2 = o2;
                    } else if (lat && kind == 2) {
                        const int pos = (fq < 2) ? prow : pcol;
                        const f32x4 c = *(const f32x4*)(rope + 2048 + pos * 8 + (4 * fq & 7)), s = *(const f32x4*)(rope + 2560 + pos * 8 + (4 * fq & 7));
                        const f32x4 o1 = x1 * c - x2 * s, o2 = x1 * s + x2 * c; x1 = o1; x2 = o2;
                    }
                    u32x2 w0, w1; w0.x = cvt_pk_bf16(x1[0], x1[1]); w0.y = cvt_pk_bf16(x1[2], x1[3]); w1.x = cvt_pk_bf16(x2[0], x2[1]); w1.y = cvt_pk_bf16(x2[2], x2[3]);
                    *(u32x2*)(rowp + col) = w0; *(u32x2*)(rowp + col + 16) = w1;
                }
                __builtin_amdgcn_sched_barrier(0);
            }
    }
};
struct EpiBf16 {
    static constexpr bool PERM = true;
    bf16* O; int ldc; const float* rstd; int ridx;
    __device__ __forceinline__ void operator()(const f32x4 (&acc)[2][2][4][2], const pg8::Unit& u, int wr, int wc, int fr, int fq) const {
        const int row0 = u.pm * 256 + wr * 64 + fr, col0 = u.pn * 256 + wc * 32 + 8 * fq;
#pragma unroll
        for (int ai = 0; ai < 2; ++ai)
#pragma unroll
            for (int m = 0; m < 4; ++m) {
                const int row = row0 + ai * 128 + m * 16; float rs = 1.f; if (rstd) rs = rstd[(size_t)row * 2 + ridx];
                bf16* rowp = O + (size_t)row * ldc + col0;
#pragma unroll
                for (int bj = 0; bj < 2; ++bj) { const f32x4 v0 = acc[ai][bj][m][0] * rs, v1 = acc[ai][bj][m][1] * rs;
                    u32x4 w; w.x = cvt_pk_bf16(v0[0], v0[1]); w.y = cvt_pk_bf16(v0[2], v0[3]); w.z = cvt_pk_bf16(v1[0], v1[1]); w.w = cvt_pk_bf16(v1[2], v1[3]);
                    *(u32x4*)(rowp + bj * 128) = w; }
            }
    }
};
struct EpiResid {
    static constexpr bool PERM = true;
    const float* base_lat; const float* base_ctx; float* out_lat; float* out_ctx; const float* gate;
    __device__ __forceinline__ void operator()(const f32x4 (&acc)[2][2][4][2], const pg8::Unit& u, int wr, int wc, int fr, int fq) const {
        const int row0 = u.pm * 256 + wr * 64 + fr, col0 = u.pn * 256 + wc * 32 + 8 * fq;
#pragma unroll
        for (int ai = 0; ai < 2; ++ai)
#pragma unroll
            for (int m = 0; m < 4; ++m) {
                const int row = row0 + ai * 128 + m * 16; const bool lat = row < NLAT; const int rr = lat ? row : row - NLAT, br = lat ? (row >> 12) : 16;
                const float* bp = (lat ? base_lat : base_ctx) + (size_t)rr * DM + col0; float* op = (lat ? out_lat : out_ctx) + (size_t)rr * DM + col0;
                const float* gp = gate + (size_t)br * 6144 + col0;
#pragma unroll
                for (int bj = 0; bj < 2; ++bj) {
                    const f32x4 g0 = *(const f32x4*)(gp + bj * 128), g1 = *(const f32x4*)(gp + bj * 128 + 4);
                    const f32x4 b0 = *(const f32x4*)(bp + bj * 128), b1 = *(const f32x4*)(bp + bj * 128 + 4);
                    *(f32x4*)(op + bj * 128) = b0 + g0 * acc[ai][bj][m][0]; *(f32x4*)(op + bj * 128 + 4) = b1 + g1 * acc[ai][bj][m][1];
                }
            }
    }
};
__device__ __forceinline__ int crow(int r, int h) { return (r & 3) + 8 * (r >> 2) + 4 * h; }
__device__ __forceinline__ float fexp2(float x) { return __builtin_amdgcn_exp2f(x); }

template <class P>
__device__ __forceinline__ void attn_tile(const LAS unsigned char* Kt, const LAS unsigned char* Vt, const bf16x8 (&qf)[P::DK / 16], f32x16 (&O)[P::DV / 32], float& m, float& l, int lane, const P& p, int t) {
    constexpr int DK = P::DK, DV = P::DV, KRS = DK * 2 + 16, NDB = DV / 32;
    const int r32 = lane & 31, h = lane >> 5;
    f32x16 s0, s1;
#pragma unroll
    for (int i = 0; i < 16; ++i) { s0[i] = 0.f; s1[i] = 0.f; }
#pragma unroll
    for (int s = 0; s < DK / 16; ++s) {
        const bf16x8 k0 = *(const LAS bf16x8*)(Kt + r32 * KRS + (16 * s + 8 * h) * 2);
        const bf16x8 k1 = *(const LAS bf16x8*)(Kt + (32 + r32) * KRS + (16 * s + 8 * h) * 2);
        s0 = __builtin_amdgcn_mfma_f32_32x32x16_bf16(k0, qf[s], s0, 0, 0, 0);
        s1 = __builtin_amdgcn_mfma_f32_32x32x16_bf16(k1, qf[s], s1, 0, 0, 0);
    }
    p.mask(t, s0, s1, lane);
    float mx = fmaxf(s0[0], s1[0]);
#pragma unroll
    for (int i = 1; i < 16; ++i) mx = fmaxf(mx, fmaxf(s0[i], s1[i]));
    mx = fmaxf(mx, __shfl_xor(mx, 32));
    const float mn = fmaxf(m, mx), alpha = fexp2(m - mn); m = mn;
    float ps = 0.f;
#pragma unroll
    for (int i = 0; i < 16; ++i) { const float a = (s0[i] > -1e29f) ? fexp2(s0[i] - mn) : 0.f, b = (s1[i] > -1e29f) ? fexp2(s1[i] - mn) : 0.f; s0[i] = a; s1[i] = b; ps += a + b; }
    l = l * alpha + ps;
#pragma unroll
    for (int db = 0; db < NDB; ++db) O[db] = O[db] * alpha;
    bf16x8 pf[2][2];
#pragma unroll
    for (int s2 = 0; s2 < 2; ++s2) {
        u32x4 w0, w1;
        w0.x = cvt_pk_bf16(s0[8 * s2 + 0], s0[8 * s2 + 1]); w0.y = cvt_pk_bf16(s0[8 * s2 + 2], s0[8 * s2 + 3]); w0.z = cvt_pk_bf16(s0[8 * s2 + 4], s0[8 * s2 + 5]); w0.w = cvt_pk_bf16(s0[8 * s2 + 6], s0[8 * s2 + 7]);
        w1.x = cvt_pk_bf16(s1[8 * s2 + 0], s1[8 * s2 + 1]); w1.y = cvt_pk_bf16(s1[8 * s2 + 2], s1[8 * s2 + 3]); w1.z = cvt_pk_bf16(s1[8 * s2 + 4], s1[8 * s2 + 5]); w1.w = cvt_pk_bf16(s1[8 * s2 + 6], s1[8 * s2 + 7]);
        pf[0][s2] = __builtin_bit_cast(bf16x8, w0); pf[1][s2] = __builtin_bit_cast(bf16x8, w1);
    }
    const int lanebase = ((lane >> 5) * 4 + ((lane >> 2) & 3)) * 64 + ((lane >> 4) & 1) * 32 + (lane & 3) * 8;
#pragma unroll
    for (int db = 0; db < NDB; ++db)
#pragma unroll
        for (int b = 0; b < 2; ++b)
#pragma unroll
            for (int s2 = 0; s2 < 2; ++s2) {
                const s16x4 v0 = __builtin_amdgcn_ds_read_tr16_b64_v4i16((LAS s16x4*)(Vt + ((4 * b + 2 * s2 + 0) * NDB + db) * 512 + lanebase));
                const s16x4 v1 = __builtin_amdgcn_ds_read_tr16_b64_v4i16((LAS s16x4*)(Vt + ((4 * b + 2 * s2 + 1) * NDB + db) * 512 + lanebase));
                const bf16x8 vf = {v0[0], v0[1], v0[2], v0[3], v1[0], v1[1], v1[2], v1[3]};
                O[db] = __builtin_amdgcn_mfma_f32_32x32x16_bf16(vf, pf[b][s2], O[db], 0, 0, 0);
            }
}

template <class P>
__device__ __forceinline__ void attn_unit(LAS unsigned char* lds, const P& p, const bf16* qptr, float m, float l, f32x16 (&O)[P::DV / 32]) {
    constexpr int DK = P::DK, DV = P::DV, KRS = DK * 2 + 16, KBYTES = 64 * KRS, VBYTES = 64 * DV * 2, NDB = DV / 32, NV = DV / 64, VCH = DV / 8;
    const int tid = threadIdx.x, lane = tid & 63, h = lane >> 5;
    bf16x8 qf[DK / 16];
#pragma unroll
    for (int s = 0; s < DK / 16; ++s) qf[s] = *(const bf16x8*)(qptr + 16 * s + 8 * h);
#pragma unroll
    for (int db = 0; db < NDB; ++db)
#pragma unroll
        for (int i = 0; i < 16; ++i) O[db][i] = 0.f;
    const int kkey = tid >> 3, kch = tid & 7, k2key = tid >> 2, k2ch = tid & 3;
    u32x4 kr, kr2 = (u32x4){0u, 0u, 0u, 0u}, vr[NV];
#define AT_LOAD(t_) do { const bf16 *kp_, *k2p_, *vp_; p.src((t_), kp_, k2p_, vp_); kr = *(const u32x4*)(kp_ + (size_t)kkey * p.ldk + kch * 8); \
        if (DK == 96) { if (tid < 256) kr2 = *(const u32x4*)(k2p_ + (size_t)k2key * p.ldk2 + k2ch * 8); } \
        _Pragma("unroll") for (int i_ = 0; i_ < NV; ++i_) { const int c_ = tid + 512 * i_, key_ = c_ / VCH, ch_ = c_ % VCH; vr[i_] = *(const u32x4*)(vp_ + (size_t)key_ * p.ldv + ch_ * 8); } } while (0)
#define AT_STORE(buf_) do { LAS unsigned char* kb_ = lds + (buf_) * KBYTES; LAS unsigned char* vb_ = lds + 2 * KBYTES + (buf_) * VBYTES; \
        *(LAS u32x4*)(kb_ + kkey * KRS + kch * 16) = kr; if (DK == 96) { if (tid < 256) *(LAS u32x4*)(kb_ + k2key * KRS + 128 + k2ch * 16) = kr2; } \
        _Pragma("unroll") for (int i_ = 0; i_ < NV; ++i_) { const int c_ = tid + 512 * i_, key_ = c_ / VCH, ch_ = c_ % VCH; \
            *(LAS u32x4*)(vb_ + ((key_ >> 3) * NDB + (ch_ >> 2)) * 512 + (key_ & 7) * 64 + (ch_ & 3) * 16) = vr[i_]; } } while (0)
    const int nt = p.nt;
    AT_LOAD(0); AT_STORE(0); __syncthreads();
    for (int t = 0; t < nt; ++t) {
        if (t + 1 < nt) AT_LOAD(t + 1);
        if (p.active(t)) attn_tile<P>(lds + (t & 1) * KBYTES, lds + 2 * KBYTES + (t & 1) * VBYTES, qf, O, m, l, lane, p, t);
        if (t + 1 < nt) AT_STORE((t + 1) & 1);
        __syncthreads();
    }
#undef AT_LOAD
#undef AT_STORE
    const float lt = l + __shfl_xor(l, 32), inv = lt > 0.f ? 1.f / lt : 0.f;
#pragma unroll
    for (int db = 0; db < NDB; ++db) O[db] = O[db] * inv;
}
template <int NDB> __device__ __forceinline__ void store_o(bf16* orow, const f32x16 (&O)[NDB], int h) {
#pragma unroll
    for (int db = 0; db < NDB; ++db)
#pragma unroll
        for (int g = 0; g < 4; ++g) { u32x2 w; w.x = cvt_pk_bf16(O[db][4 * g], O[db][4 * g + 1]); w.y = cvt_pk_bf16(O[db][4 * g + 2], O[db][4 * g + 3]); *(u32x2*)(orow + 32 * db + 8 * g + 4 * h) = w; }
}

template <int DK_, int DV_> struct PolPlain {
    static constexpr int DK = DK_, DV = DV_;
    const bf16 *kb, *k2b, *vb; int ldk, ldk2, ldv; int lat0, ctx0, nlat, nt; float c2;
    __device__ __forceinline__ void src(int t, const bf16*& k, const bf16*& k2, const bf16*& v) const {
        const int row = (t < nlat) ? lat0 + 64 * t : ctx0 + 64 * (t - nlat);
        k = kb + (size_t)row * ldk; k2 = k2b + (size_t)row * ldk2; v = vb + (size_t)row * ldv; }
    __device__ __forceinline__ bool active(int) const { return true; }
    __device__ __forceinline__ void mask(int, f32x16& s0, f32x16& s1, int) const { s0 = s0 * c2; s1 = s1 * c2; }
};
struct PolNA {
    static constexpr int DK = 64, DV = 64;
    const bf16 *kb, *k2b, *vb; int ldk, ldk2, ldv; int lat0, ctx0, lo, nt; int qrow, r0, qc, cs; const LAS float* rpb;
    __device__ __forceinline__ void src(int t, const bf16*& k, const bf16*& k2, const bf16*& v) const {
        const int row = (t < 4) ? ctx0 + 64 * t : lat0 + 64 * (lo + t - 4);
        k = kb + (size_t)row * ldk; k2 = k; v = vb + (size_t)row * ldv; }
    __device__ __forceinline__ bool active(int t) const { const int kr = lo + t - 4; return t < 4 || (kr >= r0 && kr < r0 + 8); }
    __device__ __forceinline__ void mask(int t, f32x16& s0, f32x16& s1, int lane) const {
        const float c2 = 0.125f * LOG2E;
        if (t < 4) { s0 = s0 * c2; s1 = s1 * c2; return; }
        const int h = lane >> 5, kr = lo + t - 4; const LAS float* rb = rpb + (kr - qrow + 7) * 31;
#pragma unroll
        for (int i = 0; i < 16; ++i) {
            const int kc0 = crow(i, h), kc1 = 32 + kc0;
            const int d0 = min(max(kc0 - qc + 15, 0), 30), d1 = min(max(kc1 - qc + 15, 0), 30);
            const bool v0 = (kc0 >= cs) && (kc0 < cs + 16), v1 = (kc1 >= cs) && (kc1 < cs + 16);
            s0[i] = v0 ? s0[i] * c2 + rb[d0] : NEGBIG; s1[i] = v1 ? s1[i] * c2 + rb[d1] : NEGBIG;
        }
    }
};
struct PolSWA {
    static constexpr int DK = 64, DV = 64;
    const bf16 *kb, *k2b, *vb; int ldk, ldk2, ldv; int lat0, ctx0, pos0, nt; int qp;
    __device__ __forceinline__ void src(int t, const bf16*& k, const bf16*& k2, const bf16*& v) const {
        const int row = (t < 4) ? ctx0 + 64 * t : lat0 + pos0 + 64 * (t - 4);
        k = kb + (size_t)row * ldk; k2 = k; v = vb + (size_t)row * ldv; }
    __device__ __forceinline__ bool active(int) const { return true; }
    __device__ __forceinline__ void mask(int t, f32x16& s0, f32x16& s1, int lane) const {
        const float c2 = 0.125f * LOG2E;
        if (t < 4) { s0 = s0 * c2; s1 = s1 * c2; return; }
        const int h = lane >> 5, kp0 = pos0 + 64 * (t - 4) - qp;
#pragma unroll
        for (int i = 0; i < 16; ++i) {
            const int d0 = kp0 + crow(i, h), d1 = d0 + 32;
            s0[i] = (d0 >= -128 && d0 <= 128) ? s0[i] * c2 : NEGBIG; s1[i] = (d1 >= -128 && d1 <= 128) ? s1[i] * c2 : NEGBIG;
        }
    }
};
constexpr int PEER_LST = 0, PEER_SEL = 65536, PEER_WG = 98304;
#define TOPK_INSERT(L, v_) do { unsigned v__ = (v_); _Pragma("unroll") for (int q_ = 0; q_ < 16; ++q_) { const unsigned hi_ = max(L[q_], v__); v__ = min(L[q_], v__); L[q_] = hi_; } } while (0)

template <bool LAST>
__device__ __forceinline__ void peer_phase(LAS unsigned char* lds, int nrows, const bf16* SC, const bf16* X, const bf16* U, const bf16* V,
                                           float* res_lat, float* res_ctx, const float* g2mod  , const float* ngain, const float* nmod  , bf16* Hn, int vcu, int G) {
    const int tid = threadIdx.x, lane = tid & 63, wave = __builtin_amdgcn_readfirstlane(tid >> 6);
    LAS u32x2* LST = (LAS u32x2*)(lds + PEER_LST); LAS u32x2* SEL = (LAS u32x2*)(lds + PEER_SEL); LAS float* WG = (LAS float*)(lds + PEER_WG) + wave * 128;
    const int ngroups = nrows / 32;
    for (int grp = vcu; grp < ngroups; grp += G) {
        const int row0 = grp * 32;
        {
            const int tt = tid >> 4, hp = tid & 15, pp = tid & 1;
            const u32x4* sp = (const u32x4*)(SC + (size_t)(row0 + tt) * PQ_N + hp * 128);
            unsigned L[16];
#pragma unroll
            for (int q = 0; q < 16; ++q) L[q] = 0u;
            for (int cc = 0; cc < 4; ++cc) {
                u32x4 w[4];
#pragma unroll
                for (int c = 0; c < 4; ++c) w[c] = sp[cc * 4 + c];
#pragma unroll
                for (int c = 0; c < 4; ++c)
#pragma unroll
                    for (int d = 0; d < 4; ++d)
#pragma unroll
                        for (int hf = 0; hf < 2; ++hf) {
                            const unsigned b = hf ? (w[c][d] >> 16) : (w[c][d] & 0xffffu);
                            const unsigned s = b ^ ((b & 0x8000u) ? 0xffffu : 0x8000u);
                            const unsigned n = (unsigned)(cc * 32 + c * 8 + d * 2 + hf);
                            TOPK_INSERT(L, (s << 16) | (127u - n));
                        }
            }
            float sv[16], pv[16];
#pragma unroll
            for (int q = 0; q < 16; ++q) {
                const unsigned s = L[q] >> 16, b = s ^ ((s & 0x8000u) ? 0x8000u : 0xffffu);
                sv[q] = __uint_as_float(b << 16); const unsigned si = 127u - (L[q] & 0xffffu);
                LST[tid * 16 + q] = (u32x2){b << 16, si};
                pv[q] = __shfl_xor(sv[q], 1);
            }
            unsigned M[16];
#pragma unroll
            for (int q = 0; q < 16; ++q) M[q] = 0u;
#pragma unroll
            for (int i = 0; i < 16; ++i)
#pragma unroll
                for (int j = 0; j < 16; ++j)
                    if ((i + 1) * (j + 1) <= 16) {
                        const float a = pp ? pv[i] : sv[i], b = pp ? sv[j] : pv[j];
                        const unsigned ub = __float_as_uint(a + b), ks = ub ^ ((ub >> 31) ? 0xffffffffu : 0x80000000u);
                        TOPK_INSERT(M, (ks & 0xffffff00u) | (unsigned)(255 - (i * 16 + j)));
                    }
            __syncthreads();
            float fv[16]; unsigned eid[16]; float mx = -3.0e38f;
            const int t0 = tid & ~1;
#pragma unroll
            for (int q = 0; q < 16; ++q) {
                const unsigned code = 255u - (M[q] & 0xffu), i = code >> 4, j = code & 15u;
                const u32x2 e0 = LST[t0 * 16 + i], e1 = LST[(t0 + 1) * 16 + j];
                fv[q] = __uint_as_float(e0.x) + __uint_as_float(e1.x); eid[q] = e0.y * 128u + e1.y; mx = fmaxf(mx, fv[q]);
            }
            float den = 0.f;
#pragma unroll
            for (int q = 0; q < 16; ++q) { fv[q] = __expf(fv[q] - mx); den += fv[q]; }
            const float inv = 1.f / den;
            if (pp == 0) {
                const int hh = hp >> 1;
#pragma unroll
                for (int q = 0; q < 16; ++q) SEL[tt * 128 + hh * 16 + q] = (u32x2){eid[q], __float_as_uint(fv[q] * inv)};
            }
        }
        __syncthreads();
        for (int ti = 0; ti < 4; ++ti) {
            const int tt = wave + 8 * ti, row = row0 + tt;
            const bool lat = row < NLAT; const int rr = lat ? row : row - NLAT, br = lat ? (row >> 12) : 16;
            const bf16* xrow = X + (size_t)row * DM;
            u32x4 xg[8];
#pragma unroll
            for (int c = 0; c < 8; ++c) xg[c] = *(const u32x4*)(xrow + (c * 16 + (lane & 15)) * 8);
            const LAS u32x2* sel = SEL + tt * 128;
#pragma unroll 2
            for (int g4 = 0; g4 < 32; ++g4) {
                const int k = 4 * g4 + (lane >> 4);
                const u32x2 se = sel[k];
                const bf16* up = U + (size_t)se.x * DM + (lane & 15) * 8;
                float acc = 0.f;
#pragma unroll
                for (int c = 0; c < 8; ++c) {
                    const u32x4 uw = *(const u32x4*)(up + c * 128);
#pragma unroll
                    for (int d = 0; d < 4; ++d) { acc = fmaf(bf_lo(uw[d]), bf_lo(xg[c][d]), acc); acc = fmaf(bf_hi(uw[d]), bf_hi(xg[c][d]), acc); }
                }
                acc += __shfl_xor(acc, 1); acc += __shfl_xor(acc, 2); acc += __shfl_xor(acc, 4); acc += __shfl_xor(acc, 8);
                const float ge = 0.5f * acc * (1.f + erff(acc * 0.70710678118654752f));
                if ((lane & 15) == 0) WG[k] = ge * __uint_as_float(se.y);
            }
            asm volatile("s_waitcnt lgkmcnt(0)" ::: "memory");
            float o[16];
#pragma unroll
            for (int i = 0; i < 16; ++i) o[i] = 0.f;
#pragma unroll 8
            for (int k = 0; k < 128; ++k) {
                const unsigned e = __builtin_amdgcn_readfirstlane(sel[k].x); const float wg = WG[k];
                const bf16* vp = V + (size_t)e * DM + lane * 8;
                const u32x4 v0 = *(const u32x4*)vp, v1 = *(const u32x4*)(vp + 512);
#pragma unroll
                for (int d = 0; d < 4; ++d) { o[2 * d] = fmaf(wg, bf_lo(v0[d]), o[2 * d]); o[2 * d + 1] = fmaf(wg, bf_hi(v0[d]), o[2 * d + 1]);
                                              o[8 + 2 * d] = fmaf(wg, bf_lo(v1[d]), o[8 + 2 * d]); o[8 + 2 * d + 1] = fmaf(wg, bf_hi(v1[d]), o[8 + 2 * d + 1]); }
            }
#if defined(DEBUG_CHECK)
            if (!LAST && row < 2048) { float* fd = (float*)((unsigned char*)Hn - WS_ACT2 + WS_QM) + (size_t)row * DM;
                for (int i = 0; i < 8; ++i) { fd[lane * 8 + i] = o[i]; fd[512 + lane * 8 + i] = o[8 + i]; }
                float* sd = (float*)((unsigned char*)Hn - WS_ACT2 + WS_QM) + (size_t)2048 * DM + (size_t)row * 384;
                for (int k = lane; k < 128; k += 64) { sd[k] = (float)sel[k].x; sd[128 + k] = __uint_as_float(sel[k].y); sd[256 + k] = WG[k]; } }
#endif
            float* rp = (lat ? res_lat : res_ctx) + (size_t)rr * DM; const float* gp = g2mod + (size_t)br * 6144;
            float xn[16]; float ss = 0.f;
#pragma unroll
            for (int hf = 0; hf < 2; ++hf)
#pragma unroll
                for (int q = 0; q < 2; ++q) {
                    const int col = hf * 512 + lane * 8 + q * 4;
                    const f32x4 r4 = *(const f32x4*)(rp + col), g4v = *(const f32x4*)(gp + col);
#pragma unroll
                    for (int e = 0; e < 4; ++e) { const float v = r4[e] + g4v[e] * o[hf * 8 + q * 4 + e]; xn[hf * 8 + q * 4 + e] = v; ss += v * v; }
                }
            ss = wave_sum(ss);
            const float rs = 1.0f / sqrtf(ss * (1.0f / DM) + RMS_EPS);
#pragma unroll
            for (int hf = 0; hf < 2; ++hf) {
                const int col = hf * 512 + lane * 8;
                if (LAST) {
                    const f32x4 ga = *(const f32x4*)(ngain + col), gb = *(const f32x4*)(ngain + col + 4); f32x4 oa, ob;
#pragma unroll
                    for (int e = 0; e < 4; ++e) { oa[e] = xn[hf * 8 + e] * rs * ga[e]; ob[e] = xn[hf * 8 + 4 + e] * rs * gb[e]; }
                    *(f32x4*)(rp + col) = oa; *(f32x4*)(rp + col + 4) = ob;
                } else {
                    f32x4 xa, xb;
#pragma unroll
                    for (int e = 0; e < 4; ++e) { xa[e] = xn[hf * 8 + e]; xb[e] = xn[hf * 8 + 4 + e]; }
                    *(f32x4*)(rp + col) = xa; *(f32x4*)(rp + col + 4) = xb;
                    const float* mp = nmod + (size_t)br * 6144 + col; float y[8];
#pragma unroll
                    for (int e = 0; e < 8; ++e) y[e] = xn[hf * 8 + e] * rs * ngain[col + e] * (1.f + mp[1024 + e]) + mp[e];
                    u32x4 w; w.x = cvt_pk_bf16(y[0], y[1]); w.y = cvt_pk_bf16(y[2], y[3]); w.z = cvt_pk_bf16(y[4], y[5]); w.w = cvt_pk_bf16(y[6], y[7]);
                    *(u32x4*)(Hn + (size_t)row * DM + col) = w;
                }
            }
        }
        __syncthreads();
    }
}
#define XB_TMO      128
#define XB_XCNT(j)  (256  + 64 * (j))
#define XB_XSUB(j)  (1280 + 64 * (j))
#define XB_XGEN(j)  (2304 + 64 * (j))
#define XB_TOP      3328
#define XB_TOPGEN   3392
#define XCD_BAR_WORDS 3456
#define XB_SPIN_CAP (1u << 22)
__device__ __forceinline__ unsigned xb_ld(unsigned* p)              { return __hip_atomic_load(p, __ATOMIC_RELAXED, __HIP_MEMORY_SCOPE_AGENT); }
__device__ __forceinline__ unsigned xb_add(unsigned* p, unsigned v) { return __hip_atomic_fetch_add(p, v, __ATOMIC_RELAXED, __HIP_MEMORY_SCOPE_AGENT); }
__device__ __forceinline__ unsigned xb_xcc_id() { return (unsigned)__builtin_amdgcn_s_getreg((3 << 11) | 20) & 0xFu; }
#define XB_SPIN(cond, bar) do { unsigned _sp = 0; while (cond) { __builtin_amdgcn_s_sleep(1); \
    if ((++_sp & 255u) == 0u) { if (xb_ld(&(bar)[XB_TMO])) break; if (_sp > XB_SPIN_CAP) { atomicAdd(&(bar)[XB_TMO], 1u); break; } } } } while (0)
struct XcdBarrier { unsigned* bar; unsigned x; volatile LAS unsigned* st; };
__device__ __forceinline__ XcdBarrier xcd_barrier_post(unsigned* bar, volatile LAS unsigned* st) {
    XcdBarrier b; b.bar = bar; b.x = xb_xcc_id(); b.st = st;
    if (threadIdx.x == 0) (void)xb_add(&bar[XB_XCNT(b.x)], 1u);
    return b;
}
__device__ __forceinline__ void xcd_barrier_complete(unsigned* bar, unsigned x, unsigned& nloc, unsigned& nx) {
    const unsigned G = gridDim.x * gridDim.y * gridDim.z;
    unsigned sum, cnt, mine, sp = 0u;
    for (;;) {
        sum = 0u; cnt = 0u; mine = 0u;
#pragma unroll
        for (unsigned j = 0; j < 16; ++j) { const unsigned c = xb_ld(&bar[XB_XCNT(j)]); sum += c; cnt += (c > 0u) ? 1u : 0u; mine = (j == x) ? c : mine; }
        if (sum == G) break;
        __builtin_amdgcn_s_sleep(1);
        if ((++sp & 255u) == 0u) { if (xb_ld(&bar[XB_TMO])) break; if (sp > XB_SPIN_CAP) { atomicAdd(&bar[XB_TMO], 1u); break; } }
    }
    nloc = mine > 0u ? mine : 1u; nx = cnt > 0u ? cnt : 1u;
}
__device__ __forceinline__ void xcd_barrier(const XcdBarrier& b) {
    asm volatile("s_waitcnt vmcnt(0)" ::: "memory");
    __syncthreads();
    if (threadIdx.x == 0) {
        unsigned* bar = b.bar;
        __builtin_amdgcn_s_waitcnt(0);
        unsigned nloc = b.st[0], nx = b.st[1];
        if (nloc == 0u) { xcd_barrier_complete(bar, b.x, nloc, nx); b.st[0] = nloc; b.st[1] = nx; }
        const unsigned old = xb_add(&bar[XB_XSUB(b.x)], 1u);
        const unsigned gen = old / nloc;
        if (old + 1u == (gen + 1u) * nloc) {
            __builtin_amdgcn_fence(__ATOMIC_RELEASE, "agent");
            asm volatile("s_waitcnt vmcnt(0)" ::: "memory");
            const unsigned og = xb_add(&bar[XB_TOP], 1u);
            const unsigned tg = og / nx;
            if (og + 1u == (tg + 1u) * nx) xb_add(&bar[XB_TOPGEN], 1u);
            else XB_SPIN(xb_ld(&bar[XB_TOPGEN]) == tg, bar);
            __builtin_amdgcn_fence(__ATOMIC_ACQUIRE, "agent");
            xb_add(&bar[XB_XGEN(b.x)], 1u);
            asm volatile("s_waitcnt vmcnt(0)" ::: "memory");
        } else {
            XB_SPIN(xb_ld(&bar[XB_XGEN(b.x)]) == gen, bar);
            __builtin_amdgcn_fence(__ATOMIC_ACQUIRE, "agent");
            asm volatile("s_waitcnt vmcnt(0)" ::: "memory");
        }
    }
    __syncthreads();
}

__device__ __forceinline__ void transpose_item(const float* W, int K, int ldw, bf16* WT, const float* kscale, LAS float* scr, int kb, int nb, int srccol, int lane) {
    const int k0 = 64 * kb, n0 = 32 * nb;
#pragma unroll 8
    for (int i = 0; i < 32; ++i) { const int kk = 2 * i + (lane >> 5); float v = (srccol >= 0) ? W[(size_t)(k0 + kk) * ldw + srccol] : 0.f; if (kscale) v *= kscale[k0 + kk]; scr[kk * 33 + (lane & 31)] = v; }
    asm volatile("s_waitcnt lgkmcnt(0)" ::: "memory");
    const int c = lane & 7;
#pragma unroll
    for (int j = 0; j < 4; ++j) { const int n = (lane >> 3) + 8 * j; const LAS float* s = scr + (8 * c) * 33 + n;
        u32x4 o; o.x = cvt_pk_bf16(s[0 * 33], s[1 * 33]); o.y = cvt_pk_bf16(s[2 * 33], s[3 * 33]); o.z = cvt_pk_bf16(s[4 * 33], s[5 * 33]); o.w = cvt_pk_bf16(s[6 * 33], s[7 * 33]);
        *(u32x4*)(WT + (size_t)(n0 + n) * K + k0 + 8 * c) = o; }
    asm volatile("s_waitcnt lgkmcnt(0)" ::: "memory");
}
__device__ __forceinline__ int rope_perm(int p) { return p < 8 ? p : (p < 16 ? 8 + p : (p < 24 ? p - 8 : p)); }

__device__ __forceinline__ void norm_mod_rows(int nrows, const float* src_lat, const float* src_ctx, const float* gain, const float* mod  , int sh_off, int sc_off, bf16* dst, int gw, int ngw, int lane) {
    for (int row = gw; row < nrows; row += ngw) {
        const bool lat = row < NLAT; const int rr = lat ? row : row - NLAT, br = lat ? (row >> 12) : 16;
        const f32x4* xr = (const f32x4*)((lat ? src_lat : src_ctx) + (size_t)rr * DM) + lane;
        f32x4 v[4]; float s = 0.f;
#pragma unroll
        for (int j = 0; j < 4; ++j) { v[j] = xr[64 * j]; s += (v[j].x * v[j].x + v[j].y * v[j].y) + (v[j].z * v[j].z + v[j].w * v[j].w); }
        const float rs = 1.0f / sqrtf(wave_sum(s) * (1.0f / DM) + RMS_EPS);
        const float* mp = mod + (size_t)br * 6144;
#pragma unroll
        for (int j = 0; j < 4; ++j) {
            const int col = 4 * (lane + 64 * j);
            const f32x4 g = *(const f32x4*)(gain + col), sc = *(const f32x4*)(mp + sc_off + col), sh = *(const f32x4*)(mp + sh_off + col);
            const f32x4 y = v[j] * rs * g * (sc + 1.0f) + sh;
            u32x2 w; w.x = cvt_pk_bf16(y.x, y.y); w.y = cvt_pk_bf16(y.z, y.w);
            *(u32x2*)(dst + (size_t)row * DM + col) = w;
        }
    }
}
__device__ __forceinline__ int iclamp(int v, int lo, int hi) { return v < lo ? lo : (v > hi ? hi : v); }
__device__ __forceinline__ void attn_l0_phase(LAS unsigned char* lds, const bf16* Z, bf16* OUT, const float* rpb_g, const float* sink_g, int vcu, int G) {
    const int tid = threadIdx.x, lane = tid & 63, w = __builtin_amdgcn_readfirstlane(tid >> 6), r32 = lane & 31, h = lane >> 5;
    LAS float* rpbL = (LAS float*)(lds + 65536);
    for (int u = vcu; u < 4352; u += G) {
        f32x16 O[2];
        if (u < 2048) {
            const int rg = u & 15, hd = (u >> 4) & 7, b = u >> 7;
            for (int i = tid; i < 465; i += NTHREADS) rpbL[i] = rpb_g[hd * 465 + i] * LOG2E;
            PolNA p; p.kb = Z + 512 + hd * 64; p.k2b = p.kb; p.vb = Z + 1024 + hd * 64; p.ldk = p.ldk2 = p.ldv = AB_IN; p.lat0 = b * SEQ; p.ctx0 = NLAT + b * CTX;
            const int lo = iclamp(4 * rg - 4, 0, 56), hi = iclamp(4 * rg - 1, 0, 56) + 7; p.lo = lo; p.nt = 4 + hi - lo + 1;
            const int qrow = 4 * rg + (w >> 1), half = w & 1; p.qrow = qrow; p.r0 = iclamp(qrow - 4, 0, 56); p.qc = 32 * half + r32; p.cs = iclamp(p.qc - 8, 0, 48); p.rpb = rpbL;
            const size_t row = (size_t)b * SEQ + qrow * 64 + p.qc;
            attn_unit<PolNA>(lds, p, Z + row * AB_IN + hd * 64, NEGBIG, 0.f, O);
            store_o<2>(OUT + row * DM + hd * 64, O, h);
        } else if (u < 4096) {
            const int u2 = u - 2048, qb = u2 & 63, kvh = (u2 >> 6) & 1, b = u2 >> 7, P0 = 64 * qb;
            const int i0 = P0 >= 128 ? 0 : (128 - P0) / 64; int i1 = (4160 - P0) / 64; i1 = i1 > 4 ? 4 : i1;
            PolSWA p; p.kb = Z + 2048 + kvh * 64; p.k2b = p.kb; p.vb = Z + 2176 + kvh * 64; p.ldk = p.ldk2 = p.ldv = AB_IN; p.lat0 = b * SEQ; p.ctx0 = NLAT + b * CTX;
            p.pos0 = P0 - 128 + 64 * i0; p.nt = 4 + (i1 - i0 + 1);
            const int g = w >> 1, half = w & 1, qp = P0 + 32 * half + r32, qh = kvh * 4 + g; p.qp = qp;
            const size_t row = (size_t)b * SEQ + qp;
            attn_unit<PolSWA>(lds, p, Z + row * AB_IN + 1536 + qh * 64, sink_g[qh] * LOG2E, h == 0 ? 1.f : 0.f, O);
            store_o<2>(OUT + row * DM + 512 + qh * 64, O, h);
        } else {
            const int u3 = u - 4096, ty = u3 >> 7, hd = u3 & 7, b = (u3 >> 3) & 15;
            PolPlain<64, 64> p; p.ldk = p.ldk2 = p.ldv = AB_IN; p.lat0 = 0; p.nlat = 0; p.ctx0 = NLAT + b * CTX; p.nt = 4; p.c2 = 0.125f * LOG2E;
            int qcol, ocol; float m0 = NEGBIG, l0 = 0.f;
            if (ty == 0) { p.kb = Z + 512 + hd * 64; p.vb = Z + 1024 + hd * 64; qcol = hd * 64; ocol = hd * 64; }
            else { p.kb = Z + 2048 + (hd >> 2) * 64; p.vb = Z + 2176 + (hd >> 2) * 64; qcol = 1536 + hd * 64; ocol = 512 + hd * 64; m0 = sink_g[hd] * LOG2E; l0 = h == 0 ? 1.f : 0.f; }
            p.k2b = p.kb;
            const size_t row = (size_t)NLAT + b * CTX + 32 * w + r32;
            attn_unit<PolPlain<64, 64>>(lds, p, Z + row * AB_IN + qcol, m0, l0, O);
            store_o<2>(OUT + row * DM + ocol, O, h);
        }
    }
}
__device__ __forceinline__ void attn_l1_phase(LAS unsigned char* lds, const bf16* Z, const bf16* QM, const bf16* KV, bf16* OUT, const float* lamv, const float* subln, const float* rstd, int vcu, int G) {
    const int tid = threadIdx.x, lane = tid & 63, w = __builtin_amdgcn_readfirstlane(tid >> 6), r32 = lane & 31, h = lane >> 5;
    const float lam = expf(wave_sum(lamv[lane] * lamv[64 + lane])) - expf(wave_sum(lamv[128 + lane] * lamv[192 + lane])) + LAM_INIT1;
    for (int u = vcu; u < 3072; u += G) {
        if (u < 2048) {
            const int qb = u & 15, hd = (u >> 4) & 7, b = u >> 7;
            PolPlain<96, 64> p; p.kb = KV + hd * 128; p.ldk = DM; p.k2b = Z + 384; p.ldk2 = AB_IN; p.vb = KV + hd * 128 + 64; p.ldv = DM;
            p.lat0 = b * SEQ; p.ctx0 = NLAT + b * CTX; p.nlat = 64; p.nt = 68;
            const size_t row = (size_t)b * SEQ + 256 * qb + 32 * w + r32;
            p.c2 = 0.10206207261596577f * LOG2E * rstd[row * 2];
            f32x16 O[2];
            attn_unit<PolPlain<96, 64>>(lds, p, QM + row * 768 + hd * 96, NEGBIG, 0.f, O);
            store_o<2>(OUT + row * DM + hd * 64, O, h);
        } else {
            const int u2 = u - 2048, qb = u2 & 15, hh = (u2 >> 4) & 3, b = u2 >> 6;
            PolPlain<64, 128> p; p.ldk = p.ldk2 = p.ldv = AB_IN; p.vb = Z + 1440 + hh * 128; p.lat0 = b * SEQ; p.ctx0 = NLAT + b * CTX; p.nlat = 64; p.nt = 68; p.c2 = 0.125f * LOG2E;
            const size_t row = (size_t)b * SEQ + 256 * qb + 32 * w + r32;
            f32x16 O[4]; LAS unsigned* o1s = (LAS unsigned*)(lds + 65536 + w * 8192) + lane;
            p.kb = Z + 928 + (hh * 2) * 64; p.k2b = p.kb;
            attn_unit<PolPlain<64, 128>>(lds, p, Z + row * AB_IN + 416 + (hh * 2) * 64, NEGBIG, 0.f, O);
#pragma unroll
            for (int db = 0; db < 4; ++db)
#pragma unroll
                for (int i = 0; i < 8; ++i) o1s[(db * 8 + i) * 64] = cvt_pk_bf16(O[db][2 * i], O[db][2 * i + 1]);
            p.kb = Z + 928 + (hh * 2 + 1) * 64; p.k2b = p.kb;
            attn_unit<PolPlain<64, 128>>(lds, p, Z + row * AB_IN + 416 + (hh * 2 + 1) * 64, NEGBIG, 0.f, O);
            float ss = 0.f;
#pragma unroll
            for (int db = 0; db < 4; ++db)
#pragma unroll
                for (int i = 0; i < 8; ++i) { const unsigned pw = o1s[(db * 8 + i) * 64]; const float d0 = bf_lo(pw) - lam * O[db][2 * i], d1 = bf_hi(pw) - lam * O[db][2 * i + 1]; O[db][2 * i] = d0; O[db][2 * i + 1] = d1; ss += d0 * d0 + d1 * d1; }
            ss += __shfl_xor(ss, 32);
            const float rs = (1.f - LAM_INIT1) / sqrtf(ss * (1.0f / 128.0f) + RMS_EPS);
#pragma unroll
            for (int db = 0; db < 4; ++db)
#pragma unroll
                for (int g = 0; g < 4; ++g) { const f32x4 sg = *(const f32x4*)(subln + 32 * db + 8 * g + 4 * h);
#pragma unroll
                    for (int e = 0; e < 4; ++e) O[db][4 * g + e] *= rs * sg[e]; }
            store_o<4>(OUT + row * DM + 512 + hh * 128, O, h);
        }
    }
}
#ifndef STOP_AFTER
#define STOP_AFTER 15
#endif
#ifndef ONE_LAUNCH
#define ONE_LAUNCH 1
#endif
struct Args { const float* in[24]; float* out; unsigned char* ws; int ph_lo, ph_hi; };
__global__ void __launch_bounds__(NTHREADS, 2) fwd(Args a) {
    extern __shared__ __attribute__((aligned(16))) unsigned char lds_raw[];
    LAS unsigned char* lds = (LAS unsigned char*)lds_raw;
    const int tid = threadIdx.x, lane = tid & 63, wave = __builtin_amdgcn_readfirstlane(tid >> 6);
    const int G = gridDim.x, bx = blockIdx.x, vcu = (G % 8 == 0) ? (bx % 8) * (G / 8) + bx / 8 : bx;
    const int gw = vcu * NWAVES + wave, ngw = G * NWAVES;
    unsigned char* ws = a.ws;
    unsigned* ctl = (unsigned*)(ws + WS_CTL);
    float* MOD = (float*)(ws + WS_MOD); float* ROPE = (float*)(ws + WS_ROPE); float* RSTD = (float*)(ws + WS_RSTD);
    bf16* WIN0 = (bf16*)(ws + WS_WIN0); bf16* WOUT = (bf16*)(ws + WS_WOUT); bf16* WPQ = (bf16*)(ws + WS_WPQ); bf16* WIN1 = (bf16*)(ws + WS_WIN1);
    bf16* WUQ = (bf16*)(ws + WS_WUQ); bf16* WUKV = (bf16*)(ws + WS_WUKV); float* CTXRES = (float*)(ws + WS_CTXRES);
    bf16* UB = (bf16*)(ws + WS_U); bf16* VB = (bf16*)(ws + WS_V); bf16* ACT1 = (bf16*)(ws + WS_ACT1); bf16* ACT2 = (bf16*)(ws + WS_ACT2);
    bf16* Z = (bf16*)(ws + WS_Z); bf16* QM = (bf16*)(ws + WS_QM); bf16* KV = (bf16*)(ws + WS_KV);
    const float* x_in = a.in[0]; const float* c_in = a.in[1]; const float* ctx_in = a.in[2]; const float* cctx_in = a.in[3]; const float* ada_w = a.in[4]; const float* ada_b = a.in[5];
    const float* norm1_g = a.in[6]; const float* norm2_g = a.in[7]; const float* w_out = a.in[8]; const float* peer_wq = a.in[9]; const float* peer_keys = a.in[10];
    const float* peer_u = a.in[11]; const float* peer_v = a.in[12]; const float* ab_w_in = a.in[13]; const float* na_rpb = a.in[14]; const float* swa_sink = a.in[15];
    const float* cd_w_in = a.in[16]; const float* q_norm_g = a.in[17]; const float* w_uq = a.in[18]; const float* kv_norm_g = a.in[19]; const float* w_ukv = a.in[20];
    const float* diff_lambda = a.in[21]; const float* subln_g = a.in[22]; const float* final_g = a.in[23];
    float* out = a.out;

    volatile LAS unsigned* MISC = (volatile LAS unsigned*)(lds + LDS_MISC);
    if (tid < 16) MISC[tid] = 0u;
    __syncthreads();
    const int lo = a.ph_lo, hi = a.ph_hi;
    XcdBarrier bar; bar.bar = ctl + CW_BAR; bar.x = 0; bar.st = MISC + 8;
    if (hi - lo > 1) bar = xcd_barrier_post(ctl + CW_BAR, MISC + 8);
#ifndef PHASE_MASK
#define PHASE_MASK 0xffff
#endif
#define IN(k) ((((PHASE_MASK) >> (k)) & 1) && lo <= (k) && (k) < hi)
#define SEAM(k) do { if (IN(k) && IN((k) + 1)) xcd_barrier(bar); } while (0)

    if (IN(0)) {
        if (bx < 192) {
            const int l = bx / 96, n0 = (bx % 96) * 64;
            LAS float* sil = (LAS float*)lds;
            for (int idx = tid; idx < 17 * 1024; idx += NTHREADS) { const int r = idx >> 10, k = idx & 1023; const float cv = r < 16 ? c_in[idx] : cctx_in[k]; sil[idx] = cv / (1.f + expf(-cv)); }
            __syncthreads();
            float acc[17];
#pragma unroll
            for (int r = 0; r < 17; ++r) acc[r] = 0.f;
            const float* wp = ada_w + (size_t)l * 1024 * 6144 + n0 + lane;
            for (int k = wave * 128; k < wave * 128 + 128; k += 4) {
                const float w0 = wp[(size_t)k * 6144], w1 = wp[(size_t)(k + 1) * 6144], w2 = wp[(size_t)(k + 2) * 6144], w3 = wp[(size_t)(k + 3) * 6144];
#pragma unroll
                for (int r = 0; r < 17; ++r) { const f32x4 s4 = *(const LAS f32x4*)(sil + r * 1024 + k); acc[r] += (s4.x * w0 + s4.y * w1) + (s4.z * w2 + s4.w * w3); }
            }
            LAS float* part = (LAS float*)(lds + 69632);
#pragma unroll
            for (int r = 0; r < 17; ++r) part[(wave * 17 + r) * 64 + lane] = acc[r];
            __syncthreads();
            for (int idx = tid; idx < 17 * 64; idx += NTHREADS) { const int r = idx >> 6, ln = idx & 63; float s = 0.f;
#pragma unroll
                for (int w8 = 0; w8 < 8; ++w8) s += part[(w8 * 17 + r) * 64 + ln];
                MOD[((size_t)l * 17 + r) * 6144 + n0 + ln] = s + ada_b[l * 6144 + n0 + ln]; }
            __syncthreads();
        }
        LAS float* scr = (LAS float*)(lds + wave * 16384);
        constexpr int T0 = 1152, T1 = T0 + 1024, T2 = T1 + 1024, T3 = T2 + 96, T4 = T3 + 64, T5 = T4 + 4096, T6 = T5 + 4096, T7 = T6 + 24;
        for (int it = gw; it < T7; it += ngw) {
            if (it < T0) { const int kb = it / 72, nb = it % 72; transpose_item(ab_w_in, 1024, AB_IN, WIN0, nullptr, scr, kb, nb, 32 * nb + (lane & 31), lane); }
            else if (it < T1) { const int r = it - T0, l = r >> 9, kb = (r & 511) >> 5, nb = r & 31; transpose_item(w_out + (size_t)l * DM * DM, 1024, DM, WOUT + (size_t)l * DM * DM, nullptr, scr, kb, nb, 32 * nb + (lane & 31), lane); }
            else if (it < T2) { const int r = it - T1, kb = r >> 6, nb = r & 63, n = 32 * nb + (lane & 31);
                const int src = n < CD_IN ? (nb == 12 ? 384 + rope_perm(lane & 31) : n) : -1;
                transpose_item(cd_w_in, 1024, CD_IN, WIN1, nullptr, scr, kb, nb, src, lane); }
            else if (it < T3) { const int r = it - T2, kb = r / 24, nb = r % 24; const int src = (nb % 3 == 2) ? 32 * nb + rope_perm(lane & 31) : 32 * nb + (lane & 31);
                transpose_item(w_uq, 256, 768, WUQ, q_norm_g, scr, kb, nb, src, lane); }
            else if (it < T4) { const int r = it - T3, kb = r >> 5, nb = r & 31; transpose_item(w_ukv, 128, 1024, WUKV, kv_norm_g, scr, kb, nb, 32 * nb + (lane & 31), lane); }
            else if (it < T5) {
                const int r = it - T4, l = r >> 11, hp = (r >> 7) & 15, kb = (r >> 2) & 31, nb = r & 3, i32 = lane & 31, hh = lane >> 5;
                const float* ap = peer_wq + (size_t)l * DM * PQ_N + (size_t)(32 * kb + i32) * PQ_N + hp * 128 + 64 * hh;
                const float* bp = peer_keys + (size_t)l * 2 * 128 * 128 + (size_t)(hp & 1) * 128 * 128 + (size_t)(32 * nb + i32) * 128 + 64 * hh;
                f32x16 acc;
#pragma unroll
                for (int i = 0; i < 16; ++i) acc[i] = 0.f;
                for (int s4 = 0; s4 < 16; ++s4) {
                    const f32x4 av = *(const f32x4*)(ap + 4 * s4), bv = *(const f32x4*)(bp + 4 * s4);
#pragma unroll
                    for (int e = 0; e < 4; ++e) acc = __builtin_amdgcn_mfma_f32_32x32x2f32(av[e], bv[e], acc, 0, 0, 0);
                }
                bf16* op = WPQ + (size_t)l * PQ_N * DM + (size_t)(hp * 128 + 32 * nb + i32) * DM + 32 * kb + 4 * hh;
#pragma unroll
                for (int g = 0; g < 4; ++g) { u32x2 wv; wv.x = cvt_pk_bf16(acc[4 * g], acc[4 * g + 1]); wv.y = cvt_pk_bf16(acc[4 * g + 2], acc[4 * g + 3]); *(u32x2*)(op + 8 * g) = wv; }
            }
            else if (it < T6) {
                const int r = it - T5; const float* src = (r < 2048 ? peer_u : peer_v) + (size_t)(r & 2047) * 16384; bf16* dst = (r < 2048 ? UB : VB) + (size_t)(r & 2047) * 16384;
#pragma unroll 4
                for (int i = 0; i < 32; ++i) { const f32x4 v0 = *(const f32x4*)(src + i * 512 + lane * 8), v1 = *(const f32x4*)(src + i * 512 + lane * 8 + 4);
                    u32x4 o; o.x = cvt_pk_bf16(v0.x, v0.y); o.y = cvt_pk_bf16(v0.z, v0.w); o.z = cvt_pk_bf16(v1.x, v1.y); o.w = cvt_pk_bf16(v1.z, v1.w); *(u32x4*)(dst + i * 512 + lane * 8) = o; }
            }
            else {
                const int idx = (it - T6) * 64 + lane;
                if (idx < 1024) { const int pos = idx >> 4, i = idx & 15; const float ang = (float)pos * powf(10000.f, -(float)i / 16.f); ROPE[idx] = cosf(ang); ROPE[1024 + idx] = sinf(ang); }
                else { const int j = idx - 1024, pos = j >> 3, i = j & 7; const float ang = (float)pos * powf(10000.f, -(float)i / 8.f); ROPE[2048 + j] = cosf(ang); ROPE[2560 + j] = sinf(ang); }
            }
        }
    }
    SEAM(0);
    if (IN(1)) norm_mod_rows(NROW, x_in, ctx_in, norm1_g, MOD, 0, 1024, ACT1, gw, ngw, lane);
    SEAM(1);
    if (IN(2)) { pg8::Gemm g{ACT1, WIN0, NROW, AB_IN, 1024, 1024, 1024}; pg8::StaticOrder S; S.init(NROW, AB_IN, G, bx); EpiRope<0> E{Z, AB_IN, ROPE};
        pg8::gemm_phase<EpiRope<0>, pg8::StaticOrder>(lds, g, S, E); }
    SEAM(2);
    if (IN(3)) attn_l0_phase(lds, Z, ACT2, na_rpb, swa_sink, vcu, G);
    SEAM(3);
    if (IN(4)) { pg8::Gemm g{ACT2, WOUT, NROW, DM, 1024, 1024, 1024}; pg8::StaticOrder S; S.init(NROW, DM, G, bx); EpiResid E{x_in, ctx_in, out, CTXRES, MOD + 2048};
        pg8::gemm_phase<EpiResid, pg8::StaticOrder>(lds, g, S, E); }
    SEAM(4);
    if (IN(5)) norm_mod_rows(NROW, out, CTXRES, norm2_g, MOD, 3072, 4096, ACT1, gw, ngw, lane);
    SEAM(5);
    if (IN(6)) { pg8::Gemm g{ACT1, WPQ, NROW, PQ_N, 1024, 1024, 1024}; pg8::StaticOrder S; S.init(NROW, PQ_N, G, bx); EpiBf16 E{Z, PQ_N, nullptr, 0};
        pg8::gemm_phase<EpiBf16, pg8::StaticOrder>(lds, g, S, E); }
    SEAM(6);
    if (IN(7)) peer_phase<false>(lds, NROW, Z, ACT1, UB, VB, out, CTXRES, MOD + 5120, norm1_g + DM, MOD + 17 * 6144, ACT2, vcu, G);
    SEAM(7);
    if (IN(8)) { pg8::Gemm g{ACT2, WIN1, NROW, CD_PAD, 1024, 1024, 1024}; pg8::StaticOrder S; S.init(NROW, CD_PAD, G, bx); EpiRope<1> E{Z, AB_IN, ROPE};
        pg8::gemm_phase<EpiRope<1>, pg8::StaticOrder>(lds, g, S, E); }
    SEAM(8);
    if (IN(9)) {
        for (int row = gw; row < NROW; row += ngw) {
            const bf16* zr = Z + (size_t)row * AB_IN; const u32x2 qa = *(const u32x2*)(zr + lane * 4); const unsigned kb2 = *(const unsigned*)(zr + 256 + lane * 2);
            float sq = bf_lo(qa.x) * bf_lo(qa.x) + bf_hi(qa.x) * bf_hi(qa.x) + bf_lo(qa.y) * bf_lo(qa.y) + bf_hi(qa.y) * bf_hi(qa.y), sk = bf_lo(kb2) * bf_lo(kb2) + bf_hi(kb2) * bf_hi(kb2);
            sq = wave_sum(sq); sk = wave_sum(sk);
            if (lane == 0) { RSTD[(size_t)row * 2] = 1.0f / sqrtf(sq * (1.0f / 256.0f) + RMS_EPS); RSTD[(size_t)row * 2 + 1] = 1.0f / sqrtf(sk * (1.0f / 128.0f) + RMS_EPS); }
        }
    }
    SEAM(9);
    if (IN(10)) {
        { pg8::Gemm g{Z, WUQ, NLAT, 768, 256, AB_IN, 256}; pg8::StaticOrder S; S.init(NLAT, 768, G, bx); EpiRope<2> E{QM, 768, ROPE};
          pg8::gemm_phase<EpiRope<2>, pg8::StaticOrder>(lds, g, S, E); }
        __syncthreads();
        { pg8::Gemm g{Z + 256, WUKV, NROW, 1024, 128, AB_IN, 128}; pg8::StaticOrder S; S.init(NROW, 1024, G, bx); EpiBf16 E{KV, DM, RSTD, 1};
          pg8::gemm_phase<EpiBf16, pg8::StaticOrder>(lds, g, S, E); }
    }
    SEAM(10);
    if (IN(11)) attn_l1_phase(lds, Z, QM, KV, ACT1, diff_lambda, subln_g, RSTD, vcu, G);
    SEAM(11);
    if (IN(12)) { pg8::Gemm g{ACT1, WOUT + (size_t)DM * DM, NLAT, DM, 1024, 1024, 1024}; pg8::StaticOrder S; S.init(NLAT, DM, G, bx); EpiResid E{out, CTXRES, out, CTXRES, MOD + 17 * 6144 + 2048};
        pg8::gemm_phase<EpiResid, pg8::StaticOrder>(lds, g, S, E); }
    SEAM(12);
    if (IN(13)) norm_mod_rows(NLAT, out, CTXRES, norm2_g + DM, MOD + 17 * 6144, 3072, 4096, ACT2, gw, ngw, lane);
    SEAM(13);
    if (IN(14)) { pg8::Gemm g{ACT2, WPQ + (size_t)PQ_N * DM, NLAT, PQ_N, 1024, 1024, 1024}; pg8::StaticOrder S; S.init(NLAT, PQ_N, G, bx); EpiBf16 E{Z, PQ_N, nullptr, 0};
        pg8::gemm_phase<EpiBf16, pg8::StaticOrder>(lds, g, S, E); }
    SEAM(14);
    if (IN(15)) peer_phase<true>(lds, NLAT, Z, ACT2, UB + (size_t)NEXP * DM, VB + (size_t)NEXP * DM, out, CTXRES, MOD + 17 * 6144 + 5120, final_g, MOD, ACT1, vcu, G);
#if STOP_AFTER < 15
    if (lo <= 16 && 16 < hi) {
        for (int row = gw; row < NLAT; row += ngw) {
            f32x4* xr = (f32x4*)(out + (size_t)row * DM) + lane; f32x4 v[4]; float s = 0.f;
#pragma unroll
            for (int j = 0; j < 4; ++j) { v[j] = xr[64 * j]; s += (v[j].x * v[j].x + v[j].y * v[j].y) + (v[j].z * v[j].z + v[j].w * v[j].w); }
            const float rs = 1.0f / sqrtf(wave_sum(s) * (1.0f / DM) + RMS_EPS);
#pragma unroll
            for (int j = 0; j < 4; ++j) xr[64 * j] = v[j] * rs * ((const f32x4*)final_g)[lane + 64 * j];
        }
    }
#endif
#undef IN
#undef SEAM
}

#if defined(DEBUG_CHECK)
constexpr size_t WS_DBG = 980 * MiB;
__device__ __forceinline__ float bf2f(bf16 v) { return __uint_as_float((unsigned)v << 16); }
__device__ __forceinline__ float wave_max(float v) {
#pragma unroll
    for (int o = 1; o < 64; o <<= 1) v = fmaxf(v, __shfl_xor(v, o));
    return v;
}
__device__ __forceinline__ void wave_argmax(float& v, int& i) {
#pragma unroll
    for (int o = 1; o < 64; o <<= 1) { const float ov = __shfl_xor(v, o); const int oi = __shfl_xor(i, o); if (ov > v || (ov == v && oi < i)) { v = ov; i = oi; } }
}
__global__ void __launch_bounds__(64) dbg_check(Args a, int check) {
    __shared__ float sh[4096]; __shared__ float sv[16][16]; __shared__ int si[16][16];
    const int b = blockIdx.x, lane = threadIdx.x;
    unsigned char* ws = a.ws; float* DBG = (float*)(ws + WS_DBG);
    const float* MOD = (const float*)(ws + WS_MOD);
    const bf16* ACT1 = (const bf16*)(ws + WS_ACT1); const bf16* ACT2 = (const bf16*)(ws + WS_ACT2); const bf16* Z = (const bf16*)(ws + WS_Z);
    const float* FDBG = (const float*)(ws + WS_QM);
    float err = 0.f;
    if (check == 8 || check == 9) return;
    if (check == 1) {
        const int l = b & 1, r = (b >> 1) % 17, n = (b * 97) % 6144; float s = 0.f;
        for (int k = lane; k < 1024; k += 64) { const float cv = r < 16 ? a.in[1][r * 1024 + k] : a.in[3][k]; s += cv / (1.f + expf(-cv)) * a.in[4][((size_t)l * 1024 + k) * 6144 + n]; }
        s = wave_sum(s) + a.in[5][l * 6144 + n]; const float got = MOD[((size_t)l * 17 + r) * 6144 + n]; err = fabsf(got - s) / (fabsf(s) + 0.05f);
    } else if (check == 2) {
        const int row = (b * 1031 + 7) % NROW; const bool lat = row < NLAT; const int br = lat ? row >> 12 : 16;
        const float* xr = lat ? a.in[0] + (size_t)row * DM : a.in[2] + (size_t)(row - NLAT) * DM; float ss = 0.f;
        for (int k = lane; k < 1024; k += 64) ss += xr[k] * xr[k];
        ss = wave_sum(ss); const float rs = 1.f / sqrtf(ss / 1024.f + RMS_EPS); float md = 0.f, mr = 0.f;
        for (int k = lane; k < 1024; k += 64) { const float ref = xr[k] * rs * a.in[6][k] * (1.f + MOD[(size_t)br * 6144 + 1024 + k]) + MOD[(size_t)br * 6144 + k]; md = fmaxf(md, fabsf(ref - bf2f(ACT1[(size_t)row * DM + k]))); mr = fmaxf(mr, fabsf(ref)); }
        err = wave_max(md) / wave_max(mr);
    } else if (check == 3) {
        const int row = (b * 1031 + 7) % NROW; const bool lat = row < NLAT; const int t = row & 4095; float md = 0.f, mr = 0.f;
        for (int j = 0; j < 24; ++j) {
            const int col = (b * 37 + j * 149) % AB_IN; const bool rope = lat && col >= 1536 && col < 2176; const int d = col & 63, first = (d & 31) < 16, pc = rope ? (first ? col + 16 : col - 16) : col;
            float s0 = 0.f, s1 = 0.f;
            for (int k = lane; k < 1024; k += 64) { const float hv = bf2f(ACT1[(size_t)row * DM + k]); s0 += hv * a.in[13][(size_t)k * AB_IN + col]; s1 += hv * a.in[13][(size_t)k * AB_IN + pc]; }
            s0 = wave_sum(s0); s1 = wave_sum(s1); float ref = s0;
            if (rope) { const int pos = d < 32 ? t >> 6 : t & 63, i = d & 15; const float ang = (float)pos * powf(10000.f, -(float)i / 16.f), c = cosf(ang), s = sinf(ang); ref = first ? s0 * c - s1 * s : s1 * s + s0 * c; }
            md = fmaxf(md, fabsf(ref - bf2f(Z[(size_t)row * AB_IN + col]))); mr = fmaxf(mr, fabsf(ref));
        }
        err = md / fmaxf(mr, 0.5f);
    } else if (check == 4) {
        const int hs = b & 15; const int row = (b < 48) ? (((b * 2657 + 11) % NLAT)) : (NLAT + (b * 613) % NCTX); const bool lat = row < NLAT; const int bb = lat ? row >> 12 : (row - NLAT) >> 8, t = row & 4095;
        const int qcol = hs < 8 ? hs * 64 : 1536 + (hs - 8) * 64, kcol = hs < 8 ? 512 + hs * 64 : 2048 + ((hs - 8) >> 2) * 64, vcol = hs < 8 ? 1024 + hs * 64 : 2176 + ((hs - 8) >> 2) * 64;
        const bf16* q = Z + (size_t)row * AB_IN + qcol;
        const int qr = t >> 6, qc = t & 63;
        float* lg = sh; int nk = 0;
        int* kr = (int*)(sh + 1024);
        if (lane == 0) {
            if (lat && hs < 8) { const int r0 = min(max(qr - 4, 0), 56), cs = min(max(qc - 8, 0), 48);
                for (int r = r0; r < r0 + 8; ++r) for (int c = cs; c < cs + 16; ++c) kr[nk++] = bb * 4096 + r * 64 + c; }
            else if (lat) { for (int p = max(t - 128, 0); p <= min(t + 128, 4095); ++p) kr[nk++] = bb * 4096 + p; }
            for (int c = 0; c < 256; ++c) kr[nk++] = NLAT + bb * 256 + c;
            ((int*)sh)[3000] = nk;
        }
        __syncthreads(); nk = ((int*)sh)[3000];
        float mx = -1e30f;
        for (int k = lane; k < nk; k += 64) { const bf16* kp = Z + (size_t)kr[k] * AB_IN + kcol; float s = 0.f; for (int d = 0; d < 64; ++d) s += bf2f(q[d]) * bf2f(kp[d]); s *= 0.125f;
            if (lat && hs < 8 && kr[k] < NLAT) { const int kt = kr[k] & 4095, r = kt >> 6, c = kt & 63; s += a.in[14][hs * 465 + (r - qr + 7) * 31 + min(max(c - qc + 15, 0), 30)]; }
            lg[k] = s; mx = fmaxf(mx, s); }
        if (hs >= 8) mx = fmaxf(mx, a.in[15][hs - 8]);
        mx = wave_max(mx); __syncthreads(); float den = 0.f;
        for (int k = lane; k < nk; k += 64) { lg[k] = expf(lg[k] - mx); den += lg[k]; }
        den = wave_sum(den); if (hs >= 8) den += expf(a.in[15][hs - 8] - mx);
        __syncthreads();
        float o = 0.f; for (int k = 0; k < nk; ++k) o += lg[k] * bf2f(Z[(size_t)kr[k] * AB_IN + vcol + lane]);
        o /= den; const float got = bf2f(ACT2[(size_t)row * DM + (hs < 8 ? hs * 64 : 512 + (hs - 8) * 64) + lane]);
        err = wave_max(fabsf(got - o)) / fmaxf(wave_max(fabsf(o)), 0.02f);
    } else if (check == 5) {
        const int row = (b * 1031 + 7) % NROW; const bool lat = row < NLAT; const int br = lat ? row >> 12 : 16; float md = 0.f;
        for (int j = 0; j < 16; ++j) { const int col = (b * 37 + j * 149) % DM; float s = 0.f;
            for (int k = lane; k < 1024; k += 64) s += bf2f(ACT2[(size_t)row * DM + k]) * a.in[8][(size_t)k * DM + col];
            s = wave_sum(s); const float base = lat ? a.in[0][(size_t)row * DM + col] : a.in[2][(size_t)(row - NLAT) * DM + col];
            const float ref = base + MOD[(size_t)br * 6144 + 2048 + col] * s, got = lat ? a.out[(size_t)row * DM + col] : ((const float*)(ws + WS_CTXRES))[(size_t)(row - NLAT) * DM + col];
            md = fmaxf(md, fabsf(ref - got) / fmaxf(fabsf(MOD[(size_t)br * 6144 + 2048 + col] * s), 0.02f)); }
        err = md;
    } else if (check == 6) {
        const int row = (b * 1031 + 7) % NROW, hp = b & 15; const bf16* h2 = ACT1 + (size_t)row * DM;
        for (int dd = 0; dd < 2; ++dd) { const int d = lane + 64 * dd; float s = 0.f; for (int k = 0; k < 1024; ++k) s += bf2f(h2[k]) * a.in[9][(size_t)k * PQ_N + hp * 128 + d]; sh[d] = s; }
        __syncthreads(); float md = 0.f, mr = 0.f;
        for (int nn = 0; nn < 2; ++nn) { const int n = lane + 64 * nn; float s = 0.f; for (int d = 0; d < 128; ++d) s += sh[d] * a.in[10][((size_t)(hp & 1) * 128 + n) * 128 + d];
            md = fmaxf(md, fabsf(s - bf2f(Z[(size_t)row * PQ_N + hp * 128 + n]))); mr = fmaxf(mr, fabsf(s)); }
        err = wave_max(md) / wave_max(mr);
    } else if (check == 7) {
        const int row = (b * 31 + 3) % 2048; const bf16* h2 = ACT1 + (size_t)row * DM;
        for (int hp = 0; hp < 16; ++hp) {
            float v0 = bf2f(Z[(size_t)row * PQ_N + hp * 128 + lane]), v1 = bf2f(Z[(size_t)row * PQ_N + hp * 128 + 64 + lane]);
            for (int it = 0; it < 16; ++it) { float v = v0; int i = lane; if (v1 > v0) { v = v1; i = lane + 64; } wave_argmax(v, i); if (lane == 0) { sv[hp][it] = v; si[hp][it] = i; } if (i == lane) v0 = -3e38f; if (i == lane + 64) v1 = -3e38f; }
        }
        __syncthreads();
        float f[16]; for (int m = 0; m < 16; ++m) f[m] = 0.f;
        for (int h = 0; h < 8; ++h) {
            float cv[4]; for (int r = 0; r < 4; ++r) { const int c = lane * 4 + r; cv[r] = sv[2 * h][c >> 4] + sv[2 * h + 1][c & 15]; }
            float fv[16]; int fe[16];
            for (int it = 0; it < 16; ++it) { float v = cv[0]; int i = lane * 4; for (int r = 1; r < 4; ++r) if (cv[r] > v) { v = cv[r]; i = lane * 4 + r; } wave_argmax(v, i); fv[it] = v; fe[it] = si[2 * h][i >> 4] * 128 + si[2 * h + 1][i & 15]; if ((i >> 2) == lane) cv[i & 3] = -3e38f; }
            float den = 0.f; for (int it = 0; it < 16; ++it) den += expf(fv[it] - fv[0]);
            const float* sd = FDBG + (size_t)2048 * DM + (size_t)row * 384;
            if (h == 0 && lane == 0) { sh[4000] = 0.f; sh[4001] = 0.f; }
            for (int it = 0; it < 16; ++it) { const int e = fe[it]; float s = 0.f; for (int k = lane; k < 1024; k += 64) s += a.in[11][(size_t)e * DM + k] * bf2f(h2[k]);
                s = wave_sum(s); const float wgt = 0.5f * s * (1.f + erff(s * 0.70710678f)) * expf(fv[it] - fv[0]) / den;
                if (lane == 0) { float best = 1e9f, bw = 1e9f; for (int q = 0; q < 16; ++q) if ((int)sd[h * 16 + q] == e) { best = fabsf(sd[128 + h * 16 + q] - expf(fv[it] - fv[0]) / den); bw = fabsf(sd[256 + h * 16 + q] - wgt) / fmaxf(fabsf(wgt), 1e-3f); }
                    sh[4000] = fmaxf(sh[4000], best); sh[4001] = fmaxf(sh[4001], bw); }
                for (int m = 0; m < 16; ++m) f[m] += wgt * a.in[12][(size_t)e * DM + lane + 64 * m]; }
        }
        float md = 0.f, mr = 0.f; for (int m = 0; m < 16; ++m) { md = fmaxf(md, fabsf(f[m] - FDBG[(size_t)row * DM + lane + 64 * m])); mr = fmaxf(mr, fabsf(f[m])); }
        const float e9 = wave_max(md) / wave_max(mr);
        if (lane == 0) { DBG[9 * 64 + b] = e9; DBG[7 * 64 + b] = sh[4000]; DBG[8 * 64 + b] = sh[4001]; }
        return;
    }
    err = wave_max(err);
    if (lane == 0) DBG[check * 64 + b] = err;
}
__global__ void __launch_bounds__(256) dbg_report(Args a, unsigned mask) {
    const size_t n = (size_t)NLAT * DM; float* out = a.out;
    for (size_t i = (size_t)blockIdx.x * 256 + threadIdx.x; i < n; i += (size_t)gridDim.x * 256) out[i] = 0.f;
    if (blockIdx.x == 0 && threadIdx.x == 0) {
        const float* DBG = (const float*)(a.ws + WS_DBG); int id = 0; float e = 0.f, eall = 0.f;
        for (int c = 1; c < 32 && id == 0; ++c) if (mask >> c & 1) { float m = 0.f; for (int b = 0; b < 64; ++b) { const float v = DBG[c * 64 + b]; m = (v == v) ? fmaxf(m, v) : 1e9f; } eall = fmaxf(eall, m); if (m > 0.03f) { id = c; e = m; } }
        if (id == 0) e = eall;
        float mm = 1.f + 2.2f * (log10f(fmaxf(e, 1e-4f)) + 4.f); mm = fminf(fmaxf(mm, 1.f), 9.8f);
        out[0] = mm * powf(10.f, 3.f + (float)id);
    }
}
#endif
extern "C" void kernel_launch(void* const* d_in, const int* in_sizes, int n_in, void* d_out, int out_size, void* d_ws, size_t ws_size, hipStream_t stream) {
    static int grid = 0;
    if (grid == 0) {
        if (n_in != 24 || out_size != NLAT * DM || ws_size < WS_END) { fprintf(stderr, "kernel_launch: unexpected shapes (n_in %d, out %d, ws %zu)\n", n_in, out_size, ws_size); grid = -1; return; }
        int dev = 0, cus = 0, per_cu = 0;
        if (hipGetDevice(&dev) != hipSuccess || hipDeviceGetAttribute(&cus, hipDeviceAttributeMultiprocessorCount, dev) != hipSuccess) { grid = -1; return; }
        if (hipFuncSetAttribute((const void*)fwd, hipFuncAttributeMaxDynamicSharedMemorySize, LDS_BYTES) != hipSuccess) { fprintf(stderr, "kernel_launch: hipFuncSetAttribute failed\n"); grid = -1; return; }
        if (hipOccupancyMaxActiveBlocksPerMultiprocessor(&per_cu, (const void*)fwd, NTHREADS, LDS_BYTES) != hipSuccess || per_cu < 1) { fprintf(stderr, "kernel_launch: occupancy query says %d blocks per CU\n", per_cu); }
        (void)hipGetLastError();
        grid = cus;
    }
    if (grid < 0) return;
    (void)hipMemsetAsync((char*)d_ws + WS_CTL, 0, CTL_ZERO_BYTES, stream);
    Args a{};
    for (int i = 0; i < 24; ++i) a.in[i] = (const float*)d_in[i];
    a.out = (float*)d_out; a.ws = (unsigned char*)d_ws;
#if ONE_LAUNCH
    a.ph_lo = 0; a.ph_hi = 16;
    hipLaunchKernelGGL(fwd, dim3(grid), dim3(NTHREADS), LDS_BYTES, stream, a);
#else
    for (int p = 0; p <= STOP_AFTER; ++p) { a.ph_lo = p; a.ph_hi = p + 1; hipLaunchKernelGGL(fwd, dim3(grid), dim3(NTHREADS), LDS_BYTES, stream, a); }
#if defined(DEBUG_CHECK)
    for (int c = 1; c < 32; ++c) if ((unsigned)(DEBUG_CHECK) >> c & 1) hipLaunchKernelGGL(dbg_check, dim3(64), dim3(64), 0, stream, a, c);
    hipLaunchKernelGGL(dbg_report, dim3(2048), dim3(256), 0, stream, a, (unsigned)(DEBUG_CHECK));
#elif STOP_AFTER < 15
    a.ph_lo = 16; a.ph_hi = 17; hipLaunchKernelGGL(fwd, dim3(grid), dim3(NTHREADS), LDS_BYTES, stream, a);
#endif
#endif
}
```

```cpp
#include <hip/hip_runtime.h>
#include <cstdio>
#include <cstdint>

#define GAS __attribute__((address_space(1)))
#define LAS __attribute__((address_space(3)))
typedef unsigned short bf16;
typedef unsigned u32x4 __attribute__((ext_vector_type(4)));
typedef unsigned u32x2 __attribute__((ext_vector_type(2)));
typedef float f32x4 __attribute__((ext_vector_type(4)));
typedef float f32x2 __attribute__((ext_vector_type(2)));
typedef float f32x16 __attribute__((ext_vector_type(16)));
typedef short bf16x8 __attribute__((ext_vector_type(8)));
typedef short s16x4 __attribute__((ext_vector_type(4)));
typedef __bf16 bf2_t __attribute__((ext_vector_type(2)));

constexpr int NB = 16, SEQ = 4096, DM = 1024, CTX = 256, NLAT = NB * SEQ, NCTX = NB * CTX, NROW = NLAT + NCTX;
constexpr int AB_IN = 2304, CD_IN = 1952, CD_PAD = 2048, PQ_N = 2048, NEXP = 16384;
constexpr float RMS_EPS = 1e-6f, LOG2E = 1.4426950408889634f, NEGBIG = -1e30f;
constexpr float LAM_INIT1 = 0.35550906759f;

constexpr size_t MiB = 1u << 20;
constexpr size_t WS_CTL = 0, CTL_ZERO_BYTES = 1 * MiB;
constexpr size_t WS_MOD = 1 * MiB;
constexpr size_t WS_ROPE = 2 * MiB;
constexpr size_t WS_SCL = 2 * MiB + 512 * 1024;
constexpr size_t WS_RSTD = 3 * MiB;
constexpr size_t WS_WIN0 = 4 * MiB;
constexpr size_t WS_WOUT = 9 * MiB;
constexpr size_t WS_WPQ = 13 * MiB;
constexpr size_t WS_WIN1 = 21 * MiB;
constexpr size_t WS_WUQ = 25 * MiB;
constexpr size_t WS_WUKV = 25 * MiB + 512 * 1024;
constexpr size_t WS_CTXRES = 26 * MiB;
constexpr size_t WS_U = 42 * MiB;
constexpr size_t WS_V = 106 * MiB;
constexpr size_t WS_ACT1 = 170 * MiB;
constexpr size_t WS_RES = 306 * MiB;
constexpr size_t WS_Z = 442 * MiB;
constexpr size_t WS_QM = 748 * MiB;
constexpr size_t WS_KV = 844 * MiB;
constexpr size_t WS_END = 980 * MiB;
constexpr int CW_BAR = 4096;
constexpr int CW_Q = 8192;

constexpr int NWAVES = 8, NTHREADS = 512;
constexpr int LDS_BYTES = 148480;
constexpr int LDS_MISC = 147456;

__device__ __forceinline__ unsigned cvt_pk_bf16(float lo, float hi) { const f32x2 v = {lo, hi}; return __builtin_bit_cast(unsigned, __builtin_convertvector(v, bf2_t)); }
__device__ __forceinline__ unsigned pk_fp8x4(float a, float b, float c, float d) { int t = 0; t = __builtin_amdgcn_cvt_pk_fp8_f32(a, b, t, false); t = __builtin_amdgcn_cvt_pk_fp8_f32(c, d, t, true); return (unsigned)t; }
__device__ __forceinline__ float bf_lo(unsigned w) { return __uint_as_float(w << 16); }
__device__ __forceinline__ float bf_hi(unsigned w) { return __uint_as_float(w & 0xffff0000u); }
template <int CTRL> __device__ __forceinline__ float dpp_f(float v) { return __int_as_float(__builtin_amdgcn_update_dpp(0, __float_as_int(v), CTRL, 0xF, 0xF, true)); }
__device__ __forceinline__ float xlane1(float v) { return dpp_f<0xB1>(v); }
__device__ __forceinline__ float swap16_sum(float v) { const auto r = __builtin_amdgcn_permlane16_swap(__float_as_uint(v), __float_as_uint(v), false, false); return __uint_as_float(r[0]) + __uint_as_float(r[1]); }
__device__ __forceinline__ float swap32_sum(float v) { const auto r = __builtin_amdgcn_permlane32_swap(__float_as_uint(v), __float_as_uint(v), false, false); return __uint_as_float(r[0]) + __uint_as_float(r[1]); }
__device__ __forceinline__ float red8_sum(float v) { v += dpp_f<0xB1>(v); v += dpp_f<0x4E>(v); v += dpp_f<0x141>(v); return v; }
__device__ __forceinline__ float wave_sum(float v) { v = red8_sum(v); v += dpp_f<0x140>(v); v = swap16_sum(v); return swap32_sum(v); }


__device__ __forceinline__ int fresh_tid() { int t; asm volatile("v_mov_b32 %0, %1" : "=v"(t) : "v"((int)threadIdx.x)); return t; }
__device__ __forceinline__ int fresh_lane() { int l; asm volatile("v_and_b32 %0, 63, %1" : "=v"(l) : "v"((int)threadIdx.x)); return l; }

namespace pg8 {
constexpr int BM = 256, BK = 64, HALF = 128, HTB = HALF * BK * 2, NXCD = 8, WGM = 8;
__host__ __device__ __forceinline__ int lds_byte(int r, int c) { const int st = (r >> 4) * 2 + (c >> 5), rr = r & 15, cc = c & 31, ob = rr * 64 + cc * 2; return st * 1024 + (ob ^ (((ob >> 9) & 1) << 5)); }
__host__ __device__ __forceinline__ void stage_rc(int b, int& R, int& C) { const int st = b / 1024, sb = b % 1024, swz = sb ^ (((sb >> 9) & 1) << 5); R = (st >> 1) * 16 + swz / 64; C = (st & 1) * 32 + (swz % 64) / 2; }
__host__ __device__ __forceinline__ int perm32(int rho) { const int n = rho >> 4, i = rho & 15; return 8 * (i >> 2) + 4 * n + (i & 3); }
struct Unit { int pm, pn; };
struct Gemm { const void* A; const void* Bt; int M, N, Kb, lda, ldb; };
struct StaticOrder {
    int nM, nN, nwg, G, c;
    __device__ void init(int M, int N, int G_, int c_) { nM = M / BM; nN = N / BM; nwg = nM * nN; G = G_; c = c_; }
    __device__ bool next(int i, Unit& u) const {
        const long L = (long)i * G + c; if (L >= nwg) return false;
        int wgid = (int)L; { const int q = nwg / NXCD, r = nwg % NXCD, xcd = wgid % NXCD, off = wgid / NXCD; wgid = (xcd < r ? xcd * (q + 1) : r * (q + 1) + (xcd - r) * q) + off; }
        const int nig = WGM * nN, gid = wgid / nig, fm = gid * WGM, gsz = (nM - fm) < WGM ? (nM - fm) : WGM;
        u.pm = fm + ((wgid % nig) % gsz); u.pn = (wgid % nig) / gsz; return true;
    }
    __device__ __forceinline__ void a_ready(const Unit&) const {}
    __device__ __forceinline__ void done(const Unit&) const {}
};
template <class Epi, class Sched, bool F8 = false, unsigned SCW = 0x7F7F7F7Fu, unsigned SCX = 0x7F7F7F7Fu, bool ALIGN_EPI = true, bool SP2 = true, bool I8 = false>
__device__ __forceinline__ void gemm_phase(LAS unsigned char* lds, const Gemm g, const Sched& S, const Epi& E) {
    const int tid = threadIdx.x, wid = __builtin_amdgcn_readfirstlane(tid >> 6), lane = fresh_lane(), wr = wid >> 2, wc = wid & 3, fr = lane & 15, fq = lane >> 4;
    const int nt = g.Kb / (BK * 2);
    unsigned voffA[2], voffB[2];
#pragma unroll
    for (int i = 0; i < 2; ++i) { int R, C; stage_rc(tid * 16 + i * 8192, R, C); const int Rb = Epi::PERM ? ((R & ~31) + perm32(R & 31)) : R;
        voffA[i] = (unsigned)(R * g.lda + C * 2); voffB[i] = (unsigned)(Rb * g.ldb + C * 2); }
    const size_t kstep = (size_t)(BK * 2);
    const size_t hstepA = (size_t)HALF * g.lda, hstepB = (size_t)HALF * g.ldb;
    const size_t tstepA = 2 * hstepA, tstepB = 2 * hstepB;
    const unsigned ldsw = (unsigned)wid * 1024u;
    const int aoff = lds_byte(wr * 64 + fr, fq * 8), boff = lds_byte(wc * 32 + fr, fq * 8);
#define PG8_SA(b, h) (((b) * 2 + (h)) * HTB)
#define PG8_SB(b, h) ((4 + (b) * 2 + (h)) * HTB)
#define PG8_STAGE(bufoff, gbase, voff) do { _Pragma("unroll") for (int _i = 0; _i < 2; ++_i) \
        __builtin_amdgcn_global_load_lds((const unsigned*)((const char*)(gbase) + (voff)[_i]), (LAS unsigned*)(lds + (bufoff) + ldsw + _i * 8192), 16, 0, 0); } while (0)
    typedef int i32x8_ __attribute__((ext_vector_type(8))); typedef int i32x4_ __attribute__((ext_vector_type(4)));
#define PG8_LD8(ptr_) __builtin_shufflevector(*(const LAS i32x4_*)(ptr_), *(const LAS i32x4_*)((ptr_) + 1024), 0, 1, 2, 3, 4, 5, 6, 7)
#define PG8_LDA(dst, b, h) do { _Pragma("unroll") for (int m = 0; m < 4; ++m) { if constexpr (F8) dst##8[m] = PG8_LD8(lds + PG8_SA(b, h) + aoff + m * 2048); \
        else { _Pragma("unroll") for (int k = 0; k < 2; ++k) dst[m][k] = *(const LAS bf16x8*)(lds + PG8_SA(b, h) + aoff + m * 2048 + k * 1024); } } } while (0)
#define PG8_LDB(dst, b, h) do { _Pragma("unroll") for (int n = 0; n < 2; ++n) { if constexpr (F8) dst##8[n] = PG8_LD8(lds + PG8_SB(b, h) + boff + n * 2048); \
        else { _Pragma("unroll") for (int k = 0; k < 2; ++k) dst[n][k] = *(const LAS bf16x8*)(lds + PG8_SB(b, h) + boff + n * 2048 + k * 1024); } } } while (0)
#define PG8_MMA(ai, bj, At, Bt) do { __builtin_amdgcn_s_setprio(1); _Pragma("unroll") for (int m = 0; m < 4; ++m) _Pragma("unroll") for (int n = 0; n < 2; ++n) { \
        if constexpr (F8) asm volatile("v_mfma_scale_f32_16x16x128_f8f6f4 %0, %1, %2, %0, %3, %4 op_sel_hi:[0,0,0]" : "+v"(acc[ai][bj][m][n]) : "v"(Bt##8[n]), "v"(At##8[m]), "v"(scw_), "v"(scx_)); \
        else if constexpr (I8) { _Pragma("unroll") for (int k = 0; k < 2; ++k) acc[ai][bj][m][n] = __builtin_bit_cast(f32x4, __builtin_amdgcn_mfma_i32_16x16x64_i8(__builtin_bit_cast(i32x4_, Bt[n][k]), __builtin_bit_cast(i32x4_, At[m][k]), __builtin_bit_cast(i32x4_, acc[ai][bj][m][n]), 0, 0, 0)); } \
        else { _Pragma("unroll") for (int k = 0; k < 2; ++k) acc[ai][bj][m][n] = __builtin_amdgcn_mfma_f32_16x16x32_bf16(Bt[n][k], At[m][k], acc[ai][bj][m][n], 0, 0, 0); } } \
        __builtin_amdgcn_s_setprio(0); } while (0)
#define PG8_WAIT_V(n) asm volatile("s_waitcnt vmcnt(" #n ")" ::: "memory")
#define PG8_WAIT_L(n) asm volatile("s_waitcnt lgkmcnt(" #n ")" ::: "memory")
#define PG8_BAR __builtin_amdgcn_s_barrier()
#define PG8_SCHED __builtin_amdgcn_sched_barrier(0)
    Unit cur, nxt; int ui = 0;
    if (!S.next(0, cur)) return;
    f32x4 acc[2][2][4][2];
#pragma unroll
    for (int a = 0; a < 2; ++a)
#pragma unroll
        for (int b = 0; b < 2; ++b)
#pragma unroll
            for (int m = 0; m < 4; ++m)
#pragma unroll
                for (int n = 0; n < 2; ++n) acc[a][b][m][n] = (f32x4){0.f, 0.f, 0.f, 0.f};
    const int scw_ = (int)SCW, scx_ = (int)SCX;
    bf16x8 At[4][2], B0[2][2], B1[2][2]; i32x8_ At8[4], B08[2], B18[2];
    const char* cA = (const char*)g.A + (size_t)cur.pm * tstepA; const char* cB = (const char*)g.Bt + (size_t)cur.pn * tstepB;
    S.a_ready(cur);
    if constexpr (SP2) {
        PG8_STAGE(PG8_SB(0, 0), cB, voffB); PG8_STAGE(PG8_SB(0, 1), cB + hstepB, voffB); PG8_STAGE(PG8_SA(0, 0), cA, voffA); PG8_STAGE(PG8_SA(0, 1), cA + hstepA, voffA);
        if (wr == 1) PG8_BAR;
        PG8_WAIT_V(2); PG8_BAR;
        PG8_STAGE(PG8_SB(1, 0), cB + kstep, voffB); PG8_STAGE(PG8_SA(1, 0), cA + kstep, voffA); PG8_STAGE(PG8_SB(1, 1), cB + hstepB + kstep, voffB);
        PG8_WAIT_V(6); PG8_BAR;
    } else {
        PG8_STAGE(PG8_SB(0, 0), cB, voffB); PG8_STAGE(PG8_SA(0, 0), cA, voffA); PG8_STAGE(PG8_SB(0, 1), cB + hstepB, voffB); PG8_STAGE(PG8_SA(0, 1), cA + hstepA, voffA);
        if (wr == 1) PG8_BAR;
        PG8_WAIT_V(4); PG8_BAR;
        PG8_STAGE(PG8_SB(1, 0), cB + kstep, voffB); PG8_STAGE(PG8_SA(1, 0), cA + kstep, voffA); PG8_STAGE(PG8_SB(1, 1), cB + hstepB + kstep, voffB);
        PG8_WAIT_V(6); PG8_BAR;
    }
    for (;;) {
        const bool has_next = S.next(ui + 1, nxt);
        const char* nA = has_next ? (const char*)g.A + (size_t)nxt.pm * tstepA : cA; const char* nB = has_next ? (const char*)g.Bt + (size_t)nxt.pn * tstepB : cB;
#pragma unroll 1
        for (int t = 0; t < nt; t += 2) {
            const bool last = (t == nt - 2);
            const char* a1 = cA + (size_t)(t + 1) * kstep;
            const char* a2 = last ? nA : cA + (size_t)(t + 2) * kstep; const char* b2 = last ? nB : cB + (size_t)(t + 2) * kstep;
            const char* a3 = a2 + kstep; const char* b3 = b2 + kstep;
            if (last && has_next) S.a_ready(nxt);
            if constexpr (SP2) {
            PG8_LDB(B0, 0, 0); PG8_LDB(B1, 0, 1); PG8_SCHED; PG8_LDA(At, 0, 0); PG8_STAGE(PG8_SA(1, 1), a1 + hstepA, voffA);
            PG8_WAIT_V(8); PG8_WAIT_L(0); PG8_BAR; PG8_MMA(0, 0, At, B0); PG8_MMA(0, 1, At, B1); PG8_BAR; PG8_SCHED;
            PG8_LDA(At, 0, 1); PG8_STAGE(PG8_SB(0, 0), b2, voffB); PG8_STAGE(PG8_SB(0, 1), b2 + hstepB, voffB); PG8_STAGE(PG8_SA(0, 0), a2, voffA);
            PG8_WAIT_V(8); PG8_WAIT_L(0); PG8_BAR; PG8_MMA(1, 0, At, B0); PG8_MMA(1, 1, At, B1); PG8_BAR; PG8_SCHED;
            PG8_LDB(B0, 1, 0); PG8_LDB(B1, 1, 1); PG8_SCHED; PG8_LDA(At, 1, 0); PG8_STAGE(PG8_SA(0, 1), a2 + hstepA, voffA);
            PG8_WAIT_V(8); PG8_WAIT_L(0); PG8_BAR; PG8_MMA(0, 0, At, B0); PG8_MMA(0, 1, At, B1); PG8_BAR; PG8_SCHED;
            PG8_LDA(At, 1, 1); PG8_STAGE(PG8_SB(1, 0), b3, voffB); PG8_STAGE(PG8_SB(1, 1), b3 + hstepB, voffB); PG8_STAGE(PG8_SA(1, 0), a3, voffA);
            PG8_WAIT_V(8); PG8_WAIT_L(0); PG8_BAR; PG8_MMA(1, 0, At, B0); PG8_MMA(1, 1, At, B1); PG8_BAR; PG8_SCHED;
            } else {
            PG8_LDB(B0, 0, 0); PG8_SCHED; PG8_LDA(At, 0, 0); PG8_STAGE(PG8_SA(1, 1), a1 + hstepA, voffA);
            PG8_WAIT_L(8); PG8_BAR; PG8_WAIT_L(0); PG8_MMA(0, 0, At, B0); PG8_BAR; PG8_SCHED;
            PG8_LDB(B1, 0, 1); PG8_STAGE(PG8_SB(0, 0), b2, voffB);
            PG8_BAR; PG8_WAIT_L(0); PG8_MMA(0, 1, At, B1); PG8_BAR;
            PG8_LDA(At, 0, 1); PG8_STAGE(PG8_SA(0, 0), a2, voffA);
            PG8_BAR; PG8_WAIT_L(0); PG8_MMA(1, 0, At, B0); PG8_BAR; PG8_SCHED;
            PG8_STAGE(PG8_SB(0, 1), b2 + hstepB, voffB);
            PG8_WAIT_V(6); PG8_BAR; PG8_MMA(1, 1, At, B1); PG8_BAR;
            PG8_LDB(B0, 1, 0); PG8_SCHED; PG8_LDA(At, 1, 0); PG8_STAGE(PG8_SA(0, 1), a2 + hstepA, voffA);
            PG8_WAIT_L(8); PG8_BAR; PG8_WAIT_L(0); PG8_MMA(0, 0, At, B0); PG8_BAR; PG8_SCHED;
            PG8_LDB(B1, 1, 1); PG8_STAGE(PG8_SB(1, 0), b3, voffB);
            PG8_BAR; PG8_WAIT_L(0); PG8_MMA(0, 1, At, B1); PG8_BAR;
            PG8_LDA(At, 1, 1); PG8_STAGE(PG8_SA(1, 0), a3, voffA);
            PG8_BAR; PG8_WAIT_L(0); PG8_MMA(1, 0, At, B0); PG8_BAR; PG8_SCHED;
            PG8_STAGE(PG8_SB(1, 1), b3 + hstepB, voffB);
            PG8_WAIT_V(6); PG8_BAR; PG8_MMA(1, 1, At, B1); PG8_BAR;
            }
        }
        if constexpr (ALIGN_EPI) { if (wr == 0) PG8_BAR; }
        if constexpr (F8) asm volatile("s_nop 15\n\ts_nop 15" ::: "memory");
        if constexpr (I8) {
#pragma unroll
            for (int a = 0; a < 2; ++a)
#pragma unroll
                for (int b = 0; b < 2; ++b)
#pragma unroll
                    for (int m = 0; m < 4; ++m)
#pragma unroll
                        for (int n = 0; n < 2; ++n)
#pragma unroll
                            for (int e = 0; e < 4; ++e) acc[a][b][m][n][e] = (float)__float_as_int(acc[a][b][m][n][e]);
        }
        E(acc, cur, wr, wc, fr, fq); S.done(cur);
        if (!has_next) break;
#pragma unroll
        for (int a = 0; a < 2; ++a)
#pragma unroll
            for (int b = 0; b < 2; ++b)
#pragma unroll
                for (int m = 0; m < 4; ++m)
#pragma unroll
                    for (int n = 0; n < 2; ++n) acc[a][b][m][n] = (f32x4){0.f, 0.f, 0.f, 0.f};
        cur = nxt; cA = nA; cB = nB; ++ui;
        if constexpr (ALIGN_EPI) { if (wr == 1) PG8_BAR; }
    }
    PG8_WAIT_V(0);
    if constexpr (!ALIGN_EPI) { if (wr == 0) PG8_BAR; }
    PG8_BAR;
#undef PG8_SA
#undef PG8_SB
#undef PG8_STAGE
#undef PG8_LDA
#undef PG8_LDB
#undef PG8_MMA
#undef PG8_WAIT_V
#undef PG8_WAIT_L
#undef PG8_BAR
#undef PG8_SCHED
}
}
template <int MODE> struct EpiRope {
    static constexpr bool PERM = false;
    bf16* O; int ldc; const float* rope; const float* rstd;
    __device__ __forceinline__ void operator()(const f32x4 (&acc)[2][2][4][2], const pg8::Unit& u, int wr, int wc, int fr, int fq) const {
        const int row0 = u.pm * 256 + wr * 64 + fr;
#pragma unroll
        for (int ai = 0; ai < 2; ++ai)
#pragma unroll
            for (int m = 0; m < 4; ++m) {
                const int row = row0 + ai * 128 + m * 16; const bool lat = row < NLAT; const int t = row & 4095, prow = t >> 6, pcol = t & 63;
                bf16* rowp = O + (size_t)row * ldc; float qs = 1.f; if (MODE == 2) qs = rstd[(size_t)row * 2] * (0.10206207261596577f * LOG2E);
#pragma unroll
                for (int bj = 0; bj < 2; ++bj) {
                    const int G = 8 * u.pn + 4 * bj + wc, col = 32 * G + 4 * fq;
                    f32x4 x1 = acc[ai][bj][m][0], x2 = acc[ai][bj][m][1];
                    if (MODE == 1 && G >= 13 && G < 29) { x1 = x1 * (0.125f * LOG2E); x2 = x2 * (0.125f * LOG2E); }
                    if (MODE == 2) { x1 = x1 * qs; x2 = x2 * qs; }
                    int kind = 0, par = 0;
                    if (MODE == 0) { kind = (G >= 48 && G < 68) ? 1 : 0; par = G & 1; }
                    if (MODE == 1) { kind = (G == 12) ? 2 : ((G >= 13 && G < 45) ? 1 : 0); par = (G + 1) & 1; }
                    if (MODE == 2) { kind = (G % 3 == 2) ? 2 : 0; }
                    if (lat && kind == 1) {
                        const int pos = par ? pcol : prow;
                        const f32x4 c = *(const f32x4*)(rope + pos * 16 + 4 * fq), s = *(const f32x4*)(rope + 1024 + pos * 16 + 4 * fq);
                        const f32x4 o1 = x1 * c - x2 * s, o2 = x1 * s + x2 * c; x1 = o1; x2 = o2;
                    } else if (lat && kind == 2) {
                        const int pos = (fq < 2) ? prow : pcol;
                        const f32x4 c = *(const f32x4*)(rope + 2048 + pos * 8 + (4 * fq & 7)), s = *(const f32x4*)(rope + 2560 + pos * 8 + (4 * fq & 7));
                        const f32x4 o1 = x1 * c - x2 * s, o2 = x1 * s + x2 * c; x1 = o1; x2 = o2;
                    }
                    u32x2 w0, w1; w0.x = cvt_pk_bf16(x1[0], x1[1]); w0.y = cvt_pk_bf16(x1[2], x1[3]); w1.x = cvt_pk_bf16(x2[0], x2[1]); w1.y = cvt_pk_bf16(x2[2], x2[3]);
                    const auto sx = __builtin_amdgcn_permlane16_swap(w0.x, w1.x, false, false), sy = __builtin_amdgcn_permlane16_swap(w0.y, w1.y, false, false);
                    u32x4 wv; wv.x = sx[0]; wv.y = sy[0]; wv.z = sx[1]; wv.w = sy[1];
                    *(u32x4*)(rowp + col + ((fq & 1) ? 12 : 0)) = wv;
                }
                __builtin_amdgcn_sched_barrier(0);
            }
    }
};
struct EpiBf16 {
    static constexpr bool PERM = true;
    bf16* O; int ldc; const float* rstd; int ridx;
    __device__ __forceinline__ void operator()(const f32x4 (&acc)[2][2][4][2], const pg8::Unit& u, int wr, int wc, int fr, int fq) const {
        const int row0 = u.pm * 256 + wr * 64 + fr, col0 = u.pn * 256 + wc * 32 + 8 * fq;
#pragma unroll
        for (int ai = 0; ai < 2; ++ai)
#pragma unroll
            for (int m = 0; m < 4; ++m) {
                const int row = row0 + ai * 128 + m * 16; float rs = 1.f; if (rstd) rs = rstd[(size_t)row * 2 + ridx];
                bf16* rowp = O + (size_t)row * ldc + col0;
#pragma unroll
                for (int bj = 0; bj < 2; ++bj) { const f32x4 v0 = acc[ai][bj][m][0] * rs, v1 = acc[ai][bj][m][1] * rs;
                    u32x4 w; w.x = cvt_pk_bf16(v0[0], v0[1]); w.y = cvt_pk_bf16(v0[2], v0[3]); w.z = cvt_pk_bf16(v1[0], v1[1]); w.w = cvt_pk_bf16(v1[2], v1[3]);
                    *(u32x4*)(rowp + bj * 128) = w; }
            }
    }
};
struct EpiScore {
    static constexpr bool PERM = true;
    bf16* O; int ldc; const float* xs; const float* ws;
    __device__ __forceinline__ void operator()(const f32x4 (&acc)[2][2][4][2], const pg8::Unit& u, int wr, int wc, int fr, int fq) const {
        const int row0 = u.pm * 256 + wr * 64 + fr, col0 = u.pn * 256 + wc * 32 + 8 * fq;
        f32x4 cs[2][2];
#pragma unroll
        for (int bj = 0; bj < 2; ++bj) { cs[bj][0] = *(const f32x4*)(ws + col0 + bj * 128); cs[bj][1] = *(const f32x4*)(ws + col0 + bj * 128 + 4); }
#pragma unroll
        for (int ai = 0; ai < 2; ++ai)
#pragma unroll
            for (int m = 0; m < 4; ++m) {
                const int row = row0 + ai * 128 + m * 16; const float rs = xs[row];
                bf16* rowp = O + (size_t)row * ldc + col0;
#pragma unroll
                for (int bj = 0; bj < 2; ++bj) { const f32x4 v0 = acc[ai][bj][m][0] * rs * cs[bj][0], v1 = acc[ai][bj][m][1] * rs * cs[bj][1];
                    u32x4 w; w.x = cvt_pk_bf16(v0[0], v0[1]); w.y = cvt_pk_bf16(v0[2], v0[3]); w.z = cvt_pk_bf16(v1[0], v1[1]); w.w = cvt_pk_bf16(v1[2], v1[3]);
                    *(u32x4*)(rowp + bj * 128) = w; }
            }
    }
};
template <bool F32BASE> struct EpiResid {
    static constexpr bool PERM = true;
    const float* base_lat; const float* base_ctx; bf16* res; const float* gate;
    __device__ __forceinline__ void operator()(const f32x4 (&acc)[2][2][4][2], const pg8::Unit& u, int wr, int wc, int fr, int fq) const {
        const int row0 = u.pm * 256 + wr * 64 + fr, col0 = u.pn * 256 + wc * 32 + 8 * fq;
#pragma unroll
        for (int ai = 0; ai < 2; ++ai)
#pragma unroll
            for (int m = 0; m < 4; ++m) {
                const int row = row0 + ai * 128 + m * 16; const bool lat = row < NLAT; const int rr = lat ? row : row - NLAT, br = lat ? (row >> 12) : 16;
                const float* bp = (lat ? base_lat : base_ctx) + (size_t)rr * DM + col0; bf16* op = res + (size_t)row * DM + col0;
                const float* gp = gate + (size_t)br * 6144 + col0;
#pragma unroll
                for (int bj = 0; bj < 2; ++bj) {
                    const f32x4 g0 = *(const f32x4*)(gp + bj * 128), g1 = *(const f32x4*)(gp + bj * 128 + 4);
                    f32x4 b0, b1;
                    if constexpr (F32BASE) { b0 = *(const f32x4*)(bp + bj * 128); b1 = *(const f32x4*)(bp + bj * 128 + 4); }
                    else { const u32x4 rb = *(const u32x4*)(op + bj * 128); b0 = (f32x4){bf_lo(rb.x), bf_hi(rb.x), bf_lo(rb.y), bf_hi(rb.y)}; b1 = (f32x4){bf_lo(rb.z), bf_hi(rb.z), bf_lo(rb.w), bf_hi(rb.w)}; }
                    const f32x4 v0 = b0 + g0 * acc[ai][bj][m][0], v1 = b1 + g1 * acc[ai][bj][m][1];
                    u32x4 w; w.x = cvt_pk_bf16(v0[0], v0[1]); w.y = cvt_pk_bf16(v0[2], v0[3]); w.z = cvt_pk_bf16(v1[0], v1[1]); w.w = cvt_pk_bf16(v1[2], v1[3]);
                    *(u32x4*)(op + bj * 128) = w;
                }
            }
    }
};
__device__ __forceinline__ int crow(int r, int h) { return (r & 3) + 8 * (r >> 2) + 4 * h; }
__device__ __forceinline__ float fexp2(float x) { return __builtin_amdgcn_exp2f(x); }
__device__ __forceinline__ float max3f(float a, float b, float c) { float r; asm("v_max3_f32 %0, %1, %2, %3" : "=v"(r) : "v"(a), "v"(b), "v"(c)); return r; }
#ifndef ATT_SETPRIO
#define ATT_SETPRIO 0
#endif
#ifndef ATT_STAGGER
#define ATT_STAGGER 0
#endif
#if defined(ATT_PROBE)
#define ABL(k) (ABLV == (k))
#else
#define ABL(k) false
#endif
#ifndef ATT_OVF_TEST
constexpr float ATT_OVF = 1.152921504606847e18f;
#else
constexpr float ATT_OVF = -1.0f;
#endif
constexpr float ATT_THR = 10.0f;

__device__ __forceinline__ float xmax32(float v) { const auto r = __builtin_amdgcn_permlane32_swap(__float_as_uint(v), __float_as_uint(v), false, false); return fmaxf(__uint_as_float(r[0]), __uint_as_float(r[1])); }
__device__ __forceinline__ float xsum32(float v) { const auto r = __builtin_amdgcn_permlane32_swap(__float_as_uint(v), __float_as_uint(v), false, false); return __uint_as_float(r[0]) + __uint_as_float(r[1]); }
template <class P, bool LATE, int ABLV = 0>
__device__ __forceinline__ void attn_tile_a(const LAS unsigned char* Kt, const LAS unsigned char* Vt, const bf16x8 (&qf)[P::DK / 16], f32x16 (&O)[P::DV / 32], float& m, float& l, int lane, const P& p, int t,
                                            bf16x8 (&pf)[2][2], s16x4 (&vq)[P::DV / 32][2][2][2], f32x16& negm) {
    constexpr int DK = P::DK, DV = P::DV, KRS = DK * 2 + 16, NDB = DV / 32;
    const int r32 = lane & 31, h = lane >> 5;
    constexpr int NS = DK / 16;
    bf16x8 kf[NS][2];
#define AT_KREAD(s_) do { kf[s_][0] = *(const LAS bf16x8*)(Kt + r32 * KRS + (16 * (s_) + 8 * h) * 2); kf[s_][1] = *(const LAS bf16x8*)(Kt + (32 + r32) * KRS + (16 * (s_) + 8 * h) * 2); } while (0)
    f32x16 s0, s1; float ps;
    bool exact = (t == 0);
    for (;;) {
    AT_KREAD(0); AT_KREAD(1);
    __builtin_amdgcn_sched_barrier(0);
#pragma unroll
    for (int i = 0; i < 16; ++i) { s0[i] = 0.f; s1[i] = 0.f; }
#if ATT_SETPRIO
    __builtin_amdgcn_s_setprio(1);
#endif
#pragma unroll
    for (int s = 0; s < NS; ++s) {
        if (s + 2 < NS) AT_KREAD(s + 2);
        if (P::PRE && s == 0) { s0 = __builtin_amdgcn_mfma_f32_32x32x16_bf16(kf[s][0], qf[s], negm, 0, 0, 0); s1 = __builtin_amdgcn_mfma_f32_32x32x16_bf16(kf[s][1], qf[s], negm, 0, 0, 0); }
        else if (!ABL(2) && !ABL(3)) { s0 = __builtin_amdgcn_mfma_f32_32x32x16_bf16(kf[s][0], qf[s], s0, 0, 0, 0); s1 = __builtin_amdgcn_mfma_f32_32x32x16_bf16(kf[s][1], qf[s], s1, 0, 0, 0); }
        else { s0[0] += __builtin_bit_cast(float, (int)kf[s][0][0]); s1[0] += __builtin_bit_cast(float, (int)kf[s][1][0]); }
        __builtin_amdgcn_sched_barrier(0);
    }
#if ATT_SETPRIO
    __builtin_amdgcn_s_setprio(0);
#endif
    const int lanebase = ((lane >> 5) * 4 + ((lane >> 2) & 3)) * 64 + ((lane >> 4) & 1) * 32 + (lane & 3) * 8;
    if constexpr (!LATE) {
#pragma unroll
        for (int db = 0; db < (NDB > 2 ? 2 : NDB); ++db)
#pragma unroll
            for (int b = 0; b < 2; ++b)
#pragma unroll
                for (int s2 = 0; s2 < 2; ++s2)
#pragma unroll
                    for (int tq = 0; tq < 2; ++tq) vq[db][b][s2][tq] = __builtin_amdgcn_ds_read_tr16_b64_v4i16((LAS s16x4*)(Vt + ((4 * b + 2 * s2 + tq) * NDB + db) * 512 + lanebase));
    }
    __builtin_amdgcn_sched_barrier(0);
    ps = 0.f;
    if constexpr (P::MASKED) {
        p.mask(t, s0, s1, lane);
        float mx = fmaxf(s0[0], s1[0]);
#pragma unroll
        for (int i = 1; i < 16; ++i) mx = max3f(mx, s0[i], s1[i]);
        mx = xmax32(mx);
        if (__builtin_amdgcn_ballot_w64(mx > m + ATT_THR) != 0ull) {
            const float mn = fmaxf(m, mx), alpha = fexp2(m - mn); m = mn; l *= alpha;
#pragma unroll
            for (int db = 0; db < NDB; ++db) O[db] = O[db] * alpha;
            asm volatile("" ::: "memory");
        }
#pragma unroll
        for (int i = 0; i < 16; ++i) { const float a = fexp2(s0[i] - m), b = fexp2(s1[i] - m); s0[i] = a; s1[i] = b; ps += a + b; }
    } else if constexpr (P::PRE) {
        if (exact) {
            float mx = fmaxf(s0[0], s1[0]);
#pragma unroll
            for (int i = 1; i < 16; ++i) mx = max3f(mx, s0[i], s1[i]);
            mx = xmax32(mx);
            const float d = (t == 0) ? mx : fmaxf(mx, 0.f);
            if (t != 0) { const float alpha = fexp2(-d); l *= alpha;
#pragma unroll
                for (int db = 0; db < NDB; ++db) O[db] = O[db] * alpha; }
            m += d;
#pragma unroll
            for (int i = 0; i < 16; ++i) { s0[i] -= d; s1[i] -= d; negm[i] = -m; }
            asm volatile("" ::: "memory");
        }
#pragma unroll
        for (int i = 0; i < 16; ++i) { const float a = fexp2(s0[i]), b = fexp2(s1[i]); s0[i] = a; s1[i] = b; ps += a + b; }
    } else {
        const float c2 = p.c2;
        float mx = fmaxf(s0[0], s1[0]);
#pragma unroll
        for (int i = 1; i < 16; ++i) mx = max3f(mx, s0[i], s1[i]);
        mx = xmax32(mx) * c2;
        if (__builtin_amdgcn_ballot_w64(mx > m + ATT_THR) != 0ull) {
            const float mn = fmaxf(m, mx), alpha = fexp2(m - mn); m = mn; l *= alpha;
#pragma unroll
            for (int db = 0; db < NDB; ++db) O[db] = O[db] * alpha;
            asm volatile("" ::: "memory");
        }
        const float nm = -m;
        if (!ABL(1) && !ABL(3)) {
#pragma unroll
        for (int i = 0; i < 16; ++i) { const float a = fexp2(fmaf(s0[i], c2, nm)), b = fexp2(fmaf(s1[i], c2, nm)); s0[i] = a; s1[i] = b; ps += a + b; }
        } else ps = 1.f;
    }
    if constexpr (P::PRE) { if (exact || __builtin_amdgcn_ballot_w64(!(ps <= ATT_OVF)) == 0ull) break; exact = true; }
    else break;
    }
    l += ps;
#pragma unroll
    for (int s2 = 0; s2 < 2; ++s2) {
        u32x4 w0, w1;
        w0.x = cvt_pk_bf16(s0[8 * s2 + 0], s0[8 * s2 + 1]); w0.y = cvt_pk_bf16(s0[8 * s2 + 2], s0[8 * s2 + 3]); w0.z = cvt_pk_bf16(s0[8 * s2 + 4], s0[8 * s2 + 5]); w0.w = cvt_pk_bf16(s0[8 * s2 + 6], s0[8 * s2 + 7]);
        w1.x = cvt_pk_bf16(s1[8 * s2 + 0], s1[8 * s2 + 1]); w1.y = cvt_pk_bf16(s1[8 * s2 + 2], s1[8 * s2 + 3]); w1.z = cvt_pk_bf16(s1[8 * s2 + 4], s1[8 * s2 + 5]); w1.w = cvt_pk_bf16(s1[8 * s2 + 6], s1[8 * s2 + 7]);
        pf[0][s2] = __builtin_bit_cast(bf16x8, w0); pf[1][s2] = __builtin_bit_cast(bf16x8, w1);
    }
    __builtin_amdgcn_sched_barrier(0);
#undef AT_KREAD
}
template <class P, bool LATE, int ABLV = 0>
__device__ __forceinline__ void attn_tile_b(f32x16 (&O)[P::DV / 32], const bf16x8 (&pf)[2][2], s16x4 (&vq)[P::DV / 32][2][2][2], const LAS unsigned char* Vt, int lane) {
    constexpr int NDB = P::DV / 32;
    if constexpr (LATE) {
        const int lanebase = ((lane >> 5) * 4 + ((lane >> 2) & 3)) * 64 + ((lane >> 4) & 1) * 32 + (lane & 3) * 8;
#pragma unroll
        for (int db = 0; db < NDB; ++db)
#pragma unroll
            for (int b = 0; b < 2; ++b)
#pragma unroll
                for (int s2 = 0; s2 < 2; ++s2)
#pragma unroll
                    for (int tq = 0; tq < 2; ++tq) vq[db][b][s2][tq] = __builtin_amdgcn_ds_read_tr16_b64_v4i16((LAS s16x4*)(Vt + ((4 * b + 2 * s2 + tq) * NDB + db) * 512 + lanebase));
        __builtin_amdgcn_sched_barrier(0);
    }
    if constexpr (!LATE && NDB > 2) {
        const int lanebase = ((lane >> 5) * 4 + ((lane >> 2) & 3)) * 64 + ((lane >> 4) & 1) * 32 + (lane & 3) * 8;
#pragma unroll
        for (int db = 2; db < NDB; ++db)
#pragma unroll
            for (int b = 0; b < 2; ++b)
#pragma unroll
                for (int s2 = 0; s2 < 2; ++s2)
#pragma unroll
                    for (int tq = 0; tq < 2; ++tq) vq[db][b][s2][tq] = __builtin_amdgcn_ds_read_tr16_b64_v4i16((LAS s16x4*)(Vt + ((4 * b + 2 * s2 + tq) * NDB + db) * 512 + lanebase));
    }
#pragma unroll
    for (int db = 0; db < NDB; ++db)
#pragma unroll
        for (int b = 0; b < 2; ++b)
#pragma unroll
            for (int s2 = 0; s2 < 2; ++s2) {
                if (NDB > 2 && db == 2 && b == 0 && s2 == 0) __builtin_amdgcn_sched_barrier(0);
                const s16x4 v0 = vq[db][b][s2][0], v1 = vq[db][b][s2][1];
                const bf16x8 vf = {v0[0], v0[1], v0[2], v0[3], v1[0], v1[1], v1[2], v1[3]};
                if (!ABL(2) && !ABL(3)) O[db] = __builtin_amdgcn_mfma_f32_32x32x16_bf16(vf, pf[b][s2], O[db], 0, 0, 0);
                else O[db][0] += __builtin_bit_cast(float, (int)vf[0]) + __builtin_bit_cast(float, (int)pf[b][s2][0]);
            }
}

template <class P>
__device__ __forceinline__ void attn_tile_na(const LAS unsigned char* Kt, const LAS unsigned char* Vt, const bf16x8 (&qf)[4], f32x16 (&O)[2], float& m, float& l, int lane, const P& p, int t) {
    constexpr int KRS = 64 * 2 + 16, NDB = 2;
    const int r32 = lane & 31, h = lane >> 5;
    const LAS unsigned char* kb = Kt + (p.cs + r32) * KRS + 16 * h;
    bf16x8 kf[4];
#pragma unroll
    for (int s = 0; s < 4; ++s) kf[s] = *(const LAS bf16x8*)(kb + 32 * s);
    const int lanebase = ((lane >> 5) * 4 + ((lane >> 2) & 3)) * 64 + ((lane >> 4) & 1) * 32 + (lane & 3) * 8;
    const LAS unsigned char* vb = Vt + (p.cs >> 3) * (NDB * 512) + lanebase;
    s16x4 vq[NDB][2][2];
#pragma unroll
    for (int db = 0; db < NDB; ++db)
#pragma unroll
        for (int s2 = 0; s2 < 2; ++s2)
#pragma unroll
            for (int tq = 0; tq < 2; ++tq) vq[db][s2][tq] = __builtin_amdgcn_ds_read_tr16_b64_v4i16((LAS s16x4*)(vb + ((2 * s2 + tq) * NDB + db) * 512));
    const int kr = p.lo + t - 4; const int br = (kr >= p.r0i && kr < p.r0i + 8) ? kr - p.qi + 7 : 15;
    const LAS unsigned char* rb = (const LAS unsigned char*)(p.rpb + br * 32);
    const float c2 = 0.125f * LOG2E;
    f32x16 s0; float ps; bool exact = false;
    for (;;) {
#pragma unroll
        for (int i = 0; i < 16; ++i) s0[i] = 0.f;
#pragma unroll
        for (int s = 0; s < 4; ++s) s0 = __builtin_amdgcn_mfma_f32_32x32x16_bf16(kf[s], qf[s], s0, 0, 0, 0);
#pragma unroll
        for (int i = 0; i < 16; ++i) { const unsigned off = (i & 1) ? (p.dpk[i >> 1] >> 16) : (p.dpk[i >> 1] & 0xffffu); s0[i] = fmaf(s0[i], c2, *(const LAS float*)(rb + off)); }
        if (exact) {
            float mx = s0[0];
#pragma unroll
            for (int i = 1; i < 15; i += 2) mx = max3f(mx, s0[i], s0[i + 1]);
            mx = xmax32(fmaxf(mx, s0[15]));
            const float mn = fmaxf(m, mx), alpha = fexp2(m - mn); m = mn; l *= alpha;
#pragma unroll
            for (int db = 0; db < NDB; ++db) O[db] = O[db] * alpha;
            asm volatile("" ::: "memory");
        }
        ps = 0.f;
#pragma unroll
        for (int i = 0; i < 16; ++i) { const float a = fexp2(s0[i] - m); s0[i] = a; ps += a; }
        if (exact || __builtin_amdgcn_ballot_w64(!(ps <= ATT_OVF)) == 0ull) break;
        exact = true;
    }
    l += ps;
    bf16x8 pf[2];
#pragma unroll
    for (int s2 = 0; s2 < 2; ++s2) { u32x4 w0;
        w0.x = cvt_pk_bf16(s0[8 * s2 + 0], s0[8 * s2 + 1]); w0.y = cvt_pk_bf16(s0[8 * s2 + 2], s0[8 * s2 + 3]); w0.z = cvt_pk_bf16(s0[8 * s2 + 4], s0[8 * s2 + 5]); w0.w = cvt_pk_bf16(s0[8 * s2 + 6], s0[8 * s2 + 7]);
        pf[s2] = __builtin_bit_cast(bf16x8, w0); }
#pragma unroll
    for (int db = 0; db < NDB; ++db)
#pragma unroll
        for (int s2 = 0; s2 < 2; ++s2) { const s16x4 v0 = vq[db][s2][0], v1 = vq[db][s2][1];
            const bf16x8 vf = {v0[0], v0[1], v0[2], v0[3], v1[0], v1[1], v1[2], v1[3]};
            O[db] = __builtin_amdgcn_mfma_f32_32x32x16_bf16(vf, pf[s2], O[db], 0, 0, 0); }
}

template <class P, int ABLV = 0>
__device__ __forceinline__ void attn_unit(LAS unsigned char* lds, const P& p, const bf16* qptr, float m, float l, f32x16 (&O)[P::DV / 32]) {
    constexpr int DK = P::DK, DV = P::DV, KRS = DK * 2 + 16, KBYTES = 64 * KRS, VBYTES = 64 * DV * 2, NDB = DV / 32, NV = DV / 64, VCH = DV / 8;
    const int tid = fresh_tid(), lane = fresh_lane(), h = lane >> 5;
    bf16x8 qf[DK / 16];
#pragma unroll
    for (int s = 0; s < DK / 16; ++s) qf[s] = *(const bf16x8*)(qptr + 16 * s + 8 * h);
#pragma unroll
    for (int db = 0; db < NDB; ++db)
#pragma unroll
        for (int i = 0; i < 16; ++i) O[db][i] = 0.f;
    const int kkey = tid >> 3, kch = tid & 7, k2key = tid >> 2, k2ch = tid & 3;
    u32x4 kr, kr2 = (u32x4){0u, 0u, 0u, 0u}, vr[NV];
#define AT_LOAD(t_) do { const bf16 *kp_, *k2p_, *vp_; p.src((t_), kp_, k2p_, vp_); kr = *(const u32x4*)(kp_ + (size_t)kkey * p.ldk + kch * 8); \
        if (DK == 96) { if (tid < 256) kr2 = *(const u32x4*)(k2p_ + (size_t)k2key * p.ldk2 + k2ch * 8); } \
        _Pragma("unroll") for (int i_ = 0; i_ < NV; ++i_) { const int c_ = tid + 512 * i_, key_ = c_ / VCH, ch_ = c_ % VCH; vr[i_] = *(const u32x4*)(vp_ + (size_t)key_ * p.ldv + ch_ * 8); } } while (0)
#define AT_STORE(buf_, vbuf_) do { LAS unsigned char* kb_ = lds + (buf_) * KBYTES; LAS unsigned char* vb_ = lds + 2 * KBYTES + (vbuf_) * VBYTES; \
        *(LAS u32x4*)(kb_ + kkey * KRS + kch * 16) = kr; if (DK == 96) { if (tid < 256) *(LAS u32x4*)(kb_ + k2key * KRS + 128 + k2ch * 16) = kr2; } \
        _Pragma("unroll") for (int i_ = 0; i_ < NV; ++i_) { const int c_ = tid + 512 * i_, key_ = c_ / VCH, ch_ = c_ % VCH; \
            *(LAS u32x4*)(vb_ + ((key_ >> 3) * NDB + (ch_ >> 2)) * 512 + (key_ & 7) * 64 + (ch_ & 3) * 16) = vr[i_]; } } while (0)
    const int nt = p.nt;
    const bool late = P::STAGGER && __builtin_amdgcn_readfirstlane(tid >> 6) >= 4; bool pend = false;
    bf16x8 pf[2][2]; s16x4 vq[NDB][2][2][2]; f32x16 negm;
    if constexpr (P::PRE) { m = 0.f;
#pragma unroll
        for (int i = 0; i < 16; ++i) negm[i] = 0.f; }
#pragma unroll
    for (int i = 0; i < 2; ++i)
#pragma unroll
        for (int j = 0; j < 2; ++j) pf[i][j] = (bf16x8){0, 0, 0, 0, 0, 0, 0, 0};
#pragma unroll
    for (int db = 0; db < NDB; ++db)
#pragma unroll
        for (int i = 0; i < 8; ++i) vq[db][i >> 2][(i >> 1) & 1][i & 1] = (s16x4){0, 0, 0, 0};
    u32x4 krB, kr2B = (u32x4){0u, 0u, 0u, 0u}, vrB[NV];
#define AT_SWAP_IN_B() do { kr = krB; kr2 = kr2B; _Pragma("unroll") for (int i_ = 0; i_ < NV; ++i_) vr[i_] = vrB[i_]; } while (0)
#define AT_LOADB(t_) do { const bf16 *kp_, *k2p_, *vp_; p.src((t_), kp_, k2p_, vp_); krB = *(const u32x4*)(kp_ + (size_t)kkey * p.ldk + kch * 8); \
        if (DK == 96) { if (tid < 256) kr2B = *(const u32x4*)(k2p_ + (size_t)k2key * p.ldk2 + k2ch * 8); } \
        _Pragma("unroll") for (int i_ = 0; i_ < NV; ++i_) { const int c_ = tid + 512 * i_, key_ = c_ / VCH, ch_ = c_ % VCH; vrB[i_] = *(const u32x4*)(vp_ + (size_t)key_ * p.ldv + ch_ * 8); } } while (0)
    AT_LOAD(0); AT_STORE(0, 0);
    if (nt > 1) AT_LOAD(1);
    __syncthreads();
    for (int t = 0; t < nt; ++t) {
        if (t + 2 < nt) AT_LOADB(t + 2);
        if (p.active(t)) {
            bool done = false;
            if constexpr (P::NAHALF) { if (t >= 4) { attn_tile_na<P>(lds + (t & 1) * KBYTES, lds + 2 * KBYTES + (t & 1) * VBYTES, qf, O, m, l, lane, p, t); done = true; } }
            if (!done) {
                attn_tile_a<P, false, ABLV>(lds + (t & 1) * KBYTES, lds + 2 * KBYTES + (t & 1) * VBYTES, qf, O, m, l, lane, p, t, pf, vq, negm);
                attn_tile_b<P, false, ABLV>(O, pf, vq, lds + 2 * KBYTES + (t & 1) * VBYTES, lane);
            }
        }
        if (t + 1 < nt) AT_STORE((t + 1) & 1, (t + 1) & 1);
        AT_SWAP_IN_B();
        __syncthreads();
    }
#undef AT_SWAP_IN_B
#undef AT_LOADB
#undef AT_LOAD
#undef AT_STORE
    const float lt = xsum32(l), inv = lt > 0.f ? 1.f / lt : 0.f;
#pragma unroll
    for (int db = 0; db < NDB; ++db) O[db] = O[db] * inv;
}
template <int NDB> __device__ __forceinline__ void store_o8(unsigned char* orow, const f32x16 (&O)[NDB], int h) {
#pragma unroll
    for (int db = 0; db < NDB; ++db)
#pragma unroll
        for (int g = 0; g < 4; ++g) *(unsigned*)(orow + 32 * db + 8 * g + 4 * h) = pk_fp8x4(O[db][4 * g] * 16.f, O[db][4 * g + 1] * 16.f, O[db][4 * g + 2] * 16.f, O[db][4 * g + 3] * 16.f);
}
template <int NDB> __device__ __forceinline__ void store_o(bf16* orow, const f32x16 (&O)[NDB], int h) {
#pragma unroll
    for (int db = 0; db < NDB; ++db)
#pragma unroll
        for (int g = 0; g < 4; ++g) { u32x2 w; w.x = cvt_pk_bf16(O[db][4 * g], O[db][4 * g + 1]); w.y = cvt_pk_bf16(O[db][4 * g + 2], O[db][4 * g + 3]); *(u32x2*)(orow + 32 * db + 8 * g + 4 * h) = w; }
}

template <int DK_, int DV_, bool PRE_ = false> struct PolPlain {
    static constexpr int DK = DK_, DV = DV_; static constexpr bool PRE = PRE_, NAHALF = false, MASKED = false, STAGGER = ATT_STAGGER && (DV_ == 64) && (DK_ == 96);
    const bf16 *kb, *k2b, *vb; int ldk, ldk2, ldv; int lat0, ctx0, nlat, nt; float c2;
    __device__ __forceinline__ void src(int t, const bf16*& k, const bf16*& k2, const bf16*& v) const {
        const int row = (t < nlat) ? lat0 + 64 * t : ctx0 + 64 * (t - nlat);
        k = kb + (size_t)row * ldk; k2 = k2b + (size_t)row * ldk2; v = vb + (size_t)row * ldv; }
    __device__ __forceinline__ bool active(int) const { return true; }
    __device__ __forceinline__ void mask(int, f32x16& s0, f32x16& s1, int) const { s0 = s0 * c2; s1 = s1 * c2; }
};
struct PolNA {
    static constexpr int DK = 64, DV = 64; static constexpr bool MASKED = true, STAGGER = false, PRE = false, NAHALF = true;
    const bf16 *kb, *k2b, *vb; int ldk, ldk2, ldv; int lat0, ctx0, lo, nt; int ra, rb, cs; const LAS float* rpb;
    int qi, r0i, qc;
    __device__ __forceinline__ void src(int t, const bf16*& k, const bf16*& k2, const bf16*& v) const {
        const int row = (t < 4) ? ctx0 + 64 * t : lat0 + 64 * (lo + t - 4);
        k = kb + (size_t)row * ldk; k2 = k; v = vb + (size_t)row * ldv; }
    __device__ __forceinline__ bool active(int t) const { const int kr = lo + t - 4; return t < 4 || (kr >= ra && kr < rb + 8); }
    unsigned dpk[8];
    __device__ __forceinline__ void init_lane(int lane) {
        const int h = lane >> 5, wc = iclamp_(qc - 8, 0, 48);
#pragma unroll
        for (int i = 0; i < 16; ++i) {
            const int kc = cs + crow(i, h); const int d = (kc >= wc && kc < wc + 16) ? min(max(kc - qc + 15, 0), 30) : 31;
            if (i & 1) dpk[i >> 1] |= (unsigned)(d * 4) << 16; else dpk[i >> 1] = (unsigned)(d * 4);
        }
    }
    static __device__ __forceinline__ int iclamp_(int v, int lo_, int hi_) { return v < lo_ ? lo_ : (v > hi_ ? hi_ : v); }
    __device__ __forceinline__ void mask(int, f32x16& s0, f32x16& s1, int) const { const float c2 = 0.125f * LOG2E; s0 = s0 * c2; s1 = s1 * c2; }
};
struct PolSWA {
    static constexpr int DK = 64, DV = 64; static constexpr bool MASKED = true, STAGGER = false, PRE = false, NAHALF = false;
    const bf16 *kb, *k2b, *vb; int ldk, ldk2, ldv; int lat0, ctx0, pos0, nt; int qp;
    __device__ __forceinline__ void src(int t, const bf16*& k, const bf16*& k2, const bf16*& v) const {
        const int row = (t < 4) ? ctx0 + 64 * t : lat0 + pos0 + 64 * (t - 4);
        k = kb + (size_t)row * ldk; k2 = k; v = vb + (size_t)row * ldv; }
    __device__ __forceinline__ bool active(int) const { return true; }
    __device__ __forceinline__ void mask(int t, f32x16& s0, f32x16& s1, int lane) const {
        const float c2 = 0.125f * LOG2E;
        if (t < 4) { s0 = s0 * c2; s1 = s1 * c2; return; }
        const int h = lane >> 5, kp0 = pos0 + 64 * (t - 4) - qp;
#pragma unroll
        for (int i = 0; i < 16; ++i) {
            const int d0 = kp0 + crow(i, h), d1 = d0 + 32;
            s0[i] = (d0 >= -128 && d0 <= 128) ? s0[i] * c2 : NEGBIG; s1[i] = (d1 >= -128 && d1 <= 128) ? s1[i] * c2 : NEGBIG;
        }
    }
};
__device__ __forceinline__ bool attn_unit64(LAS unsigned char* lds, const PolPlain<96, 64, true>& p, const bf16* qp0, const bf16* qp1, f32x16 (&O)[2][2]) {
    constexpr int DK = 96, DV = 64, KRS = DK * 2 + 16, KBYTES = 64 * KRS, VBYTES = 64 * DV * 2, NDB = 2, NS = 6;
    const int tid = fresh_tid(), lane = fresh_lane(), h = lane >> 5, r32 = lane & 31;
    bf16x8 qf[2][NS];
#pragma unroll
    for (int s = 0; s < NS; ++s) { qf[0][s] = *(const bf16x8*)(qp0 + 16 * s + 8 * h); qf[1][s] = *(const bf16x8*)(qp1 + 16 * s + 8 * h); }
#pragma unroll
    for (int g = 0; g < 2; ++g)
#pragma unroll
        for (int db = 0; db < NDB; ++db)
#pragma unroll
            for (int i = 0; i < 16; ++i) O[g][db][i] = 0.f;
    float l0 = 0.f, l1 = 0.f; bool alarm = false;
    const int kkey = tid >> 3, kch = tid & 7, k2key = tid >> 2, k2ch = tid & 3;
    const int lanebase = ((lane >> 5) * 4 + ((lane >> 2) & 3)) * 64 + ((lane >> 4) & 1) * 32 + (lane & 3) * 8;
    u32x4 kr, kr2 = (u32x4){0u, 0u, 0u, 0u}, vr;
#define A6_LOAD(t_) do { const bf16 *kp_, *k2p_, *vp_; p.src((t_), kp_, k2p_, vp_); kr = *(const u32x4*)(kp_ + (size_t)kkey * p.ldk + kch * 8); \
        if (tid < 256) kr2 = *(const u32x4*)(k2p_ + (size_t)k2key * p.ldk2 + k2ch * 8); vr = *(const u32x4*)(vp_ + (size_t)(tid >> 3) * p.ldv + (tid & 7) * 8); } while (0)
#define A6_STORE(buf_) do { LAS unsigned char* kb_ = lds + (buf_) * KBYTES; LAS unsigned char* vb_ = lds + 2 * KBYTES + (buf_) * VBYTES; \
        *(LAS u32x4*)(kb_ + kkey * KRS + kch * 16) = kr; if (tid < 256) *(LAS u32x4*)(kb_ + k2key * KRS + 128 + k2ch * 16) = kr2; \
        { const int key_ = tid >> 3, ch_ = tid & 7; *(LAS u32x4*)(vb_ + ((key_ >> 3) * NDB + (ch_ >> 2)) * 512 + (key_ & 7) * 64 + (ch_ & 3) * 16) = vr; } } while (0)
    const int nt = p.nt;
    A6_LOAD(0); A6_STORE(0);
    __syncthreads();
    for (int t = 0; t < nt; ++t) {
        if (t + 1 < nt) A6_LOAD(t + 1);
        const LAS unsigned char* Kt = lds + (t & 1) * KBYTES; const LAS unsigned char* Vt = lds + 2 * KBYTES + (t & 1) * VBYTES;
        bf16x8 kf[NS][2];
#define A6_KREAD(s_) do { kf[s_][0] = *(const LAS bf16x8*)(Kt + r32 * KRS + (16 * (s_) + 8 * h) * 2); kf[s_][1] = *(const LAS bf16x8*)(Kt + (32 + r32) * KRS + (16 * (s_) + 8 * h) * 2); } while (0)
        A6_KREAD(0);
        __builtin_amdgcn_sched_barrier(0);
        f32x16 sa0, sa1, sb0, sb1;
#pragma unroll
        for (int i = 0; i < 16; ++i) { sa0[i] = 0.f; sa1[i] = 0.f; sb0[i] = 0.f; sb1[i] = 0.f; }
#pragma unroll
        for (int s = 0; s < NS; ++s) {
            if (s + 1 < NS) A6_KREAD(s + 1);
            sa0 = __builtin_amdgcn_mfma_f32_32x32x16_bf16(kf[s][0], qf[0][s], sa0, 0, 0, 0); sa1 = __builtin_amdgcn_mfma_f32_32x32x16_bf16(kf[s][1], qf[0][s], sa1, 0, 0, 0);
            sb0 = __builtin_amdgcn_mfma_f32_32x32x16_bf16(kf[s][0], qf[1][s], sb0, 0, 0, 0); sb1 = __builtin_amdgcn_mfma_f32_32x32x16_bf16(kf[s][1], qf[1][s], sb1, 0, 0, 0);
            __builtin_amdgcn_sched_barrier(0);
        }
#undef A6_KREAD
        float pa = 0.f, pb = 0.f; bf16x8 pfa[2][2], pfb[2][2];
#pragma unroll
        for (int i = 0; i < 16; ++i) { const float a = fexp2(sa0[i]), b = fexp2(sa1[i]); sa0[i] = a; sa1[i] = b; pa += a + b; }
#pragma unroll
        for (int s2 = 0; s2 < 2; ++s2) { u32x4 w0, w1;
            w0.x = cvt_pk_bf16(sa0[8 * s2 + 0], sa0[8 * s2 + 1]); w0.y = cvt_pk_bf16(sa0[8 * s2 + 2], sa0[8 * s2 + 3]); w0.z = cvt_pk_bf16(sa0[8 * s2 + 4], sa0[8 * s2 + 5]); w0.w = cvt_pk_bf16(sa0[8 * s2 + 6], sa0[8 * s2 + 7]);
            w1.x = cvt_pk_bf16(sa1[8 * s2 + 0], sa1[8 * s2 + 1]); w1.y = cvt_pk_bf16(sa1[8 * s2 + 2], sa1[8 * s2 + 3]); w1.z = cvt_pk_bf16(sa1[8 * s2 + 4], sa1[8 * s2 + 5]); w1.w = cvt_pk_bf16(sa1[8 * s2 + 6], sa1[8 * s2 + 7]);
            pfa[0][s2] = __builtin_bit_cast(bf16x8, w0); pfa[1][s2] = __builtin_bit_cast(bf16x8, w1); }
        __builtin_amdgcn_sched_barrier(0);
#pragma unroll
        for (int i = 0; i < 16; ++i) { const float a = fexp2(sb0[i]), b = fexp2(sb1[i]); sb0[i] = a; sb1[i] = b; pb += a + b; }
#pragma unroll
        for (int s2 = 0; s2 < 2; ++s2) { u32x4 w0, w1;
            w0.x = cvt_pk_bf16(sb0[8 * s2 + 0], sb0[8 * s2 + 1]); w0.y = cvt_pk_bf16(sb0[8 * s2 + 2], sb0[8 * s2 + 3]); w0.z = cvt_pk_bf16(sb0[8 * s2 + 4], sb0[8 * s2 + 5]); w0.w = cvt_pk_bf16(sb0[8 * s2 + 6], sb0[8 * s2 + 7]);
            w1.x = cvt_pk_bf16(sb1[8 * s2 + 0], sb1[8 * s2 + 1]); w1.y = cvt_pk_bf16(sb1[8 * s2 + 2], sb1[8 * s2 + 3]); w1.z = cvt_pk_bf16(sb1[8 * s2 + 4], sb1[8 * s2 + 5]); w1.w = cvt_pk_bf16(sb1[8 * s2 + 6], sb1[8 * s2 + 7]);
            pfb[0][s2] = __builtin_bit_cast(bf16x8, w0); pfb[1][s2] = __builtin_bit_cast(bf16x8, w1); }
        alarm = alarm || !(pa <= ATT_OVF) || !(pb <= ATT_OVF);
        l0 += pa; l1 += pb;
        __builtin_amdgcn_sched_barrier(0);
#pragma unroll
        for (int q = 0; q < 4; ++q) {
            const int b = q >> 1, s2 = q & 1; bf16x8 vf[NDB];
#pragma unroll
            for (int db = 0; db < NDB; ++db) {
                const s16x4 v0 = __builtin_amdgcn_ds_read_tr16_b64_v4i16((LAS s16x4*)(Vt + ((2 * q + 0) * NDB + db) * 512 + lanebase)), v1 = __builtin_amdgcn_ds_read_tr16_b64_v4i16((LAS s16x4*)(Vt + ((2 * q + 1) * NDB + db) * 512 + lanebase));
                vf[db] = (bf16x8){v0[0], v0[1], v0[2], v0[3], v1[0], v1[1], v1[2], v1[3]}; }
#pragma unroll
            for (int db = 0; db < NDB; ++db) { O[0][db] = __builtin_amdgcn_mfma_f32_32x32x16_bf16(vf[db], pfa[b][s2], O[0][db], 0, 0, 0); O[1][db] = __builtin_amdgcn_mfma_f32_32x32x16_bf16(vf[db], pfb[b][s2], O[1][db], 0, 0, 0); }
            __builtin_amdgcn_sched_barrier(0);
        }
        if (t + 1 < nt) A6_STORE((t + 1) & 1);
        __syncthreads();
    }
#undef A6_LOAD
#undef A6_STORE
    const float lt0 = xsum32(l0), lt1 = xsum32(l1);
    alarm = alarm || !(lt0 >= 8.67e-19f) || !(lt1 >= 8.67e-19f);
    const float i0 = 1.f / lt0, i1 = 1.f / lt1;
#pragma unroll
    for (int db = 0; db < NDB; ++db) { O[0][db] = O[0][db] * i0; O[1][db] = O[1][db] * i1; }
    return alarm;
}
#define XB_TMO      128
#define XB_XCNT(j)  (256  + 64 * (j))
#define XB_XSUB(j)  (1280 + 64 * (j))
#define XB_XGEN(j)  (2304 + 64 * (j))
#define XB_TOP      3328
#define XB_TOPGEN   3392
#define XCD_BAR_WORDS 3456
#define XB_SPIN_CAP (1u << 22)
__device__ __forceinline__ unsigned xb_ld(unsigned* p)              { return __hip_atomic_load(p, __ATOMIC_RELAXED, __HIP_MEMORY_SCOPE_AGENT); }
__device__ __forceinline__ unsigned xb_add(unsigned* p, unsigned v) { return __hip_atomic_fetch_add(p, v, __ATOMIC_RELAXED, __HIP_MEMORY_SCOPE_AGENT); }
__device__ __forceinline__ unsigned xb_xcc_id() { return (unsigned)__builtin_amdgcn_s_getreg((3 << 11) | 20) & 0xFu; }
#define XB_SPIN(cond, bar) do { unsigned _sp = 0; while (cond) { __builtin_amdgcn_s_sleep(1); \
    if ((++_sp & 255u) == 0u) { if (xb_ld(&(bar)[XB_TMO])) break; if (_sp > XB_SPIN_CAP) { atomicAdd(&(bar)[XB_TMO], 1u); break; } } } } while (0)
struct XcdBarrier { unsigned* bar; unsigned x; volatile LAS unsigned* st; };
__device__ __forceinline__ XcdBarrier xcd_barrier_post(unsigned* bar, volatile LAS unsigned* st) {
    XcdBarrier b; b.bar = bar; b.x = xb_xcc_id(); b.st = st;
    if (threadIdx.x == 0) (void)xb_add(&bar[XB_XCNT(b.x)], 1u);
    return b;
}
__device__ __forceinline__ void xcd_barrier_complete(unsigned* bar, unsigned x, unsigned& nloc, unsigned& nx) {
    const unsigned G = gridDim.x * gridDim.y * gridDim.z;
    unsigned sum, cnt, mine, sp = 0u;
    for (;;) {
        sum = 0u; cnt = 0u; mine = 0u;
#pragma unroll
        for (unsigned j = 0; j < 16; ++j) { const unsigned c = xb_ld(&bar[XB_XCNT(j)]); sum += c; cnt += (c > 0u) ? 1u : 0u; mine = (j == x) ? c : mine; }
        if (sum == G) break;
        __builtin_amdgcn_s_sleep(1);
        if ((++sp & 255u) == 0u) { if (xb_ld(&bar[XB_TMO])) break; if (sp > XB_SPIN_CAP) { atomicAdd(&bar[XB_TMO], 1u); break; } }
    }
    nloc = mine > 0u ? mine : 1u; nx = cnt > 0u ? cnt : 1u;
}
__device__ __forceinline__ void xcd_barrier(const XcdBarrier& b) {
    asm volatile("s_waitcnt vmcnt(0)" ::: "memory");
    __syncthreads();
    if (threadIdx.x == 0) {
        unsigned* bar = b.bar;
        __builtin_amdgcn_s_waitcnt(0);
        unsigned nloc = b.st[0], nx = b.st[1];
        if (nloc == 0u) { xcd_barrier_complete(bar, b.x, nloc, nx); b.st[0] = nloc; b.st[1] = nx; }
        const unsigned old = xb_add(&bar[XB_XSUB(b.x)], 1u);
        const unsigned gen = old / nloc;
        if (old + 1u == (gen + 1u) * nloc) {
            __builtin_amdgcn_fence(__ATOMIC_RELEASE, "agent");
            asm volatile("s_waitcnt vmcnt(0)" ::: "memory");
            const unsigned og = xb_add(&bar[XB_TOP], 1u);
            const unsigned tg = og / nx;
            if (og + 1u == (tg + 1u) * nx) xb_add(&bar[XB_TOPGEN], 1u);
            else XB_SPIN(xb_ld(&bar[XB_TOPGEN]) == tg, bar);
            __builtin_amdgcn_fence(__ATOMIC_ACQUIRE, "agent");
            xb_add(&bar[XB_XGEN(b.x)], 1u);
            asm volatile("s_waitcnt vmcnt(0)" ::: "memory");
        } else {
            XB_SPIN(xb_ld(&bar[XB_XGEN(b.x)]) == gen, bar);
            __builtin_amdgcn_fence(__ATOMIC_ACQUIRE, "agent");
            asm volatile("s_waitcnt vmcnt(0)" ::: "memory");
        }
    }
    __syncthreads();
}

__device__ __forceinline__ void transpose_item(const float* W, int K, int ldw, bf16* WT, const float* kscale, LAS float* scr, int kb, int nb, int srccol, int lane) {
    const int k0 = 64 * kb, n0 = 32 * nb;
#pragma unroll 8
    for (int i = 0; i < 32; ++i) { const int kk = 2 * i + (lane >> 5); float v = (srccol >= 0) ? W[(size_t)(k0 + kk) * ldw + srccol] : 0.f; if (kscale) v *= kscale[k0 + kk]; scr[kk * 33 + (lane & 31)] = v; }
    asm volatile("s_waitcnt lgkmcnt(0)" ::: "memory");
    const int c = lane & 7;
#pragma unroll
    for (int j = 0; j < 4; ++j) { const int n = (lane >> 3) + 8 * j; const LAS float* s = scr + (8 * c) * 33 + n;
        u32x4 o; o.x = cvt_pk_bf16(s[0 * 33], s[1 * 33]); o.y = cvt_pk_bf16(s[2 * 33], s[3 * 33]); o.z = cvt_pk_bf16(s[4 * 33], s[5 * 33]); o.w = cvt_pk_bf16(s[6 * 33], s[7 * 33]);
        *(u32x4*)(WT + (size_t)(n0 + n) * K + k0 + 8 * c) = o; }
    asm volatile("s_waitcnt lgkmcnt(0)" ::: "memory");
}
__device__ __forceinline__ void transpose_item_f8(const float* W, int K, int ldw, unsigned char* WT, float scale, LAS float* scr, int kb, int nb, int srccol, int lane) {
    const int k0 = 64 * kb, n0 = 32 * nb;
#pragma unroll 8
    for (int i = 0; i < 32; ++i) { const int kk = 2 * i + (lane >> 5); const float v = (srccol >= 0) ? W[(size_t)(k0 + kk) * ldw + srccol] : 0.f; scr[kk * 33 + (lane & 31)] = v * scale; }
    asm volatile("s_waitcnt lgkmcnt(0)" ::: "memory");
    const int n = lane & 31, kh = lane >> 5; const LAS float* sp = scr + (32 * kh) * 33 + n; u32x4 o0, o1;
#pragma unroll
    for (int q = 0; q < 4; ++q) { o0[q] = pk_fp8x4(sp[(4 * q) * 33], sp[(4 * q + 1) * 33], sp[(4 * q + 2) * 33], sp[(4 * q + 3) * 33]);
                                  o1[q] = pk_fp8x4(sp[(16 + 4 * q) * 33], sp[(16 + 4 * q + 1) * 33], sp[(16 + 4 * q + 2) * 33], sp[(16 + 4 * q + 3) * 33]); }
    *(u32x4*)(WT + (size_t)(n0 + n) * K + k0 + 32 * kh) = o0; *(u32x4*)(WT + (size_t)(n0 + n) * K + k0 + 32 * kh + 16) = o1;
    asm volatile("s_waitcnt lgkmcnt(0)" ::: "memory");
}
__device__ __forceinline__ int rope_perm(int p) { return p < 8 ? p : (p < 16 ? 8 + p : (p < 24 ? p - 8 : p)); }

template <int OUTM, bool SRCB = false>
__device__ __forceinline__ void norm_mod_rows(int nrows, const float* src_lat, const float* src_ctx, const float* gain, const float* mod  , int sh_off, int sc_off, bf16* dst, int gw, int ngw, int lane, signed char* dst8 = nullptr, float* xsc = nullptr) {
    constexpr int NB = 4;
    const int R = (nrows + ngw - 1) / ngw, row0 = gw * R, row1 = min(row0 + R, nrows);
    if (row0 >= row1) return;
    u32x2 qb[NB][4]; f32x4 qf[NB][4];
#define NM_LOAD(buf_, r_) do { const int r2_ = min((r_), row1 - 1); \
        if constexpr (SRCB) { const u32x2* xb_ = (const u32x2*)((const bf16*)src_lat + (size_t)r2_ * DM) + lane; _Pragma("unroll") for (int j_ = 0; j_ < 4; ++j_) qb[buf_][j_] = xb_[64 * j_]; } \
        else { const bool lat_ = r2_ < NLAT; const f32x4* xr_ = (const f32x4*)((lat_ ? src_lat : src_ctx) + (size_t)(lat_ ? r2_ : r2_ - NLAT) * DM) + lane; _Pragma("unroll") for (int j_ = 0; j_ < 4; ++j_) qf[buf_][j_] = xr_[64 * j_]; } } while (0)
#pragma unroll
    for (int p = 0; p < NB - 1; ++p) NM_LOAD(p, row0 + p);
    int brcur = -1; f32x4 A[4], SH[4];
    auto group = [&](const int base) __attribute__((always_inline)) {
#pragma unroll
        for (int i = 0; i < NB; ++i) {
            const int row = min(base + i, row1 - 1);
            NM_LOAD((i + NB - 1) % NB, base + i + NB - 1);
            {
                const int br = row < NLAT ? (row >> 12) : 16;
                if (br != brcur) { brcur = br; const float* mp = mod + (size_t)br * 6144;
#pragma unroll
                    for (int j = 0; j < 4; ++j) { const int col = 4 * (lane + 64 * j);
                        const f32x4 g = *(const f32x4*)(gain + col), sc = *(const f32x4*)(mp + sc_off + col); SH[j] = *(const f32x4*)(mp + sh_off + col);
                        A[j] = g * (sc + 1.0f); }
#pragma unroll
                    for (int j = 0; j < 4; ++j) asm volatile("" : "+v"(SH[j])); }
                f32x4 v[4]; float s = 0.f;
#pragma unroll
                for (int j = 0; j < 4; ++j) { if constexpr (SRCB) { const u32x2 w = qb[i][j]; v[j] = (f32x4){bf_lo(w.x), bf_hi(w.x), bf_lo(w.y), bf_hi(w.y)}; } else v[j] = qf[i][j]; }
#pragma unroll
                for (int j = 0; j < 4; ++j) s += (v[j].x * v[j].x + v[j].y * v[j].y) + (v[j].z * v[j].z + v[j].w * v[j].w);
                const float rs = 1.0f / sqrtf(wave_sum(s) * (1.0f / DM) + RMS_EPS);
                f32x4 y[4]; float am = 0.f;
#pragma unroll
                for (int j = 0; j < 4; ++j) {
                    const int col = 4 * (lane + 64 * j);
                    y[j] = v[j] * rs * A[j] + SH[j];
                    if constexpr (OUTM == 1) { *(unsigned*)((unsigned char*)dst + (size_t)row * DM + col) = pk_fp8x4(y[j].x, y[j].y, y[j].z, y[j].w); }
                    else if constexpr (OUTM != 4) { u32x2 w; w.x = cvt_pk_bf16(y[j].x, y[j].y); w.y = cvt_pk_bf16(y[j].z, y[j].w); *(u32x2*)(dst + (size_t)row * DM + col) = w; }
                    if constexpr (OUTM >= 3) am = fmaxf(am, fmaxf(fmaxf(fabsf(y[j].x), fabsf(y[j].y)), fmaxf(fabsf(y[j].z), fabsf(y[j].w))));
                }
                if constexpr (OUTM >= 3) {
                    am = fmaxf(am, dpp_f<0xB1>(am)); am = fmaxf(am, dpp_f<0x4E>(am)); am = fmaxf(am, dpp_f<0x141>(am)); am = fmaxf(am, dpp_f<0x140>(am));
                    { const auto r = __builtin_amdgcn_permlane16_swap(__float_as_uint(am), __float_as_uint(am), false, false); am = fmaxf(__uint_as_float(r[0]), __uint_as_float(r[1])); }
                    { const auto r = __builtin_amdgcn_permlane32_swap(__float_as_uint(am), __float_as_uint(am), false, false); am = fmaxf(__uint_as_float(r[0]), __uint_as_float(r[1])); }
                    const float q = am > 0.f ? 127.f / am : 0.f;
#pragma unroll
                    for (int j = 0; j < 4; ++j) {
                        const int col = 4 * (lane + 64 * j);
                        const int a = (int)rintf(y[j].x * q), b = (int)rintf(y[j].y * q), c = (int)rintf(y[j].z * q), d = (int)rintf(y[j].w * q);
                        *(unsigned*)(dst8 + (size_t)row * DM + col) = (unsigned)(a & 0xff) | ((unsigned)(b & 0xff) << 8) | ((unsigned)(c & 0xff) << 16) | ((unsigned)(d & 0xff) << 24);
                    }
                    if (lane == 0) xsc[row] = am * (1.0f / 127.f);
                }
            }
        }
    };
    for (int cbase = row0; cbase < row1; cbase += 4 * NB) {
        group(cbase);
        if (cbase + NB < row1) { group(cbase + NB); if (cbase + 2 * NB < row1) { group(cbase + 2 * NB); if (cbase + 3 * NB < row1) group(cbase + 3 * NB); } }
    }
#undef NM_LOAD
}
constexpr int PEER_LST = 0, PEER_SEL = 65536, PEER_WG = 98304;
__device__ __forceinline__ float gelu_erf(float v) {
    const float t = __builtin_amdgcn_rcpf(fabsf(v) * 0.2316418882f + 1.0f);
    float q = t * 0.5307027145f - 0.7265760135f; q = q * t + 0.7107068705f; q = q * t - 0.142248368f; q = q * t + 0.127414796f; q = q * t;
    const float m = v * (q * __builtin_amdgcn_exp2f(v * v * -0.72134752044f));
    return v < 0.f ? m : v - m;
}
#define TOPK_INSERT(L, v_) do { unsigned v__ = (v_); _Pragma("unroll") for (int q_ = 0; q_ < 16; ++q_) { const unsigned hi_ = max(L[q_], v__); v__ = min(L[q_], v__); L[q_] = hi_; } } while (0)


#ifndef PEER_TB_CFG
#define PEER_TB_CFG 16
#endif
constexpr int PEER_TB = PEER_TB_CFG;
constexpr int PEER_NQ = PEER_TB / 4, PEER_M2 = PEER_TB * 256;

typedef short s16x2 __attribute__((ext_vector_type(2)));
#define SEL_NET16(A_) do { \
        SEL_CE(A_, 0, 13); SEL_CE(A_, 1, 12); SEL_CE(A_, 2, 15); SEL_CE(A_, 3, 14); SEL_CE(A_, 4, 8); SEL_CE(A_, 5, 6); SEL_CE(A_, 7, 11); SEL_CE(A_, 9, 10); \
        SEL_CE(A_, 0, 5); SEL_CE(A_, 1, 7); SEL_CE(A_, 2, 9); SEL_CE(A_, 3, 4); SEL_CE(A_, 6, 13); SEL_CE(A_, 8, 14); SEL_CE(A_, 10, 15); SEL_CE(A_, 11, 12); \
        SEL_CE(A_, 0, 1); SEL_CE(A_, 2, 3); SEL_CE(A_, 4, 5); SEL_CE(A_, 6, 8); SEL_CE(A_, 7, 9); SEL_CE(A_, 10, 11); SEL_CE(A_, 12, 13); SEL_CE(A_, 14, 15); \
        SEL_CE(A_, 0, 2); SEL_CE(A_, 1, 3); SEL_CE(A_, 4, 10); SEL_CE(A_, 5, 11); SEL_CE(A_, 6, 7); SEL_CE(A_, 8, 9); SEL_CE(A_, 12, 14); SEL_CE(A_, 13, 15); \
        SEL_CE(A_, 1, 2); SEL_CE(A_, 3, 12); SEL_CE(A_, 4, 6); SEL_CE(A_, 5, 7); SEL_CE(A_, 8, 10); SEL_CE(A_, 9, 11); SEL_CE(A_, 13, 14); \
        SEL_CE(A_, 1, 4); SEL_CE(A_, 2, 6); SEL_CE(A_, 5, 8); SEL_CE(A_, 7, 10); SEL_CE(A_, 9, 13); SEL_CE(A_, 11, 14); \
        SEL_CE(A_, 2, 4); SEL_CE(A_, 3, 6); SEL_CE(A_, 9, 12); SEL_CE(A_, 11, 13); \
        SEL_CE(A_, 3, 5); SEL_CE(A_, 6, 8); SEL_CE(A_, 7, 9); SEL_CE(A_, 10, 12); \
        SEL_CE(A_, 3, 4); SEL_CE(A_, 5, 6); SEL_CE(A_, 7, 8); SEL_CE(A_, 9, 10); SEL_CE(A_, 11, 12); \
        SEL_CE(A_, 6, 7); SEL_CE(A_, 8, 9); } while (0)
__device__ __forceinline__ void peer_select(LAS unsigned char* lds, int nrows, const bf16* SC, unsigned short* SELE, bf16* SELW, int vcu, int G) {
    const int tid = fresh_tid();
    LAS u32x2* LST = (LAS u32x2*)(lds + PEER_LST);
    const int ngroups = nrows / 32;
    for (int grp = vcu; grp < ngroups; grp += G) {
        const int row0 = grp * 32;
        const int tt = tid >> 4, hp = tid & 15, pp = tid & 1;
        const u32x4* sp = (const u32x4*)(SC + (size_t)(row0 + tt) * PQ_N + hp * 128);
        unsigned L[16];
#define SEL_CE(A_, i_, l_) do { const unsigned hi_ = max(A_[i_], A_[l_]), lo_ = min(A_[i_], A_[l_]); A_[i_] = hi_; A_[l_] = lo_; } while (0)
#define SEL_CEA(A_, i_, l_) do { const unsigned hi_ = max(A_[i_], A_[l_]), lo_ = min(A_[i_], A_[l_]); A_[i_] = lo_; A_[l_] = hi_; } while (0)
#pragma unroll 1
        for (int cc = 0; cc < 8; ++cc) {
            const u32x4 w0 = sp[cc * 2], w1 = sp[cc * 2 + 1]; unsigned C[16];
            const unsigned ib = 127u - (unsigned)(cc * 16);
#pragma unroll
            for (int d = 0; d < 8; ++d) {
                const unsigned ww = d < 4 ? w0[d & 3] : w1[d & 3];
                const s16x2 sg = __builtin_bit_cast(s16x2, ww) >> 15;
                const unsigned x = ww ^ (__builtin_bit_cast(unsigned, sg) | 0x80008000u);
                C[2 * d] = (x << 16) | (ib - (unsigned)(2 * d)); C[2 * d + 1] = (x & 0xffff0000u) | (ib - (unsigned)(2 * d + 1));
            }
            SEL_NET16(C);
            if (cc == 0) {
#pragma unroll
                for (int q = 0; q < 16; ++q) L[q] = C[q];
            } else {
#pragma unroll
                for (int q = 0; q < 16; ++q) L[q] = max(L[q], C[15 - q]);
#pragma unroll
                for (int j = 8; j > 0; j >>= 1)
#pragma unroll
                    for (int i = 0; i < 16; ++i) { const int l2 = i ^ j; if (l2 > i) SEL_CE(L, i, l2); }
            }
        }
#undef SEL_CE
#undef SEL_CEA
        float sv[16], pv[16];
#pragma unroll
        for (int q = 0; q < 16; ++q) {
            const unsigned s = L[q] >> 16, b = s ^ ((s & 0x8000u) ? 0x8000u : 0xffffu);
            sv[q] = __uint_as_float(b << 16); const unsigned si = 127u - (L[q] & 0xffffu);
            LST[tid * 16 + q] = (u32x2){b << 16, si};
            pv[q] = xlane1(sv[q]);
        }
        unsigned CK[50];
        { int n = 0;
#pragma unroll
          for (int i = 0; i < 16; ++i)
#pragma unroll
            for (int j = 0; j < 16; ++j)
                if ((i + 1) * (j + 1) <= 16) {
                    const float a = pp ? pv[i] : sv[i], b = pp ? sv[j] : pv[j];
                    const unsigned ub = __float_as_uint(a + b), ks = ub ^ ((ub >> 31) ? 0xffffffffu : 0x80000000u);
                    CK[n++] = (ks & 0xffffff00u) | (unsigned)(255 - (i * 16 + j));
                } }
        unsigned M[16];
#define SEL_CE(A_, i_, l_) do { const unsigned hi_ = max(A_[i_], A_[l_]), lo_ = min(A_[i_], A_[l_]); A_[i_] = hi_; A_[l_] = lo_; } while (0)
#define SEL_CEA(A_, i_, l_) do { const unsigned hi_ = max(A_[i_], A_[l_]), lo_ = min(A_[i_], A_[l_]); A_[i_] = lo_; A_[l_] = hi_; } while (0)
#pragma unroll
        for (int cc = 0; cc < 3; ++cc) {
            unsigned C[16];
#pragma unroll
            for (int q = 0; q < 16; ++q) C[q] = CK[cc * 16 + q];
            SEL_NET16(C);
            if (cc == 0) {
#pragma unroll
                for (int q = 0; q < 16; ++q) M[q] = C[q];
            } else {
#pragma unroll
                for (int q = 0; q < 16; ++q) M[q] = max(M[q], C[15 - q]);
#pragma unroll
                for (int j = 8; j > 0; j >>= 1)
#pragma unroll
                    for (int i = 0; i < 16; ++i) { const int l2 = i ^ j; if (l2 > i) SEL_CE(M, i, l2); }
            }
        }
#undef SEL_CE
#undef SEL_CEA
        TOPK_INSERT(M, CK[48]); TOPK_INSERT(M, CK[49]);
        __syncthreads();
        float fv[16]; unsigned eid[16]; float mx = -3.0e38f;
        const int t0 = tid & ~1;
#pragma unroll
        for (int q = 0; q < 16; ++q) {
            const unsigned code = 255u - (M[q] & 0xffu), i = code >> 4, j = code & 15u;
            const u32x2 e0 = LST[t0 * 16 + i], e1 = LST[(t0 + 1) * 16 + j];
            fv[q] = __uint_as_float(e0.x) + __uint_as_float(e1.x); eid[q] = e0.y * 128u + e1.y; mx = fmaxf(mx, fv[q]);
        }
        float den = 0.f;
#pragma unroll
        for (int q = 0; q < 16; ++q) { fv[q] = __expf(fv[q] - mx); den += fv[q]; }
        const float inv = 1.f / den;
        const size_t ob = (size_t)(row0 + tt) * 128 + (hp >> 1) * 16 + pp * 8;
        const unsigned pm = pp ? 0xffffffffu : 0u;
        u32x4 e4, g4;
#pragma unroll
        for (int q = 0; q < 4; ++q) {
            const unsigned ea = (eid[2 * q] & ~pm) | (eid[8 + 2 * q] & pm), eb2 = (eid[2 * q + 1] & ~pm) | (eid[8 + 2 * q + 1] & pm);
            const float ga = __uint_as_float((__float_as_uint(fv[2 * q]) & ~pm) | (__float_as_uint(fv[8 + 2 * q]) & pm)) * inv, gb = __uint_as_float((__float_as_uint(fv[2 * q + 1]) & ~pm) | (__float_as_uint(fv[8 + 2 * q + 1]) & pm)) * inv;
            e4[q] = ea | (eb2 << 16); g4[q] = cvt_pk_bf16(ga, gb);
        }
        *(u32x4*)(SELE + ob) = e4; *(u32x4*)(SELW + ob) = g4;
        __syncthreads();
    }
}

struct SweepCursor { unsigned* q; int nitems, s, x; };
__device__ __forceinline__ bool sweep_next(SweepCursor& c, int lane, int& slice, int& item) {
    for (;;) {
        if (c.s >= 8) return false;
        slice = (c.x + c.s) & 7;
        unsigned it = 0u;
        if (lane == 0) it = __hip_atomic_fetch_add(c.q + 64 * slice, 1u, __ATOMIC_RELAXED, __HIP_MEMORY_SCOPE_AGENT);
        it = __builtin_amdgcn_readfirstlane(it);
        if ((int)it < c.nitems) { item = (int)it; return true; }
        ++c.s;
    }
}
__device__ __forceinline__ unsigned sweep_pop_async(const SweepCursor& c, int lane) {
    unsigned it = 0u;
    if (lane == 0) it = __hip_atomic_fetch_add(c.q + 64 * ((c.x + c.s) & 7), 1u, __ATOMIC_RELAXED, __HIP_MEMORY_SCOPE_AGENT);
    return it;
}
template <int ABLU = 0>
__device__ __forceinline__ void peer_usweep(LAS unsigned char* lds, int nrows, const signed char* X8, const float* XSC, const unsigned char* U, const unsigned short* SELE, bf16* PA, unsigned* queue) {
    const int lane = fresh_lane(), kk = lane >> 3, sub = lane & 7, wave = __builtin_amdgcn_readfirstlane(threadIdx.x >> 6);
    LAS unsigned char* wl = lds + wave * 16384;
    SweepCursor cur{queue, nrows / PEER_TB, 0, (int)(xb_xcc_id() & 7u)};
    int slice, item;
    bool have = sweep_next(cur, lane, slice, item);
    unsigned tkv = 0u; u32x4 m[PEER_NQ + PEER_NQ / 2];
#define PU_META(sl_, it_) do { const int r0_ = (it_) * PEER_TB; _Pragma("unroll") for (int q = 0; q < PEER_NQ; ++q) m[q] = *(const u32x4*)(SELE + (size_t)r0_ * 128 + (q * 64 + lane) * 8); \
        _Pragma("unroll") for (int q = 0; q < PEER_NQ / 2; ++q) { const int c = q * 64 + lane; m[PEER_NQ + q] = *(const u32x4*)(X8 + (size_t)(r0_ + (c >> 3)) * DM + (sl_) * 128 + (c & 7) * 16); } } while (0)
    if (have) { tkv = sweep_pop_async(cur, lane); PU_META(slice, item); }
    while (have) {
        const int row0 = item * PEER_TB; const unsigned char* Us = U + (size_t)slice * NEXP * 128; const unsigned lo16 = sub * 16;
        {
#pragma unroll
            for (int q = 0; q < PEER_NQ + PEER_NQ / 2; ++q) *(LAS u32x4*)(wl + (q * 64 + lane) * 16) = m[q];
            asm volatile("s_waitcnt lgkmcnt(0)" ::: "memory");
        }
        u32x4 eb[2]; u32x4 uw0[16], uw1[16];
#define PU_IDS(t_) do { eb[0] = *(const LAS u32x4*)(wl + (t_) * 256 + kk * 32); eb[1] = *(const LAS u32x4*)(wl + (t_) * 256 + kk * 32 + 16); } while (0)
#define PU_ROWS(UW_, XS_, t_) do { XS_ = XSC[row0 + (t_)]; _Pragma("unroll") for (int i_ = 0; i_ < 16; ++i_) { const unsigned w_ = eb[i_ >> 3][(i_ >> 1) & 3], e_ = (i_ & 1) ? (w_ >> 16) : (w_ & 0xffffu); UW_[i_] = *(const u32x4*)(Us + ((e_ << 7) + lo16)); } } while (0)
#define PU_COMP(UW_, XS_, t_) do { const u32x4 xq_ = *(const LAS u32x4*)(wl + PEER_M2 + (t_) * 128 + sub * 16); const float xs_ = XS_; \
            f32x4 r_[4]; _Pragma("unroll") for (int i_ = 0; i_ < 16; ++i_) { int a_ = 0; if (ABLU == 0) { _Pragma("unroll") for (int d_ = 0; d_ < 4; ++d_) a_ = __builtin_amdgcn_sdot4((int)UW_[i_][d_], (int)xq_[d_], a_, false); } \
                else a_ = (int)(UW_[i_][0] ^ UW_[i_][1] ^ UW_[i_][2] ^ UW_[i_][3]); \
                r_[i_ >> 2][i_ & 3] = red8_sum((float)a_) * xs_; } \
            if (sub == 0) { bf16* pp_ = PA + ((size_t)(row0 + (t_)) * 8 + slice) * 128 + kk * 16; u32x4 w0_, w1_; \
                w0_.x = cvt_pk_bf16(r_[0][0], r_[0][1]); w0_.y = cvt_pk_bf16(r_[0][2], r_[0][3]); w0_.z = cvt_pk_bf16(r_[1][0], r_[1][1]); w0_.w = cvt_pk_bf16(r_[1][2], r_[1][3]); \
                w1_.x = cvt_pk_bf16(r_[2][0], r_[2][1]); w1_.y = cvt_pk_bf16(r_[2][2], r_[2][3]); w1_.z = cvt_pk_bf16(r_[3][0], r_[3][1]); w1_.w = cvt_pk_bf16(r_[3][2], r_[3][3]); \
                *(u32x4*)pp_ = w0_; *(u32x4*)(pp_ + 8) = w1_; } } while (0)
        float xs0, xs1;
        PU_IDS(0); PU_ROWS(uw0, xs0, 0);
#pragma unroll 1
        for (int t = 0; t < PEER_TB - 2; t += 2) {
            PU_IDS(t + 1); PU_ROWS(uw1, xs1, t + 1);
            PU_COMP(uw0, xs0, t);
            PU_IDS(t + 2); PU_ROWS(uw0, xs0, t + 2);
            PU_COMP(uw1, xs1, t + 1);
        }
        PU_IDS(PEER_TB - 1); PU_ROWS(uw1, xs1, PEER_TB - 1);
        PU_COMP(uw0, xs0, PEER_TB - 2);
        {
            int nitem = (int)__builtin_amdgcn_readfirstlane(tkv), nslice = (cur.x + cur.s) & 7; bool nhave = nitem < cur.nitems;
            if (!nhave) { ++cur.s; nhave = sweep_next(cur, lane, nslice, nitem); }
            tkv = sweep_pop_async(cur, lane); PU_META(nhave ? nslice : 0, nhave ? nitem : 0);
            PU_COMP(uw1, xs1, PEER_TB - 1);
            slice = nslice; item = nitem; have = nhave;
        }
#undef PU_IDS
#undef PU_ROWS
#undef PU_COMP
    }
#undef PU_META
}
template <int V> struct IConst { static constexpr int value = V; };
__device__ __forceinline__ void peer_combine(int nrows, const bf16* PA, const unsigned short* SELE, bf16* SELW, const float* usc, const float* vsc, float* WSC, int gw, int ngw, int lane) {
    const int R = ((nrows / 4 + ngw - 1) / ngw) * 4, row0 = gw * R, row1 = min(row0 + R, nrows);
    if (row0 >= row1) return;
    unsigned pw[8][8], ew[8], gd[8]; float su0[8], su1[8], sv0[8], sv1[8];
#define PC_LOADA(buf_, r_) do { const size_t r2_ = (size_t)min((r_), row1 - 1); \
        _Pragma("unroll") for (int j_ = 0; j_ < 8; ++j_) pw[buf_][j_] = *(const unsigned*)(PA + (r2_ * 8 + j_) * 128 + 2 * lane); \
        ew[buf_] = *(const unsigned*)(SELE + r2_ * 128 + 2 * lane); gd[buf_] = *(const unsigned*)(SELW + r2_ * 128 + 2 * lane); } while (0)
#define PC_LOADB(buf_) do { const unsigned e0_ = ew[buf_] & 0xffffu, e1_ = ew[buf_] >> 16; su0[buf_] = usc[e0_]; su1[buf_] = usc[e1_]; sv0[buf_] = vsc[e0_]; sv1[buf_] = vsc[e1_]; } while (0)
#pragma unroll
    for (int p = 0; p < 4; ++p) PC_LOADA(p, row0 + p);
#pragma unroll
    for (int p = 0; p < 2; ++p) PC_LOADB(p);
    auto group = [&](auto PAR, const int base) __attribute__((always_inline)) {
        constexpr int P4 = decltype(PAR)::value * 4;
#pragma unroll
        for (int i = 0; i < 4; ++i) {
            const int cb = (P4 + i) & 7;
            const int row = base + i;
            PC_LOADA((cb + 4) & 7, row + 4);
            PC_LOADB((cb + 2) & 7);
            float ax = 0.f, ay = 0.f;
#pragma unroll
            for (int j = 0; j < 8; ++j) { const unsigned w = pw[cb][j]; ax += bf_lo(w); ay += bf_hi(w); }
            const unsigned gwd = gd[cb];
            const float w0 = bf_lo(gwd) * gelu_erf(ax * su0[cb]) * sv0[cb], w1 = bf_hi(gwd) * gelu_erf(ay * su1[cb]) * sv1[cb];
            float am = fmaxf(fabsf(w0), fabsf(w1));
            am = fmaxf(am, dpp_f<0xB1>(am)); am = fmaxf(am, dpp_f<0x4E>(am)); am = fmaxf(am, dpp_f<0x141>(am)); am = fmaxf(am, dpp_f<0x140>(am));
            { const auto r = __builtin_amdgcn_permlane16_swap(__float_as_uint(am), __float_as_uint(am), false, false); am = fmaxf(__uint_as_float(r[0]), __uint_as_float(r[1])); }
            { const auto r = __builtin_amdgcn_permlane32_swap(__float_as_uint(am), __float_as_uint(am), false, false); am = fmaxf(__uint_as_float(r[0]), __uint_as_float(r[1])); }
            const unsigned eb = __float_as_uint(am) >> 23;
            const bool ok = eb >= 16u && eb < 240u;
            const float sc = ok ? __uint_as_float((eb - 7u) << 23) : 1.f, inv = ok ? __uint_as_float((261u - eb) << 23) : 1.f;
            const float s0 = w0 * inv, s1 = w1 * inv;
            const int hi = __builtin_amdgcn_cvt_pk_fp8_f32(s0, s1, 0, false);
            const f32x2 hb = __builtin_amdgcn_cvt_pk_f32_fp8(hi, false);
            const int lo = __builtin_amdgcn_cvt_pk_fp8_f32(s0 - hb.x, s1 - hb.y, 0, false);
            unsigned char* wq = (unsigned char*)(SELW + (size_t)row * 128);
            *(unsigned short*)(wq + 2 * lane) = (unsigned short)(hi & 0xffff);
            *(unsigned short*)(wq + 128 + 2 * lane) = (unsigned short)(lo & 0xffff);
            if (lane == 0) WSC[row] = sc;
        }
    };
    for (int cbase = row0; cbase < row1; cbase += 16) {
        group(IConst<0>{}, cbase);
        if (cbase + 4 < row1) { group(IConst<1>{}, cbase + 4); if (cbase + 8 < row1) { group(IConst<0>{}, cbase + 8); if (cbase + 12 < row1) group(IConst<1>{}, cbase + 12); } }
    }
#undef PC_LOADA
#undef PC_LOADB
}
constexpr int PV_TB = 8, PV_WL = 18432, PV_IDS = 16384;
__device__ __forceinline__ void peer_vsweep(LAS unsigned char* lds, int nrows, const unsigned char* V, const unsigned short* SELE, const unsigned char* WQ, const float* WSC, bf16* RESB, const float* g2mod, unsigned* queue, const unsigned char* ZERO) {
    typedef int i32x8_ __attribute__((ext_vector_type(8))); typedef int i32x4_ __attribute__((ext_vector_type(4))); typedef int i32x2_ __attribute__((ext_vector_type(2)));
    const int lane = fresh_lane(), kk = lane >> 3, sub = lane & 7, wave = __builtin_amdgcn_readfirstlane(threadIdx.x >> 6);
    LAS unsigned char* wl = lds + wave * PV_WL;
    unsigned wa[8], ra[8];
    { const int sx = sub ^ ((kk >> 1) & 1), q = lane >> 4, r = (lane >> 1) & 7, c = lane & 1, xr = r ^ (q & 1);
#pragma unroll
      for (int v = 0; v < 8; ++v) { wa[v] = (unsigned)(kk * 2048 + ((sx ^ v) << 4)); ra[v] = (unsigned)((32 * q + r) * 128 + ((v ^ xr) << 4) + 8 * c); } }
    const bool aon = (lane & 15) < 2; const unsigned aoff = (unsigned)((lane & 1) * 128 + (lane >> 4) * 32);
    SweepCursor cur{queue, nrows / PV_TB, 0, (int)(xb_xcc_id() & 7u)};
    int slice, item;
    bool have = sweep_next(cur, lane, slice, item);
    unsigned tkv = 0u; u32x4 m[2];
#define PV_META(it_) do { _Pragma("unroll") for (int q = 0; q < 2; ++q) m[q] = *(const u32x4*)((const unsigned char*)(SELE + (size_t)((it_) * PV_TB) * 128) + (unsigned)((q * 64 + lane) * 16)); } while (0)
    if (have) { tkv = sweep_pop_async(cur, lane); PV_META(item); }
    while (have) {
        const int row0 = item * PV_TB; const unsigned char* Vs = V + (size_t)slice * NEXP * 128; const unsigned lo16 = sub * 16;
        const float* gp_ = g2mod + (size_t)(row0 < NLAT ? (row0 >> 12) : 16) * 6144 + slice * 128 + 8 * (lane & 15); const f32x4 gq0 = *(const f32x4*)gp_, gq1 = *(const f32x4*)(gp_ + 4);
        const unsigned roff = (unsigned)(slice * 256 + 16 * (lane & 15));
        {
#pragma unroll
            for (int q = 0; q < 2; ++q) *(LAS u32x4*)(wl + PV_IDS + (q * 64 + lane) * 16) = m[q];
            asm volatile("s_waitcnt lgkmcnt(0)" ::: "memory");
        }
        u32x4 eb[2]; u32x4 vw0[16], vw1[16]; i32x4_ aw0[2], aw1[2]; float sc0, sc1; u32x4 rv0, rv1;
#define PV_IDS_(t_) do { eb[0] = *(const LAS u32x4*)(wl + PV_IDS + (t_) * 256 + kk * 32); eb[1] = *(const LAS u32x4*)(wl + PV_IDS + (t_) * 256 + kk * 32 + 16); } while (0)
#define PV_ROWS(VW_, AW_, SC_, RV_, t_) do { SC_ = WSC[row0 + (t_)]; RV_ = *(const u32x4*)((const unsigned char*)(RESB + (size_t)(row0 + (t_)) * DM) + roff); _Pragma("unroll") for (int i_ = 0; i_ < 16; ++i_) { const unsigned w_ = eb[i_ >> 3][(i_ >> 1) & 3], e_ = (i_ & 1) ? (w_ >> 16) : (w_ & 0xffffu); VW_[i_] = *(const u32x4*)(Vs + ((e_ << 7) + lo16)); } \
            { const i32x4_* ap_ = (const i32x4_*)(aon ? WQ + (size_t)(row0 + (t_)) * 256 + aoff : ZERO); AW_[0] = ap_[0]; AW_[1] = ap_[1]; } } while (0)
#define PV_COMP(VW_, AW_, SC_, RV_, t_) do { _Pragma("unroll") for (int i_ = 0; i_ < 16; ++i_) *(LAS u32x4*)(wl + wa[i_ & 7] + i_ * 128) = VW_[i_]; \
            const i32x8_ a8_ = __builtin_shufflevector(AW_[0], AW_[1], 0, 1, 2, 3, 4, 5, 6, 7); const float sc_ = SC_; float fo_[8]; \
            i32x8_ b8_[8]; \
            _Pragma("unroll") for (int g_ = 0; g_ < 5; ++g_) {          \
                if (g_ < 4) { _Pragma("unroll") for (int cb_ = 2 * g_; cb_ < 2 * g_ + 2; ++cb_) _Pragma("unroll") for (int j_ = 0; j_ < 4; ++j_) { \
                    const i32x2_ t2_ = __builtin_amdgcn_ds_read_tr8_b64_v2i32((LAS i32x2_*)(wl + ra[cb_] + j_ * 1024)); b8_[cb_][2 * j_] = t2_.x; b8_[cb_][2 * j_ + 1] = t2_.y; } } \
                if (g_ > 0) { _Pragma("unroll") for (int cb_ = 2 * g_ - 2; cb_ < 2 * g_; ++cb_) { \
                    const f32x4 d_ = __builtin_amdgcn_mfma_scale_f32_16x16x128_f8f6f4(a8_, b8_[cb_], (f32x4){0.f, 0.f, 0.f, 0.f}, 0, 0, 0, 0x7F7F7F7F, 0, 0x7F7F7F7F); fo_[cb_] = (d_[0] + d_[1]) * sc_; asm volatile("" : "+v"(fo_[cb_])); } } \
                __builtin_amdgcn_sched_barrier(0); } \
            if (lane < 16) {                                         \
                _Pragma("unroll") for (int cb_ = 0; cb_ < 8; ++cb_) *(LAS float*)(wl + (16 * cb_ + lane) * 4) = fo_[cb_]; \
                const f32x4 f0_ = *(const LAS f32x4*)(wl + lane * 32), f1_ = *(const LAS f32x4*)(wl + lane * 32 + 16); u32x4 ow_; \
                ow_.x = cvt_pk_bf16(bf_lo(RV_.x) + gq0[0] * f0_[0], bf_hi(RV_.x) + gq0[1] * f0_[1]); ow_.y = cvt_pk_bf16(bf_lo(RV_.y) + gq0[2] * f0_[2], bf_hi(RV_.y) + gq0[3] * f0_[3]); \
                ow_.z = cvt_pk_bf16(bf_lo(RV_.z) + gq1[0] * f1_[0], bf_hi(RV_.z) + gq1[1] * f1_[1]); ow_.w = cvt_pk_bf16(bf_lo(RV_.w) + gq1[2] * f1_[2], bf_hi(RV_.w) + gq1[3] * f1_[3]); \
                *(u32x4*)((unsigned char*)(RESB + (size_t)(row0 + (t_)) * DM) + roff) = ow_; } } while (0)
        PV_IDS_(0); PV_ROWS(vw0, aw0, sc0, rv0, 0);
#pragma unroll 1
        for (int t = 0; t < PV_TB - 2; t += 2) {
            PV_IDS_(t + 1); PV_ROWS(vw1, aw1, sc1, rv1, t + 1);
            PV_COMP(vw0, aw0, sc0, rv0, t);
            PV_IDS_(t + 2); PV_ROWS(vw0, aw0, sc0, rv0, t + 2);
            PV_COMP(vw1, aw1, sc1, rv1, t + 1);
        }
        PV_IDS_(PV_TB - 1); PV_ROWS(vw1, aw1, sc1, rv1, PV_TB - 1);
        PV_COMP(vw0, aw0, sc0, rv0, PV_TB - 2);
        {
            int nitem = (int)__builtin_amdgcn_readfirstlane(tkv), nslice = (cur.x + cur.s) & 7; bool nhave = nitem < cur.nitems;
            if (!nhave) { ++cur.s; nhave = sweep_next(cur, lane, nslice, nitem); }
            tkv = sweep_pop_async(cur, lane); PV_META(nhave ? nitem : 0);
            PV_COMP(vw1, aw1, sc1, rv1, PV_TB - 1);
            slice = nslice; item = nitem; have = nhave;
        }
#undef PV_IDS_
#undef PV_ROWS
#undef PV_COMP
    }
#undef PV_META
}
template <bool LAST>
__device__ __forceinline__ void peer_rows(int nrows, const bf16* res, float* outp, const float* ngain, const float* nmod, bf16* Hn, int gw, int ngw, int lane) {
    constexpr int NB = 4;
    const int R = (nrows + ngw - 1) / ngw, row0 = gw * R, row1 = min(row0 + R, nrows);
    if (row0 >= row1) return;
    float A[16], SH[16];
    if (LAST) {
#pragma unroll
        for (int q = 0; q < 4; ++q) { const f32x4 ga = *(const f32x4*)(ngain + lane * 16 + q * 4);
#pragma unroll
            for (int e = 0; e < 4; ++e) A[q * 4 + e] = ga[e]; }
    }
    u32x4 q0[NB], q1[NB];
#define PR_LOAD(buf_, r_) do { const bf16* rp_ = res + (size_t)min((r_), row1 - 1) * DM + lane * 16; q0[buf_] = *(const u32x4*)rp_; q1[buf_] = *(const u32x4*)(rp_ + 8); } while (0)
#pragma unroll
    for (int p = 0; p < NB - 1; ++p) PR_LOAD(p, row0 + p);
    int brcur = -1;
    auto group = [&](const int base) __attribute__((always_inline)) {
#pragma unroll
        for (int i = 0; i < NB; ++i) {
            const int row = min(base + i, row1 - 1);
            PR_LOAD((i + NB - 1) % NB, base + i + NB - 1);
            {
                if (!LAST) { const int br = row < NLAT ? (row >> 12) : 16;
                    if (br != brcur) { brcur = br; const float* mp = nmod + (size_t)br * 6144 + lane * 16;
#pragma unroll
                        for (int q = 0; q < 4; ++q) { const f32x4 ga = *(const f32x4*)(ngain + lane * 16 + q * 4), sc = *(const f32x4*)(mp + 1024 + q * 4), sh = *(const f32x4*)(mp + q * 4);
#pragma unroll
                            for (int e = 0; e < 4; ++e) { A[q * 4 + e] = ga[e] * (1.f + sc[e]); SH[q * 4 + e] = sh[e]; } }
#pragma unroll
                        for (int e = 0; e < 16; ++e) asm volatile("" : "+v"(SH[e])); } }
                const u32x4 r0 = q0[i], r1 = q1[i];
                float xn[16]; float ss = 0.f;
#pragma unroll
                for (int d = 0; d < 4; ++d) { xn[2 * d] = bf_lo(r0[d]); xn[2 * d + 1] = bf_hi(r0[d]); xn[8 + 2 * d] = bf_lo(r1[d]); xn[8 + 2 * d + 1] = bf_hi(r1[d]); }
#pragma unroll
                for (int e = 0; e < 16; ++e) ss += xn[e] * xn[e];
                ss = wave_sum(ss);
                const float rs = 1.0f / sqrtf(ss * (1.0f / DM) + RMS_EPS);
                if (LAST) {
                    float* op = outp + (size_t)row * DM + lane * 16;
#pragma unroll
                    for (int q = 0; q < 4; ++q) { f32x4 oa;
#pragma unroll
                        for (int e = 0; e < 4; ++e) oa[e] = xn[q * 4 + e] * rs * A[q * 4 + e];
                        *(f32x4*)(op + q * 4) = oa; }
                } else {
                    float y[16];
#pragma unroll
                    for (int e = 0; e < 16; ++e) y[e] = xn[e] * rs * A[e] + SH[e];
                    u32x4 w0; w0.x = pk_fp8x4(y[0], y[1], y[2], y[3]); w0.y = pk_fp8x4(y[4], y[5], y[6], y[7]); w0.z = pk_fp8x4(y[8], y[9], y[10], y[11]); w0.w = pk_fp8x4(y[12], y[13], y[14], y[15]);
                    *(u32x4*)((unsigned char*)Hn + (size_t)row * DM + lane * 16) = w0;
                }
            }
        }
    };
    for (int cbase = row0; cbase < row1; cbase += 4 * NB) {
        group(cbase);
        if (cbase + NB < row1) { group(cbase + NB); if (cbase + 2 * NB < row1) { group(cbase + 2 * NB); if (cbase + 3 * NB < row1) group(cbase + 3 * NB); } }
    }
#undef PR_LOAD
}
__device__ __forceinline__ int iclamp(int v, int lo, int hi) { return v < lo ? lo : (v > hi ? hi : v); }
__device__ __forceinline__ void attn_l0_phase(LAS unsigned char* lds, const bf16* Z, unsigned char* OUT, const float* rpb_g, const float* sink_g, int vcu, int G) {
    const int tid = threadIdx.x, lane = fresh_lane(), w = __builtin_amdgcn_readfirstlane(tid >> 6), r32 = lane & 31, h = lane >> 5;
    LAS float* rpbL = (LAS float*)(lds + 65536);
    for (int u = vcu; u < 4352; u += G) {
        f32x16 O[2];
        if (u < 2048) {
            const int rg = u & 15, hd = (u >> 4) & 7, b = u >> 7;
            { const int rr = tid >> 5, cc = tid & 31; rpbL[tid] = (rr < 15 && cc < 31) ? rpb_g[hd * 465 + rr * 31 + cc] * LOG2E : NEGBIG; }
            PolNA p; p.kb = Z + 512 + hd * 64; p.k2b = p.kb; p.vb = Z + 1024 + hd * 64; p.ldk = p.ldk2 = p.ldv = AB_IN; p.lat0 = b * SEQ; p.ctx0 = NLAT + b * CTX;
            const int lo = iclamp(4 * rg - 4, 0, 56), hi = iclamp(4 * rg - 1, 0, 56) + 7; p.lo = lo; p.nt = 4 + hi - lo + 1;
            const int q0 = 4 * rg + 2 * (w >> 2), g = w & 3, qi = q0 + (r32 >> 4), qc = 16 * g + (r32 & 15);
            p.ra = iclamp(q0 - 4, 0, 56); p.rb = iclamp(q0 - 3, 0, 56); p.cs = iclamp(16 * g - 8, 0, 32); p.qi = qi; p.r0i = iclamp(qi - 4, 0, 56); p.qc = qc; p.rpb = rpbL; p.init_lane(lane);
            const size_t row = (size_t)b * SEQ + qi * 64 + qc;
            attn_unit<PolNA>(lds, p, Z + row * AB_IN + hd * 64, NEGBIG, 0.f, O);
            store_o8<2>(OUT + row * DM + hd * 64, O, h);
        } else if (u < 4096) {
            const int u2 = u - 2048, qb = u2 & 63, kvh = (u2 >> 6) & 1, b = u2 >> 7, P0 = 64 * qb;
            const int i0 = P0 >= 128 ? 0 : (128 - P0) / 64; int i1 = (4160 - P0) / 64; i1 = i1 > 4 ? 4 : i1;
            PolSWA p; p.kb = Z + 2048 + kvh * 64; p.k2b = p.kb; p.vb = Z + 2176 + kvh * 64; p.ldk = p.ldk2 = p.ldv = AB_IN; p.lat0 = b * SEQ; p.ctx0 = NLAT + b * CTX;
            p.pos0 = P0 - 128 + 64 * i0; p.nt = 4 + (i1 - i0 + 1);
            const int g = w >> 1, half = w & 1, qp = P0 + 32 * half + r32, qh = kvh * 4 + g; p.qp = qp;
            const size_t row = (size_t)b * SEQ + qp;
            attn_unit<PolSWA>(lds, p, Z + row * AB_IN + 1536 + qh * 64, sink_g[qh] * LOG2E, h == 0 ? 1.f : 0.f, O);
            store_o8<2>(OUT + row * DM + 512 + qh * 64, O, h);
        } else {
            const int u3 = u - 4096, ty = u3 >> 7, hd = u3 & 7, b = (u3 >> 3) & 15;
            PolPlain<64, 64> p; p.ldk = p.ldk2 = p.ldv = AB_IN; p.lat0 = 0; p.nlat = 0; p.ctx0 = NLAT + b * CTX; p.nt = 4; p.c2 = 0.125f * LOG2E;
            int qcol, ocol; float m0 = NEGBIG, l0 = 0.f;
            if (ty == 0) { p.kb = Z + 512 + hd * 64; p.vb = Z + 1024 + hd * 64; qcol = hd * 64; ocol = hd * 64; }
            else { p.kb = Z + 2048 + (hd >> 2) * 64; p.vb = Z + 2176 + (hd >> 2) * 64; qcol = 1536 + hd * 64; ocol = 512 + hd * 64; m0 = sink_g[hd] * LOG2E; l0 = h == 0 ? 1.f : 0.f; }
            p.k2b = p.kb;
            const size_t row = (size_t)NLAT + b * CTX + 32 * w + r32;
            attn_unit<PolPlain<64, 64>>(lds, p, Z + row * AB_IN + qcol, m0, l0, O);
            store_o8<2>(OUT + row * DM + ocol, O, h);
        }
    }
}
template <int ABLV>
__device__ __forceinline__ void attn_l1_phase(LAS unsigned char* lds, const bf16* Z, const bf16* QM, const bf16* KV, unsigned char* OUT, bf16* STASH, const float* lamv, const float* subln, const float* rstd, int vcu, int G) {
    const int tid = threadIdx.x, lane = fresh_lane(), w = __builtin_amdgcn_readfirstlane(tid >> 6), r32 = lane & 31, h = lane >> 5;
    const float lam = __uint_as_float(__builtin_amdgcn_readfirstlane(__float_as_uint(expf(wave_sum(lamv[lane] * lamv[64 + lane])) - expf(wave_sum(lamv[128 + lane] * lamv[192 + lane])) + LAM_INIT1)));
    for (int u = vcu; u < 2048; u += G) {
        if (u < 1024) {
            const int qb = u & 7, hd = (u >> 3) & 7, b = u >> 6;
            PolPlain<96, 64, true> p; p.kb = KV + hd * 128; p.ldk = DM; p.k2b = Z + 384; p.ldk2 = AB_IN; p.vb = KV + hd * 128 + 64; p.ldv = DM;
            p.lat0 = b * SEQ; p.ctx0 = NLAT + b * CTX; p.nlat = 64; p.nt = 68; p.c2 = 1.f;
            const size_t row = (size_t)b * SEQ + 512 * qb + 64 * w + (fresh_lane() & 31);
            f32x16 O2[2][2];
            const bool alarm = attn_unit64(lds, p, QM + row * 768 + hd * 96, QM + (row + 32) * 768 + hd * 96, O2);
            { const int l2 = fresh_lane(); const size_t row2 = (size_t)b * SEQ + 512 * qb + 64 * w + (l2 & 31);
              store_o8<2>(OUT + row2 * DM + hd * 64, O2[0], l2 >> 5); store_o8<2>(OUT + (row2 + 32) * DM + hd * 64, O2[1], l2 >> 5); }
            volatile LAS unsigned* aflag = (volatile LAS unsigned*)(lds + 140 * 1024);
            if (tid == 0) *aflag = 0u;
            __syncthreads();
            if (__builtin_amdgcn_ballot_w64(alarm) != 0ull && fresh_lane() == 0) *aflag = 1u;
            __syncthreads();
            if (*aflag != 0u) {
                asm volatile("s_waitcnt vmcnt(0)" ::: "memory");
                for (int hf = 0; hf < 2; ++hf) { const int l3 = fresh_lane(); const size_t rowh = (size_t)b * SEQ + 512 * qb + 256 * hf + 32 * w + (l3 & 31); f32x16 O[2];
                    attn_unit<PolPlain<96, 64, true>, ABLV>(lds, p, QM + rowh * 768 + hd * 96, NEGBIG, 0.f, O);
                    store_o8<2>(OUT + rowh * DM + hd * 64, O, l3 >> 5); }
            }
            __syncthreads();
        } else {
            const int u2 = u - 1024, qb = u2 & 15, hh = (u2 >> 4) & 3, b = u2 >> 6;
            PolPlain<64, 128, true> p; p.ldk = p.ldk2 = p.ldv = AB_IN; p.vb = Z + 1440 + hh * 128; p.lat0 = b * SEQ; p.ctx0 = NLAT + b * CTX; p.nlat = 64; p.nt = 68; p.c2 = 1.f;
            const size_t row = (size_t)b * SEQ + 256 * qb + 32 * w + (fresh_lane() & 31);
            f32x16 O[4]; bf16* o1g = STASH + row * DM + 512 + hh * 128;
            p.kb = Z + 928 + (hh * 2) * 64; p.k2b = p.kb;
            attn_unit<PolPlain<64, 128, true>, ABLV>(lds, p, Z + row * AB_IN + 416 + (hh * 2) * 64, NEGBIG, 0.f, O);
#pragma unroll
            for (int db = 0; db < 4; ++db)
#pragma unroll
                for (int g = 0; g < 4; ++g) { u32x2 wv; wv.x = cvt_pk_bf16(O[db][4 * g], O[db][4 * g + 1]); wv.y = cvt_pk_bf16(O[db][4 * g + 2], O[db][4 * g + 3]); *(u32x2*)(o1g + 32 * db + 8 * g + 4 * h) = wv; }
            p.kb = Z + 928 + (hh * 2 + 1) * 64; p.k2b = p.kb;
            attn_unit<PolPlain<64, 128, true>, ABLV>(lds, p, Z + row * AB_IN + 416 + (hh * 2 + 1) * 64, NEGBIG, 0.f, O);
            float ss = 0.f;
#pragma unroll
            for (int db = 0; db < 4; ++db)
#pragma unroll
                for (int g = 0; g < 4; ++g) { const u32x2 pw = *(const u32x2*)(o1g + 32 * db + 8 * g + 4 * h);
                    const float d0 = bf_lo(pw.x) - lam * O[db][4 * g], d1 = bf_hi(pw.x) - lam * O[db][4 * g + 1], d2 = bf_lo(pw.y) - lam * O[db][4 * g + 2], d3 = bf_hi(pw.y) - lam * O[db][4 * g + 3];
                    O[db][4 * g] = d0; O[db][4 * g + 1] = d1; O[db][4 * g + 2] = d2; O[db][4 * g + 3] = d3; ss += (d0 * d0 + d1 * d1) + (d2 * d2 + d3 * d3); }
            ss = xsum32(ss);
            const float rs = (1.f - LAM_INIT1) / sqrtf(ss * (1.0f / 128.0f) + RMS_EPS);
#pragma unroll
            for (int db = 0; db < 4; ++db)
#pragma unroll
                for (int g = 0; g < 4; ++g) { const f32x4 sg = *(const f32x4*)(subln + 32 * db + 8 * g + 4 * (fresh_lane() >> 5));
#pragma unroll
                    for (int e = 0; e < 4; ++e) O[db][4 * g + e] *= rs * sg[e]; }
            store_o8<4>(OUT + row * DM + 512 + hh * 128, O, h);
        }
    }
}
#ifndef STOP_AFTER
#define STOP_AFTER 23
#endif
#ifndef ONE_LAUNCH
#define ONE_LAUNCH 1
#endif
struct Args { const float* in[24]; float* out; unsigned char* ws; int ph_lo, ph_hi; };
__global__ void __launch_bounds__(NTHREADS, 2) fwd(Args a) {
    extern __shared__ __attribute__((aligned(16))) unsigned char lds_raw[];
    LAS unsigned char* lds = (LAS unsigned char*)lds_raw;
    const int tid = threadIdx.x, wave = __builtin_amdgcn_readfirstlane(tid >> 6);
#define lane fresh_lane()
    const int G = gridDim.x, bx = blockIdx.x, vcu = (G % 8 == 0) ? (bx % 8) * (G / 8) + bx / 8 : bx;
    const int gw = vcu * NWAVES + wave, ngw = G * NWAVES;
    unsigned char* ws = a.ws;
    unsigned* ctl = (unsigned*)(ws + WS_CTL);
    float* MOD = (float*)(ws + WS_MOD); float* ROPE = (float*)(ws + WS_ROPE); float* RSTD = (float*)(ws + WS_RSTD);
    unsigned char* WIN0 = ws + WS_WIN0; unsigned char* WOUT = ws + WS_WOUT; signed char* WPQ = (signed char*)(ws + WS_WPQ); float* WPF = (float*)(ws + WS_Z); float* WPSC = (float*)(ws + WS_SCL + 256 * 1024); unsigned char* WIN1 = ws + WS_WIN1;
    bf16* WUQ = (bf16*)(ws + WS_WUQ); bf16* WUKV = (bf16*)(ws + WS_WUKV);
    unsigned char* UB = ws + WS_U; unsigned char* VB = ws + WS_V; float* USC = (float*)(ws + WS_SCL); float* VSC = USC + 2 * NEXP; bf16* ACT1 = (bf16*)(ws + WS_ACT1); bf16* ACT2 = (bf16*)a.out; bf16* RES = (bf16*)(ws + WS_RES);
    bf16* Z = (bf16*)(ws + WS_Z); bf16* QM = (bf16*)(ws + WS_QM); bf16* KV = (bf16*)(ws + WS_KV);
    unsigned short* SELE = (unsigned short*)(ws + WS_QM); bf16* SELW = (bf16*)(ws + WS_QM + 34 * MiB); bf16* PA = (bf16*)(ws + WS_Z); bf16* FB = (bf16*)(ws + WS_KV);
    float* XSC = (float*)(ws + WS_ROPE + 65536);
    const float* x_in = a.in[0]; const float* c_in = a.in[1]; const float* ctx_in = a.in[2]; const float* cctx_in = a.in[3]; const float* ada_w = a.in[4]; const float* ada_b = a.in[5];
    const float* norm1_g = a.in[6]; const float* norm2_g = a.in[7]; const float* w_out = a.in[8]; const float* peer_wq = a.in[9]; const float* peer_keys = a.in[10];
    const float* peer_u = a.in[11]; const float* peer_v = a.in[12]; const float* ab_w_in = a.in[13]; const float* na_rpb = a.in[14]; const float* swa_sink = a.in[15];
    const float* cd_w_in = a.in[16]; const float* q_norm_g = a.in[17]; const float* w_uq = a.in[18]; const float* kv_norm_g = a.in[19]; const float* w_ukv = a.in[20];
    const float* diff_lambda = a.in[21]; const float* subln_g = a.in[22]; const float* final_g = a.in[23];
    float* out = a.out;

    volatile LAS unsigned* MISC = (volatile LAS unsigned*)(lds + LDS_MISC);
    if (tid < 16) MISC[tid] = 0u;
    __syncthreads();
    const int lo = a.ph_lo, hi = a.ph_hi & 0xff;
    XcdBarrier bar; bar.bar = ctl + CW_BAR; bar.x = 0; bar.st = MISC + 8;
    if (hi - lo > 1) bar = xcd_barrier_post(ctl + CW_BAR, MISC + 8);
#ifndef PHASE_MASK
#define PHASE_MASK 0xffffff
#endif
#define IN(k) ((((PHASE_MASK) >> (k)) & 1) && lo <= (k) && (k) < hi)
#if defined(DEBUG_TIME)
#define STAMP(k) do { if (bx == 0 && tid == 0) ((unsigned long long*)(ws + 980 * MiB))[k] = __builtin_amdgcn_s_memrealtime(); } while (0)
#else
#define STAMP(k) do { } while (0)
#endif
#ifndef REPEAT_MASK
#define REPEAT_MASK 0
#endif
#define SEAM(k) do { if (IN(k) && IN((k) + 1)) xcd_barrier(bar); STAMP((k) + 1); } while (0)
    STAMP(0);

    if (IN(0)) {
        if (bx < 192) {
            const int l = bx / 96, n0 = (bx % 96) * 64;
            LAS float* sil = (LAS float*)lds;
            for (int idx = tid; idx < 17 * 1024; idx += NTHREADS) { const int r = idx >> 10, k = idx & 1023; const float cv = r < 16 ? c_in[idx] : cctx_in[k]; sil[idx] = cv / (1.f + expf(-cv)); }
            __syncthreads();
            float acc[17];
#pragma unroll
            for (int r = 0; r < 17; ++r) acc[r] = 0.f;
            const float* wp = ada_w + (size_t)l * 1024 * 6144 + n0 + lane;
            for (int k = wave * 128; k < wave * 128 + 128; k += 4) {
                const float w0 = wp[(size_t)k * 6144], w1 = wp[(size_t)(k + 1) * 6144], w2 = wp[(size_t)(k + 2) * 6144], w3 = wp[(size_t)(k + 3) * 6144];
#pragma unroll
                for (int r = 0; r < 17; ++r) { const f32x4 s4 = *(const LAS f32x4*)(sil + r * 1024 + k); acc[r] += (s4.x * w0 + s4.y * w1) + (s4.z * w2 + s4.w * w3); }
            }
            LAS float* part = (LAS float*)(lds + 69632);
#pragma unroll
            for (int r = 0; r < 17; ++r) part[(wave * 17 + r) * 64 + lane] = acc[r];
            __syncthreads();
            for (int idx = tid; idx < 17 * 64; idx += NTHREADS) { const int r = idx >> 6, ln = idx & 63; float s = 0.f;
#pragma unroll
                for (int w8 = 0; w8 < 8; ++w8) s += part[(w8 * 17 + r) * 64 + ln];
                MOD[((size_t)l * 17 + r) * 6144 + n0 + ln] = s + ada_b[l * 6144 + n0 + ln]; }
            __syncthreads();
        }
        LAS float* scr = (LAS float*)(lds + wave * 16384);
        constexpr int T0 = 1152, T1 = T0 + 1024, T2 = T1 + 1024, T3 = T2 + 96, T4 = T3 + 64, T5 = T4 + 4096, T6 = T5 + 4096, T7 = T6 + 24;
        for (int it = gw; it < T7; it += ngw) {
            if (it < T0) { const int kb = it / 72, nb = it % 72; transpose_item_f8(ab_w_in, 1024, AB_IN, WIN0, 64.f, scr, kb, nb, 32 * nb + (lane & 31), lane); }
            else if (it < T1) { const int r = it - T0, l = r >> 9, kb = (r & 511) >> 5, nb = r & 31; transpose_item_f8(w_out + (size_t)l * DM * DM, 1024, DM, WOUT + (size_t)l * DM * DM, 64.f, scr, kb, nb, 32 * nb + (lane & 31), lane); }
            else if (it < T2) { const int r = it - T1, kb = r >> 6, nb = r & 63, n = 32 * nb + (lane & 31);
                const int src = n < CD_IN ? (nb == 12 ? 384 + rope_perm(lane & 31) : n) : -1;
                transpose_item_f8(cd_w_in, 1024, CD_IN, WIN1, 64.f, scr, kb, nb, src, lane); }
            else if (it < T3) { const int r = it - T2, kb = r / 24, nb = r % 24; const int src = (nb % 3 == 2) ? 32 * nb + rope_perm(lane & 31) : 32 * nb + (lane & 31);
                transpose_item(w_uq, 256, 768, WUQ, q_norm_g, scr, kb, nb, src, lane); }
            else if (it < T4) { const int r = it - T3, kb = r >> 5, nb = r & 31; transpose_item(w_ukv, 128, 1024, WUKV, kv_norm_g, scr, kb, nb, 32 * nb + (lane & 31), lane); }
            else if (it < T5) {
                const int r = it - T4, l = r >> 11, hp = (r >> 7) & 15, kb = (r >> 2) & 31, nb = r & 3, i32 = lane & 31, hh = lane >> 5;
                const float* ap = peer_wq + (size_t)l * DM * PQ_N + (size_t)(32 * kb + i32) * PQ_N + hp * 128 + 64 * hh;
                const float* bp = peer_keys + (size_t)l * 2 * 128 * 128 + (size_t)(hp & 1) * 128 * 128 + (size_t)(32 * nb + i32) * 128 + 64 * hh;
                f32x16 acc;
#pragma unroll
                for (int i = 0; i < 16; ++i) acc[i] = 0.f;
                for (int s4 = 0; s4 < 16; ++s4) {
                    const f32x4 av = *(const f32x4*)(ap + 4 * s4), bv = *(const f32x4*)(bp + 4 * s4);
#pragma unroll
                    for (int e = 0; e < 4; ++e) acc = __builtin_amdgcn_mfma_f32_32x32x2f32(av[e], bv[e], acc, 0, 0, 0);
                }
                float* op = WPF + (size_t)l * PQ_N * DM + (size_t)(hp * 128 + 32 * nb + i32) * DM + 32 * kb + 4 * hh;
#pragma unroll
                for (int g = 0; g < 4; ++g) *(f32x4*)(op + 8 * g) = (f32x4){acc[4 * g], acc[4 * g + 1], acc[4 * g + 2], acc[4 * g + 3]};
            }
            else if (it < T6) {
                const int r0 = (it - T5) * 16; const bool isv = r0 >= 2 * NEXP; const int e0 = isv ? r0 - 2 * NEXP : r0;
                const float* src0 = (isv ? peer_v : peer_u) + (size_t)e0 * DM + lane * 16;
#pragma unroll 1
                for (int r4 = 0; r4 < 16; r4 += 4) {
                    f32x4 v[4][4];
#pragma unroll
                    for (int k = 0; k < 4; ++k)
#pragma unroll
                        for (int q = 0; q < 4; ++q) v[k][q] = *(const f32x4*)(src0 + (size_t)(r4 + k) * DM + 4 * q);
#pragma unroll
                    for (int k = 0; k < 4; ++k) {
                        const int er = e0 + r4 + k; float am = 0.f;
#pragma unroll
                        for (int q = 0; q < 4; ++q) am = fmaxf(am, fmaxf(fmaxf(fabsf(v[k][q].x), fabsf(v[k][q].y)), fmaxf(fabsf(v[k][q].z), fabsf(v[k][q].w))));
                        am = fmaxf(am, dpp_f<0xB1>(am)); am = fmaxf(am, dpp_f<0x4E>(am)); am = fmaxf(am, dpp_f<0x141>(am)); am = fmaxf(am, dpp_f<0x140>(am));
                        { const auto r = __builtin_amdgcn_permlane16_swap(__float_as_uint(am), __float_as_uint(am), false, false); am = fmaxf(__uint_as_float(r[0]), __uint_as_float(r[1])); }
                        { const auto r = __builtin_amdgcn_permlane32_swap(__float_as_uint(am), __float_as_uint(am), false, false); am = fmaxf(__uint_as_float(r[0]), __uint_as_float(r[1])); }
                        const float sc = am > 0.f ? (isv ? 240.f : 127.f) / am : 1.f; u32x4 w;
#pragma unroll
                        for (int q = 0; q < 4; ++q) {
                            if (isv) { int t = 0; t = __builtin_amdgcn_cvt_pk_fp8_f32(v[k][q].x * sc, v[k][q].y * sc, t, false); t = __builtin_amdgcn_cvt_pk_fp8_f32(v[k][q].z * sc, v[k][q].w * sc, t, true); w[q] = (unsigned)t; }
                            else { const int a = (int)rintf(v[k][q].x * sc), b = (int)rintf(v[k][q].y * sc), c = (int)rintf(v[k][q].z * sc), d = (int)rintf(v[k][q].w * sc);
                                   w[q] = (unsigned)(a & 0xff) | ((unsigned)(b & 0xff) << 8) | ((unsigned)(c & 0xff) << 16) | ((unsigned)(d & 0xff) << 24); } }
                        *(u32x4*)((isv ? VB : UB) + (size_t)(er >> 14) * NEXP * DM + (size_t)(lane >> 3) * NEXP * 128 + (size_t)(er & (NEXP - 1)) * 128 + (lane & 7) * 16) = w;
                        if (lane == 0) (isv ? VSC : USC)[er] = am > 0.f ? am / (isv ? 240.f : 127.f) : 1.f;
                    }
                }
            }
            else {
                const int idx = (it - T6) * 64 + lane;
                if (idx < 1024) { const int pos = idx >> 4, i = idx & 15; const float ang = (float)pos * powf(10000.f, -(float)i / 16.f); ROPE[idx] = cosf(ang); ROPE[1024 + idx] = sinf(ang); }
                else { const int j = idx - 1024, pos = j >> 3, i = j & 7; const float ang = (float)pos * powf(10000.f, -(float)i / 8.f); ROPE[2048 + j] = cosf(ang); ROPE[2560 + j] = sinf(ang); }
            }
        }
    }
    SEAM(0);
    if (IN(1)) { norm_mod_rows<1>(NROW, x_in, ctx_in, norm1_g, MOD, 0, 1024, ACT1, gw, ngw, lane);
        for (int row = gw; row < 2 * PQ_N; row += ngw) {
            const f32x4* wr4 = (const f32x4*)(WPF + (size_t)row * DM) + lane; f32x4 v[4]; float am = 0.f;
#pragma unroll
            for (int j = 0; j < 4; ++j) { v[j] = wr4[64 * j]; am = fmaxf(am, fmaxf(fmaxf(fabsf(v[j].x), fabsf(v[j].y)), fmaxf(fabsf(v[j].z), fabsf(v[j].w)))); }
            am = fmaxf(am, dpp_f<0xB1>(am)); am = fmaxf(am, dpp_f<0x4E>(am)); am = fmaxf(am, dpp_f<0x141>(am)); am = fmaxf(am, dpp_f<0x140>(am));
            { const auto r = __builtin_amdgcn_permlane16_swap(__float_as_uint(am), __float_as_uint(am), false, false); am = fmaxf(__uint_as_float(r[0]), __uint_as_float(r[1])); }
            { const auto r = __builtin_amdgcn_permlane32_swap(__float_as_uint(am), __float_as_uint(am), false, false); am = fmaxf(__uint_as_float(r[0]), __uint_as_float(r[1])); }
            const float q = am > 0.f ? 127.f / am : 0.f;
#pragma unroll
            for (int j = 0; j < 4; ++j) {
                const int a = (int)rintf(v[j].x * q), b = (int)rintf(v[j].y * q), c = (int)rintf(v[j].z * q), d = (int)rintf(v[j].w * q);
                *(unsigned*)(WPQ + (size_t)row * DM + 4 * (lane + 64 * j)) = (unsigned)(a & 0xff) | ((unsigned)(b & 0xff) << 8) | ((unsigned)(c & 0xff) << 16) | ((unsigned)(d & 0xff) << 24);
            }
            if (lane == 0) WPSC[row] = am * (1.0f / 127.f);
        }
    }
    SEAM(1);
    if (IN(2)) { pg8::Gemm g{ACT1, WIN0, NROW, AB_IN, 1024, 1024, 1024}; pg8::StaticOrder S; S.init(NROW, AB_IN, G, bx); EpiRope<0> E{Z, AB_IN, ROPE};
        pg8::gemm_phase<EpiRope<0>, pg8::StaticOrder, true, 0x79797979u, 0x7F7F7F7Fu>(lds, g, S, E); }
    SEAM(2);
    if (IN(3)) { attn_l0_phase(lds, Z, (unsigned char*)ACT2, na_rpb, swa_sink, vcu, G); }
    SEAM(3);
    if (IN(4)) { pg8::Gemm g{ACT2, WOUT, NROW, DM, 1024, 1024, 1024}; pg8::StaticOrder S; S.init(NROW, DM, G, bx); EpiResid<true> E{x_in, ctx_in, RES, MOD + 2048};
        pg8::gemm_phase<EpiResid<true>, pg8::StaticOrder, true, 0x79797979u, 0x7B7B7B7Bu>(lds, g, S, E); }
    SEAM(4);
    if (IN(5)) { norm_mod_rows<4, true>(NROW, (const float*)RES, nullptr, norm2_g, MOD, 3072, 4096, ACT1, gw, ngw, lane, (signed char*)ACT2, XSC); }
    SEAM(5);
    if (IN(6)) { pg8::Gemm g{ACT2, WPQ, NROW, PQ_N, 1024, 1024, 1024}; pg8::StaticOrder S; S.init(NROW, PQ_N, G, bx); EpiScore E{Z, PQ_N, XSC, WPSC};
        pg8::gemm_phase<EpiScore, pg8::StaticOrder, false, 0x7F7F7F7Fu, 0x7F7F7F7Fu, true, true, true>(lds, g, S, E); }
    SEAM(6);
#ifndef PROBE_DUP
#define PROBE_DUP 0
#endif
    if (IN(7)) { peer_select(lds, NROW, Z, SELE, SELW, vcu, G); if (PROBE_DUP & 1) { xcd_barrier(bar); peer_select(lds, NROW, Z, SELE, SELW, vcu, G); } }
    SEAM(7);
    if (IN(8)) { if (PROBE_DUP & 8) { peer_usweep<1>(lds, NROW, (const signed char*)ACT2, XSC, UB, SELE, PA, ctl + CW_Q + 4 * 512); xcd_barrier(bar); }
        peer_usweep(lds, NROW, (const signed char*)ACT2, XSC, UB, SELE, PA, ctl + CW_Q + 0 * 512); if (PROBE_DUP & 2) { xcd_barrier(bar); peer_usweep(lds, NROW, (const signed char*)ACT2, XSC, UB, SELE, PA, ctl + CW_Q + 4 * 512); } }
    SEAM(8);
    if (IN(9)) peer_combine(NROW, PA, SELE, SELW, USC, VSC, XSC, gw, ngw, lane);
    SEAM(9);
    if (IN(10)) { peer_vsweep(lds, NROW, VB, SELE, (const unsigned char*)SELW, XSC, RES, MOD + 5120, ctl + CW_Q + 1 * 512, ws + 512 * 1024); }
    SEAM(10);
    if (IN(11)) peer_rows<false>(NROW, RES, out, norm1_g + DM, MOD + 17 * 6144, ACT2, gw, ngw, lane);
    SEAM(11);
    if (IN(12)) { pg8::Gemm g{ACT2, WIN1, NROW, CD_PAD, 1024, 1024, 1024}; pg8::StaticOrder S; S.init(NROW, CD_PAD, G, bx); EpiRope<1> E{Z, AB_IN, ROPE};
        pg8::gemm_phase<EpiRope<1>, pg8::StaticOrder, true, 0x79797979u, 0x7F7F7F7Fu>(lds, g, S, E); }
    SEAM(12);
    if (IN(13)) {
        const int R13 = ((NROW / 4 + ngw - 1) / ngw) * 4, r13a = gw * R13, r13b = min(r13a + R13, NROW);
        if (r13a < r13b) {
            u32x2 qa8[8]; unsigned kb8[8];
#define P13_LOAD(buf_, r_) do { const bf16* zr_ = Z + (size_t)min((r_), r13b - 1) * AB_IN; qa8[buf_] = *(const u32x2*)(zr_ + lane * 4); kb8[buf_] = *(const unsigned*)(zr_ + 256 + lane * 2); } while (0)
#pragma unroll
            for (int p = 0; p < 6; ++p) P13_LOAD(p, r13a + p);
            auto group13 = [&](auto PAR, const int base) __attribute__((always_inline)) {
                constexpr int P4 = decltype(PAR)::value * 4;
#pragma unroll
                for (int i = 0; i < 4; ++i) {
                    const int cb = (P4 + i) & 7, row = base + i;
                    P13_LOAD((cb + 6) & 7, row + 6);
                    const u32x2 qa = qa8[cb]; const unsigned kb2 = kb8[cb];
                    float sq = bf_lo(qa.x) * bf_lo(qa.x) + bf_hi(qa.x) * bf_hi(qa.x) + bf_lo(qa.y) * bf_lo(qa.y) + bf_hi(qa.y) * bf_hi(qa.y), sk = bf_lo(kb2) * bf_lo(kb2) + bf_hi(kb2) * bf_hi(kb2);
                    sq = wave_sum(sq); sk = wave_sum(sk);
                    if (lane == 0) { RSTD[(size_t)row * 2] = 1.0f / sqrtf(sq * (1.0f / 256.0f) + RMS_EPS); RSTD[(size_t)row * 2 + 1] = 1.0f / sqrtf(sk * (1.0f / 128.0f) + RMS_EPS); }
                }
            };
            for (int cbase = r13a; cbase < r13b; cbase += 16) {
                group13(IConst<0>{}, cbase);
                if (cbase + 4 < r13b) { group13(IConst<1>{}, cbase + 4); if (cbase + 8 < r13b) { group13(IConst<0>{}, cbase + 8); if (cbase + 12 < r13b) group13(IConst<1>{}, cbase + 12); } }
            }
#undef P13_LOAD
        }
    }
    SEAM(13);
    if (IN(14)) {
        { pg8::Gemm g{Z, WUQ, NLAT, 768, 512, AB_IN * 2, 512}; pg8::StaticOrder S; S.init(NLAT, 768, G, bx); EpiRope<2> E{QM, 768, ROPE, RSTD};
          pg8::gemm_phase<EpiRope<2>, pg8::StaticOrder>(lds, g, S, E); }
        __syncthreads();
        { pg8::Gemm g{Z + 256, WUKV, NROW, 1024, 256, AB_IN * 2, 256}; pg8::StaticOrder S; S.init(NROW, 1024, G, bx); EpiBf16 E{KV, DM, RSTD, 1};
          pg8::gemm_phase<EpiBf16, pg8::StaticOrder>(lds, g, S, E); }
    }
    SEAM(14);
    if (IN(15)) {
#if defined(ATT_PROBE)
        if (a.ph_hi >> 8) attn_l1_phase<ATT_PROBE>(lds, Z, QM, KV, (unsigned char*)ACT2 + 64 * MiB, ACT2, diff_lambda, subln_g, RSTD, vcu, G); else
#endif
        attn_l1_phase<0>(lds, Z, QM, KV, (unsigned char*)ACT1, ACT2, diff_lambda, subln_g, RSTD, vcu, G); }
    SEAM(15);
    if (IN(16)) { pg8::Gemm g{ACT1, WOUT + (size_t)DM * DM, NLAT, DM, 1024, 1024, 1024}; pg8::StaticOrder S; S.init(NLAT, DM, G, bx); EpiResid<false> E{nullptr, nullptr, RES, MOD + 17 * 6144 + 2048};
        pg8::gemm_phase<EpiResid<false>, pg8::StaticOrder, true, 0x79797979u, 0x7B7B7B7Bu>(lds, g, S, E); }
    SEAM(16);
    if (IN(17)) { norm_mod_rows<4, true>(NLAT, (const float*)RES, nullptr, norm2_g + DM, MOD + 17 * 6144, 3072, 4096, ACT2, gw, ngw, lane, (signed char*)ACT1, XSC); }
    SEAM(17);
    if (IN(18)) { pg8::Gemm g{ACT1, WPQ + (size_t)PQ_N * DM, NLAT, PQ_N, 1024, 1024, 1024}; pg8::StaticOrder S; S.init(NLAT, PQ_N, G, bx); EpiScore E{Z, PQ_N, XSC, WPSC + PQ_N};
        pg8::gemm_phase<EpiScore, pg8::StaticOrder, false, 0x7F7F7F7Fu, 0x7F7F7F7Fu, true, true, true>(lds, g, S, E); }
    SEAM(18);
    if (IN(19)) peer_select(lds, NLAT, Z, SELE, SELW, vcu, G);
    SEAM(19);
    if (IN(20)) peer_usweep(lds, NLAT, (const signed char*)ACT1, XSC, UB + (size_t)NEXP * DM, SELE, PA, ctl + CW_Q + 2 * 512);
    SEAM(20);
    if (IN(21)) peer_combine(NLAT, PA, SELE, SELW, USC + NEXP, VSC + NEXP, XSC, gw, ngw, lane);
    SEAM(21);
    if (IN(22)) peer_vsweep(lds, NLAT, VB + (size_t)NEXP * DM, SELE, (const unsigned char*)SELW, XSC, RES, MOD + 17 * 6144 + 5120, ctl + CW_Q + 3 * 512, ws + 512 * 1024);
    SEAM(22);
    if (IN(23)) peer_rows<true>(NLAT, RES, out, final_g, MOD, ACT1, gw, ngw, lane);
    STAMP(24);
#if STOP_AFTER < 23
    if (lo <= 24 && 24 < hi) {
        for (int row = gw; row < NLAT; row += ngw) {
            f32x4* xr = (f32x4*)(out + (size_t)row * DM) + lane; f32x4 v[4]; float s = 0.f;
#pragma unroll
            for (int j = 0; j < 4; ++j) { v[j] = xr[64 * j]; s += (v[j].x * v[j].x + v[j].y * v[j].y) + (v[j].z * v[j].z + v[j].w * v[j].w); }
            const float rs = 1.0f / sqrtf(wave_sum(s) * (1.0f / DM) + RMS_EPS);
#pragma unroll
            for (int j = 0; j < 4; ++j) xr[64 * j] = v[j] * rs * ((const f32x4*)final_g)[lane + 64 * j];
        }
    }
#endif
#undef IN
#undef SEAM
#undef lane
}

#if defined(DEBUG_CHECK) || defined(DEBUG_TIME)
constexpr size_t WS_DBG = 980 * MiB;
__device__ __forceinline__ float bf2f(bf16 v) { return __uint_as_float((unsigned)v << 16); }
__device__ __forceinline__ float wave_max(float v) {
#pragma unroll
    for (int o = 1; o < 64; o <<= 1) v = fmaxf(v, __shfl_xor(v, o));
    return v;
}
__device__ __forceinline__ void wave_argmax(float& v, int& i) {
#pragma unroll
    for (int o = 1; o < 64; o <<= 1) { const float ov = __shfl_xor(v, o); const int oi = __shfl_xor(i, o); if (ov > v || (ov == v && oi < i)) { v = ov; i = oi; } }
}
__global__ void __launch_bounds__(64) dbg_check(Args a, int check) {
    __shared__ float sh[4096]; __shared__ float sv[16][16]; __shared__ int si[16][16];
    const int b = blockIdx.x, lane = threadIdx.x;
    unsigned char* ws = a.ws; float* DBG = (float*)(ws + WS_DBG);
    const float* MOD = (const float*)(ws + WS_MOD);
    const bf16* ACT1 = (const bf16*)(ws + WS_ACT1); const bf16* ACT2 = (const bf16*)(ws + WS_ACT2); const bf16* Z = (const bf16*)(ws + WS_Z);
    const float* FDBG = (const float*)(ws + WS_QM);
    float err = 0.f;
    if (check == 8 || check == 9) return;
    if (check == 1) {
        const int l = b & 1, r = (b >> 1) % 17, n = (b * 97) % 6144; float s = 0.f;
        for (int k = lane; k < 1024; k += 64) { const float cv = r < 16 ? a.in[1][r * 1024 + k] : a.in[3][k]; s += cv / (1.f + expf(-cv)) * a.in[4][((size_t)l * 1024 + k) * 6144 + n]; }
        s = wave_sum(s) + a.in[5][l * 6144 + n]; const float got = MOD[((size_t)l * 17 + r) * 6144 + n]; err = fabsf(got - s) / (fabsf(s) + 0.05f);
    } else if (check == 2) {
        const int row = (b * 1031 + 7) % NROW; const bool lat = row < NLAT; const int br = lat ? row >> 12 : 16;
        const float* xr = lat ? a.in[0] + (size_t)row * DM : a.in[2] + (size_t)(row - NLAT) * DM; float ss = 0.f;
        for (int k = lane; k < 1024; k += 64) ss += xr[k] * xr[k];
        ss = wave_sum(ss); const float rs = 1.f / sqrtf(ss / 1024.f + RMS_EPS); float md = 0.f, mr = 0.f;
        for (int k = lane; k < 1024; k += 64) { const float ref = xr[k] * rs * a.in[6][k] * (1.f + MOD[(size_t)br * 6144 + 1024 + k]) + MOD[(size_t)br * 6144 + k]; md = fmaxf(md, fabsf(ref - bf2f(ACT1[(size_t)row * DM + k]))); mr = fmaxf(mr, fabsf(ref)); }
        err = wave_max(md) / wave_max(mr);
    } else if (check == 3) {
        const int row = (b * 1031 + 7) % NROW; const bool lat = row < NLAT; const int t = row & 4095; float md = 0.f, mr = 0.f;
        for (int j = 0; j < 24; ++j) {
            const int col = (b * 37 + j * 149) % AB_IN; const bool rope = lat && col >= 1536 && col < 2176; const int d = col & 63, first = (d & 31) < 16, pc = rope ? (first ? col + 16 : col - 16) : col;
            float s0 = 0.f, s1 = 0.f;
            for (int k = lane; k < 1024; k += 64) { const float hv = bf2f(ACT1[(size_t)row * DM + k]); s0 += hv * a.in[13][(size_t)k * AB_IN + col]; s1 += hv * a.in[13][(size_t)k * AB_IN + pc]; }
            s0 = wave_sum(s0); s1 = wave_sum(s1); float ref = s0;
            if (rope) { const int pos = d < 32 ? t >> 6 : t & 63, i = d & 15; const float ang = (float)pos * powf(10000.f, -(float)i / 16.f), c = cosf(ang), s = sinf(ang); ref = first ? s0 * c - s1 * s : s1 * s + s0 * c; }
            md = fmaxf(md, fabsf(ref - bf2f(Z[(size_t)row * AB_IN + col]))); mr = fmaxf(mr, fabsf(ref));
        }
        err = md / fmaxf(mr, 0.5f);
    } else if (check == 4) {
        const int hs = b & 15; const int row = (b < 48) ? (((b * 2657 + 11) % NLAT)) : (NLAT + (b * 613) % NCTX); const bool lat = row < NLAT; const int bb = lat ? row >> 12 : (row - NLAT) >> 8, t = row & 4095;
        const int qcol = hs < 8 ? hs * 64 : 1536 + (hs - 8) * 64, kcol = hs < 8 ? 512 + hs * 64 : 2048 + ((hs - 8) >> 2) * 64, vcol = hs < 8 ? 1024 + hs * 64 : 2176 + ((hs - 8) >> 2) * 64;
        const bf16* q = Z + (size_t)row * AB_IN + qcol;
        const int qr = t >> 6, qc = t & 63;
        float* lg = sh; int nk = 0;
        int* kr = (int*)(sh + 1024);
        if (lane == 0) {
            if (lat && hs < 8) { const int r0 = min(max(qr - 4, 0), 56), cs = min(max(qc - 8, 0), 48);
                for (int r = r0; r < r0 + 8; ++r) for (int c = cs; c < cs + 16; ++c) kr[nk++] = bb * 4096 + r * 64 + c; }
            else if (lat) { for (int p = max(t - 128, 0); p <= min(t + 128, 4095); ++p) kr[nk++] = bb * 4096 + p; }
            for (int c = 0; c < 256; ++c) kr[nk++] = NLAT + bb * 256 + c;
            ((int*)sh)[3000] = nk;
        }
        __syncthreads(); nk = ((int*)sh)[3000];
        float mx = -1e30f;
        for (int k = lane; k < nk; k += 64) { const bf16* kp = Z + (size_t)kr[k] * AB_IN + kcol; float s = 0.f; for (int d = 0; d < 64; ++d) s += bf2f(q[d]) * bf2f(kp[d]); s *= 0.125f;
            if (lat && hs < 8 && kr[k] < NLAT) { const int kt = kr[k] & 4095, r = kt >> 6, c = kt & 63; s += a.in[14][hs * 465 + (r - qr + 7) * 31 + min(max(c - qc + 15, 0), 30)]; }
            lg[k] = s; mx = fmaxf(mx, s); }
        if (hs >= 8) mx = fmaxf(mx, a.in[15][hs - 8]);
        mx = wave_max(mx); __syncthreads(); float den = 0.f;
        for (int k = lane; k < nk; k += 64) { lg[k] = expf(lg[k] - mx); den += lg[k]; }
        den = wave_sum(den); if (hs >= 8) den += expf(a.in[15][hs - 8] - mx);
        __syncthreads();
        float o = 0.f; for (int k = 0; k < nk; ++k) o += lg[k] * bf2f(Z[(size_t)kr[k] * AB_IN + vcol + lane]);
        o /= den; const float got = bf2f(ACT2[(size_t)row * DM + (hs < 8 ? hs * 64 : 512 + (hs - 8) * 64) + lane]);
        err = wave_max(fabsf(got - o)) / fmaxf(wave_max(fabsf(o)), 0.02f);
    } else if (check == 5) {
        const int row = (b * 1031 + 7) % NROW; const bool lat = row < NLAT; const int br = lat ? row >> 12 : 16; float md = 0.f;
        for (int j = 0; j < 16; ++j) { const int col = (b * 37 + j * 149) % DM; float s = 0.f;
            for (int k = lane; k < 1024; k += 64) s += bf2f(ACT2[(size_t)row * DM + k]) * a.in[8][(size_t)k * DM + col];
            s = wave_sum(s); const float base = lat ? a.in[0][(size_t)row * DM + col] : a.in[2][(size_t)(row - NLAT) * DM + col];
            const float ref = base + MOD[(size_t)br * 6144 + 2048 + col] * s, got = lat ? a.out[(size_t)row * DM + col] : ((const float*)(ws + WS_CTXRES))[(size_t)(row - NLAT) * DM + col];
            md = fmaxf(md, fabsf(ref - got) / fmaxf(fabsf(MOD[(size_t)br * 6144 + 2048 + col] * s), 0.02f)); }
        err = md;
    } else if (check == 6) {
        const int row = (b * 1031 + 7) % NROW, hp = b & 15; const bf16* h2 = ACT1 + (size_t)row * DM;
        for (int dd = 0; dd < 2; ++dd) { const int d = lane + 64 * dd; float s = 0.f; for (int k = 0; k < 1024; ++k) s += bf2f(h2[k]) * a.in[9][(size_t)k * PQ_N + hp * 128 + d]; sh[d] = s; }
        __syncthreads(); float md = 0.f, mr = 0.f;
        for (int nn = 0; nn < 2; ++nn) { const int n = lane + 64 * nn; float s = 0.f; for (int d = 0; d < 128; ++d) s += sh[d] * a.in[10][((size_t)(hp & 1) * 128 + n) * 128 + d];
            md = fmaxf(md, fabsf(s - bf2f(Z[(size_t)row * PQ_N + hp * 128 + n]))); mr = fmaxf(mr, fabsf(s)); }
        err = wave_max(md) / wave_max(mr);
    } else if (check == 7) {
        const int row = (b * 31 + 3) % 2048; const bf16* h2 = ACT1 + (size_t)row * DM;
        for (int hp = 0; hp < 16; ++hp) {
            float v0 = bf2f(Z[(size_t)row * PQ_N + hp * 128 + lane]), v1 = bf2f(Z[(size_t)row * PQ_N + hp * 128 + 64 + lane]);
            for (int it = 0; it < 16; ++it) { float v = v0; int i = lane; if (v1 > v0) { v = v1; i = lane + 64; } wave_argmax(v, i); if (lane == 0) { sv[hp][it] = v; si[hp][it] = i; } if (i == lane) v0 = -3e38f; if (i == lane + 64) v1 = -3e38f; }
        }
        __syncthreads();
        float f[16]; for (int m = 0; m < 16; ++m) f[m] = 0.f;
        for (int h = 0; h < 8; ++h) {
            float cv[4]; for (int r = 0; r < 4; ++r) { const int c = lane * 4 + r; cv[r] = sv[2 * h][c >> 4] + sv[2 * h + 1][c & 15]; }
            float fv[16]; int fe[16];
            for (int it = 0; it < 16; ++it) { float v = cv[0]; int i = lane * 4; for (int r = 1; r < 4; ++r) if (cv[r] > v) { v = cv[r]; i = lane * 4 + r; } wave_argmax(v, i); fv[it] = v; fe[it] = si[2 * h][i >> 4] * 128 + si[2 * h + 1][i & 15]; if ((i >> 2) == lane) cv[i & 3] = -3e38f; }
            float den = 0.f; for (int it = 0; it < 16; ++it) den += expf(fv[it] - fv[0]);
            const float* sd = FDBG + (size_t)2048 * DM + (size_t)row * 384;
            if (h == 0 && lane == 0) { sh[4000] = 0.f; sh[4001] = 0.f; }
            for (int it = 0; it < 16; ++it) { const int e = fe[it]; float s = 0.f; for (int k = lane; k < 1024; k += 64) s += a.in[11][(size_t)e * DM + k] * bf2f(h2[k]);
                s = wave_sum(s); const float wgt = 0.5f * s * (1.f + erff(s * 0.70710678f)) * expf(fv[it] - fv[0]) / den;
                if (lane == 0) { float best = 1e9f, bw = 1e9f; for (int q = 0; q < 16; ++q) if ((int)sd[h * 16 + q] == e) { best = fabsf(sd[128 + h * 16 + q] - expf(fv[it] - fv[0]) / den); bw = fabsf(sd[256 + h * 16 + q] - wgt) / fmaxf(fabsf(wgt), 1e-3f); }
                    sh[4000] = fmaxf(sh[4000], best); sh[4001] = fmaxf(sh[4001], bw); }
                for (int m = 0; m < 16; ++m) f[m] += wgt * a.in[12][(size_t)e * DM + lane + 64 * m]; }
        }
        float md = 0.f, mr = 0.f; for (int m = 0; m < 16; ++m) { md = fmaxf(md, fabsf(f[m] - FDBG[(size_t)row * DM + lane + 64 * m])); mr = fmaxf(mr, fabsf(f[m])); }
        const float e9 = wave_max(md) / wave_max(mr);
        if (lane == 0) { DBG[9 * 64 + b] = e9; DBG[7 * 64 + b] = sh[4000]; DBG[8 * 64 + b] = sh[4001]; }
        return;
    }
    err = wave_max(err);
    if (lane == 0) DBG[check * 64 + b] = err;
}
__global__ void __launch_bounds__(256) dbg_report(Args a, unsigned mask) {
    const size_t n = (size_t)NLAT * DM; float* out = a.out;
    for (size_t i = (size_t)blockIdx.x * 256 + threadIdx.x; i < n; i += (size_t)gridDim.x * 256) out[i] = 0.f;
    if (blockIdx.x == 0 && threadIdx.x == 0) {
        const float* DBG = (const float*)(a.ws + WS_DBG); int id = 0; float e = 0.f, eall = 0.f;
        for (int c = 1; c < 32 && id == 0; ++c) if (mask >> c & 1) { float m = 0.f; for (int b = 0; b < 64; ++b) { const float v = DBG[c * 64 + b]; m = (v == v) ? fmaxf(m, v) : 1e9f; } eall = fmaxf(eall, m); if (m > 0.03f) { id = c; e = m; } }
        if (id == 0) e = eall;
        float mm = 1.f + 2.2f * (log10f(fmaxf(e, 1e-4f)) + 4.f); mm = fminf(fmaxf(mm, 1.f), 9.8f);
        out[0] = mm * powf(10.f, 3.f + (float)id);
    }
}
#endif

#if defined(DEBUG_TIME)
__global__ void __launch_bounds__(256) time_report(Args a, unsigned maskA, unsigned maskB) {
    const unsigned long long* TS = (const unsigned long long*)(a.ws + 980 * MiB);
    float ta = 0.f, tb = 0.f;
    for (int k = 0; k < 16; ++k) { const float d = (float)(TS[k + 1] - TS[k]) * 0.01f; if (maskA >> k & 1) ta += d; if (maskB >> k & 1) tb += d; }
    const size_t n = (size_t)NLAT * DM, K = (size_t)(tb * 1000.f); float* out = a.out;
    for (size_t i = (size_t)blockIdx.x * 256 + threadIdx.x; i < n; i += (size_t)gridDim.x * 256) out[i] = i < K ? ta : 0.f;
}
#endif
extern "C" void kernel_launch(void* const* d_in, const int* in_sizes, int n_in, void* d_out, int out_size, void* d_ws, size_t ws_size, hipStream_t stream) {
    static int grid = 0;
    if (grid == 0) {
        if (n_in != 24 || out_size != NLAT * DM || ws_size < WS_END) { fprintf(stderr, "kernel_launch: unexpected shapes (n_in %d, out %d, ws %zu)\n", n_in, out_size, ws_size); grid = -1; return; }
        int dev = 0, cus = 0, per_cu = 0;
        if (hipGetDevice(&dev) != hipSuccess || hipDeviceGetAttribute(&cus, hipDeviceAttributeMultiprocessorCount, dev) != hipSuccess) { grid = -1; return; }
        if (hipFuncSetAttribute((const void*)fwd, hipFuncAttributeMaxDynamicSharedMemorySize, LDS_BYTES) != hipSuccess) { fprintf(stderr, "kernel_launch: hipFuncSetAttribute failed\n"); grid = -1; return; }
        if (hipOccupancyMaxActiveBlocksPerMultiprocessor(&per_cu, (const void*)fwd, NTHREADS, LDS_BYTES) != hipSuccess || per_cu < 1) { fprintf(stderr, "kernel_launch: occupancy query says %d blocks per CU\n", per_cu); }
        (void)hipGetLastError();
        grid = cus;
    }
    if (grid < 0) return;
    (void)hipMemsetAsync((char*)d_ws + WS_CTL, 0, CTL_ZERO_BYTES, stream);
    Args a{};
    for (int i = 0; i < 24; ++i) a.in[i] = (const float*)d_in[i];
    a.out = (float*)d_out; a.ws = (unsigned char*)d_ws;
#if ONE_LAUNCH
    a.ph_lo = 0; a.ph_hi = 24;
    hipLaunchKernelGGL(fwd, dim3(grid), dim3(NTHREADS), LDS_BYTES, stream, a);
#if defined(DEBUG_TIME)
    hipLaunchKernelGGL(time_report, dim3(2048), dim3(256), 0, stream, a, (unsigned)(TIME_MASK_A), (unsigned)(TIME_MASK_B));
#endif
#else
    for (int p = 0; p <= STOP_AFTER; ++p) for (int rep = 0; rep <= (((REPEAT_MASK) >> p) & 1); ++rep) { a.ph_lo = p; a.ph_hi = p + 1;
#if defined(ATT_PROBE)
        if (rep == 0 && p == 15 && (((REPEAT_MASK) >> p) & 1)) a.ph_hi |= (ATT_PROBE) << 8;
#endif
        hipLaunchKernelGGL(fwd, dim3(grid), dim3(NTHREADS), LDS_BYTES, stream, a); }
#if defined(DEBUG_CHECK)
    for (int c = 1; c < 32; ++c) if ((unsigned)(DEBUG_CHECK) >> c & 1) hipLaunchKernelGGL(dbg_check, dim3(64), dim3(64), 0, stream, a, c);
    hipLaunchKernelGGL(dbg_report, dim3(2048), dim3(256), 0, stream, a, (unsigned)(DEBUG_CHECK));
#elif STOP_AFTER < 23
    a.ph_lo = 24; a.ph_hi = 25; hipLaunchKernelGGL(fwd, dim3(grid), dim3(NTHREADS), LDS_BYTES, stream, a);
#endif
#endif
}
```

```cpp
#include <hip/hip_runtime.h>
#include <cstdio>
#include <cstdint>

#define GAS __attribute__((address_space(1)))
#define LAS __attribute__((address_space(3)))
typedef unsigned short bf16;
typedef unsigned u32x4 __attribute__((ext_vector_type(4)));
typedef unsigned u32x2 __attribute__((ext_vector_type(2)));
typedef float f32x4 __attribute__((ext_vector_type(4)));
typedef float f32x2 __attribute__((ext_vector_type(2)));
typedef float f32x16 __attribute__((ext_vector_type(16)));
typedef short bf16x8 __attribute__((ext_vector_type(8)));
typedef short s16x4 __attribute__((ext_vector_type(4)));
typedef __bf16 bf2_t __attribute__((ext_vector_type(2)));

constexpr int NB = 16, SEQ = 4096, DM = 1024, CTX = 256, NLAT = NB * SEQ, NCTX = NB * CTX, NROW = NLAT + NCTX;
constexpr int AB_IN = 2304, CD_IN = 1952, CD_PAD = 2048, PQ_N = 2048, NEXP = 16384;
constexpr float RMS_EPS = 1e-6f, LOG2E = 1.4426950408889634f, NEGBIG = -1e30f;
constexpr float LAM_INIT1 = 0.35550906759f;

constexpr size_t MiB = 1u << 20;
constexpr size_t WS_CTL = 0, CTL_ZERO_BYTES = 1 * MiB;
constexpr size_t WS_MOD = 1 * MiB;
constexpr size_t WS_ROPE = 2 * MiB;
constexpr size_t WS_SCL = 2 * MiB + 512 * 1024;
constexpr size_t WS_RSTD = 3 * MiB;
constexpr size_t WS_WIN0 = 4 * MiB;
constexpr size_t WS_WOUT = 9 * MiB;
constexpr size_t WS_WPQ = 13 * MiB;
constexpr size_t WS_WIN1 = 21 * MiB;
constexpr size_t WS_WUQ = 25 * MiB;
constexpr size_t WS_WUKV = 25 * MiB + 512 * 1024;
constexpr size_t WS_CTXRES = 26 * MiB;
constexpr size_t WS_U = 42 * MiB;
constexpr size_t WS_V = 106 * MiB;
constexpr size_t WS_ACT1 = 170 * MiB;
constexpr size_t WS_RES = 306 * MiB;
constexpr size_t WS_Z = 442 * MiB;
constexpr size_t WS_QM = 748 * MiB;
constexpr size_t WS_KV = 844 * MiB;
constexpr size_t WS_END = 980 * MiB;
constexpr int CW_BAR = 4096;
constexpr int CW_Q = 8192;

constexpr int NWAVES = 8, NTHREADS = 512;
constexpr int LDS_BYTES = 148480;
constexpr int LDS_MISC = 147456;

__device__ __forceinline__ unsigned cvt_pk_bf16(float lo, float hi) { const f32x2 v = {lo, hi}; return __builtin_bit_cast(unsigned, __builtin_convertvector(v, bf2_t)); }
__device__ __forceinline__ unsigned pk_fp8x4(float a, float b, float c, float d) { int t = 0; t = __builtin_amdgcn_cvt_pk_fp8_f32(a, b, t, false); t = __builtin_amdgcn_cvt_pk_fp8_f32(c, d, t, true); return (unsigned)t; }
__device__ __forceinline__ float bf_lo(unsigned w) { return __uint_as_float(w << 16); }
__device__ __forceinline__ float bf_hi(unsigned w) { return __uint_as_float(w & 0xffff0000u); }
template <int CTRL> __device__ __forceinline__ float dpp_f(float v) { return __int_as_float(__builtin_amdgcn_update_dpp(0, __float_as_int(v), CTRL, 0xF, 0xF, true)); }
__device__ __forceinline__ float xlane1(float v) { return dpp_f<0xB1>(v); }
__device__ __forceinline__ float swap16_sum(float v) { const auto r = __builtin_amdgcn_permlane16_swap(__float_as_uint(v), __float_as_uint(v), false, false); return __uint_as_float(r[0]) + __uint_as_float(r[1]); }
__device__ __forceinline__ float swap32_sum(float v) { const auto r = __builtin_amdgcn_permlane32_swap(__float_as_uint(v), __float_as_uint(v), false, false); return __uint_as_float(r[0]) + __uint_as_float(r[1]); }
__device__ __forceinline__ float red8_sum(float v) { v += dpp_f<0xB1>(v); v += dpp_f<0x4E>(v); v += dpp_f<0x141>(v); return v; }
__device__ __forceinline__ float wave_sum(float v) { v = red8_sum(v); v += dpp_f<0x140>(v); v = swap16_sum(v); return swap32_sum(v); }


__device__ __forceinline__ int fresh_tid() { int t; asm volatile("v_mov_b32 %0, %1" : "=v"(t) : "v"((int)threadIdx.x)); return t; }
__device__ __forceinline__ int fresh_lane() { int l; asm volatile("v_and_b32 %0, 63, %1" : "=v"(l) : "v"((int)threadIdx.x)); return l; }

namespace pg8 {
constexpr int BM = 256, BK = 64, HALF = 128, HTB = HALF * BK * 2, NXCD = 8, WGM = 8;
__host__ __device__ __forceinline__ int lds_byte(int r, int c) { const int st = (r >> 4) * 2 + (c >> 5), rr = r & 15, cc = c & 31, ob = rr * 64 + cc * 2; return st * 1024 + (ob ^ (((ob >> 9) & 1) << 5)); }
__host__ __device__ __forceinline__ void stage_rc(int b, int& R, int& C) { const int st = b / 1024, sb = b % 1024, swz = sb ^ (((sb >> 9) & 1) << 5); R = (st >> 1) * 16 + swz / 64; C = (st & 1) * 32 + (swz % 64) / 2; }
__host__ __device__ __forceinline__ int perm32(int rho) { const int n = rho >> 4, i = rho & 15; return 8 * (i >> 2) + 4 * n + (i & 3); }
struct Unit { int pm, pn; };
struct Gemm { const void* A; const void* Bt; int M, N, Kb, lda, ldb; };
struct StaticOrder {
    int nM, nN, nwg, G, c;
    __device__ void init(int M, int N, int G_, int c_) { nM = M / BM; nN = N / BM; nwg = nM * nN; G = G_; c = c_; }
    __device__ bool next(int i, Unit& u) const {
        const long L = (long)i * G + c; if (L >= nwg) return false;
        int wgid = (int)L; { const int q = nwg / NXCD, r = nwg % NXCD, xcd = wgid % NXCD, off = wgid / NXCD; wgid = (xcd < r ? xcd * (q + 1) : r * (q + 1) + (xcd - r) * q) + off; }
        const int nig = WGM * nN, gid = wgid / nig, fm = gid * WGM, gsz = (nM - fm) < WGM ? (nM - fm) : WGM;
        u.pm = fm + ((wgid % nig) % gsz); u.pn = (wgid % nig) / gsz; return true;
    }
    __device__ __forceinline__ void a_ready(const Unit&) const {}
    __device__ __forceinline__ void done(const Unit&) const {}
};
template <class Epi, class Sched, bool F8 = false, unsigned SCW = 0x7F7F7F7Fu, unsigned SCX = 0x7F7F7F7Fu, bool ALIGN_EPI = true, bool SP2 = true, bool I8 = false>
__device__ __forceinline__ void gemm_phase(LAS unsigned char* lds, const Gemm g, const Sched& S, const Epi& E) {
    const int tid = threadIdx.x, wid = __builtin_amdgcn_readfirstlane(tid >> 6), lane = fresh_lane(), wr = wid >> 2, wc = wid & 3, fr = lane & 15, fq = lane >> 4;
    const int nt = g.Kb / (BK * 2);
    unsigned voffA[2], voffB[2];
#pragma unroll
    for (int i = 0; i < 2; ++i) { int R, C; stage_rc(tid * 16 + i * 8192, R, C); const int Rb = Epi::PERM ? ((R & ~31) + perm32(R & 31)) : R;
        voffA[i] = (unsigned)(R * g.lda + C * 2); voffB[i] = (unsigned)(Rb * g.ldb + C * 2); }
    const size_t kstep = (size_t)(BK * 2);
    const size_t hstepA = (size_t)HALF * g.lda, hstepB = (size_t)HALF * g.ldb;
    const size_t tstepA = 2 * hstepA, tstepB = 2 * hstepB;
    const unsigned ldsw = (unsigned)wid * 1024u;
    const int aoff = lds_byte(wr * 64 + fr, fq * 8), boff = lds_byte(wc * 32 + fr, fq * 8);
#define PG8_SA(b, h) (((b) * 2 + (h)) * HTB)
#define PG8_SB(b, h) ((4 + (b) * 2 + (h)) * HTB)
#define PG8_STAGE(bufoff, gbase, voff) do { _Pragma("unroll") for (int _i = 0; _i < 2; ++_i) \
        __builtin_amdgcn_global_load_lds((const unsigned*)((const char*)(gbase) + (voff)[_i]), (LAS unsigned*)(lds + (bufoff) + ldsw + _i * 8192), 16, 0, 0); } while (0)
    typedef int i32x8_ __attribute__((ext_vector_type(8))); typedef int i32x4_ __attribute__((ext_vector_type(4)));
#define PG8_LD8(ptr_) __builtin_shufflevector(*(const LAS i32x4_*)(ptr_), *(const LAS i32x4_*)((ptr_) + 1024), 0, 1, 2, 3, 4, 5, 6, 7)
#define PG8_LDA(dst, b, h) do { _Pragma("unroll") for (int m = 0; m < 4; ++m) { if constexpr (F8) dst##8[m] = PG8_LD8(lds + PG8_SA(b, h) + aoff + m * 2048); \
        else { _Pragma("unroll") for (int k = 0; k < 2; ++k) dst[m][k] = *(const LAS bf16x8*)(lds + PG8_SA(b, h) + aoff + m * 2048 + k * 1024); } } } while (0)
#define PG8_LDB(dst, b, h) do { _Pragma("unroll") for (int n = 0; n < 2; ++n) { if constexpr (F8) dst##8[n] = PG8_LD8(lds + PG8_SB(b, h) + boff + n * 2048); \
        else { _Pragma("unroll") for (int k = 0; k < 2; ++k) dst[n][k] = *(const LAS bf16x8*)(lds + PG8_SB(b, h) + boff + n * 2048 + k * 1024); } } } while (0)
#define PG8_MMA(ai, bj, At, Bt) do { __builtin_amdgcn_s_setprio(1); _Pragma("unroll") for (int m = 0; m < 4; ++m) _Pragma("unroll") for (int n = 0; n < 2; ++n) { \
        if constexpr (F8) asm volatile("v_mfma_scale_f32_16x16x128_f8f6f4 %0, %1, %2, %0, %3, %4 op_sel_hi:[0,0,0]" : "+v"(acc[ai][bj][m][n]) : "v"(Bt##8[n]), "v"(At##8[m]), "v"(scw_), "v"(scx_)); \
        else if constexpr (I8) { _Pragma("unroll") for (int k = 0; k < 2; ++k) acc[ai][bj][m][n] = __builtin_bit_cast(f32x4, __builtin_amdgcn_mfma_i32_16x16x64_i8(__builtin_bit_cast(i32x4_, Bt[n][k]), __builtin_bit_cast(i32x4_, At[m][k]), __builtin_bit_cast(i32x4_, acc[ai][bj][m][n]), 0, 0, 0)); } \
        else { _Pragma("unroll") for (int k = 0; k < 2; ++k) acc[ai][bj][m][n] = __builtin_amdgcn_mfma_f32_16x16x32_bf16(Bt[n][k], At[m][k], acc[ai][bj][m][n], 0, 0, 0); } } \
        __builtin_amdgcn_s_setprio(0); } while (0)
#define PG8_WAIT_V(n) asm volatile("s_waitcnt vmcnt(" #n ")" ::: "memory")
#define PG8_WAIT_L(n) asm volatile("s_waitcnt lgkmcnt(" #n ")" ::: "memory")
#define PG8_BAR __builtin_amdgcn_s_barrier()
#define PG8_SCHED __builtin_amdgcn_sched_barrier(0)
    Unit cur, nxt; int ui = 0;
    if (!S.next(0, cur)) return;
    f32x4 acc[2][2][4][2];
#pragma unroll
    for (int a = 0; a < 2; ++a)
#pragma unroll
        for (int b = 0; b < 2; ++b)
#pragma unroll
            for (int m = 0; m < 4; ++m)
#pragma unroll
                for (int n = 0; n < 2; ++n) acc[a][b][m][n] = (f32x4){0.f, 0.f, 0.f, 0.f};
    const int scw_ = (int)SCW, scx_ = (int)SCX;
    bf16x8 At[4][2], B0[2][2], B1[2][2]; i32x8_ At8[4], B08[2], B18[2];
    const char* cA = (const char*)g.A + (size_t)cur.pm * tstepA; const char* cB = (const char*)g.Bt + (size_t)cur.pn * tstepB;
    S.a_ready(cur);
    if constexpr (SP2) {
        PG8_STAGE(PG8_SB(0, 0), cB, voffB); PG8_STAGE(PG8_SB(0, 1), cB + hstepB, voffB); PG8_STAGE(PG8_SA(0, 0), cA, voffA); PG8_STAGE(PG8_SA(0, 1), cA + hstepA, voffA);
        if (wr == 1) PG8_BAR;
        PG8_WAIT_V(2); PG8_BAR;
        PG8_STAGE(PG8_SB(1, 0), cB + kstep, voffB); PG8_STAGE(PG8_SA(1, 0), cA + kstep, voffA); PG8_STAGE(PG8_SB(1, 1), cB + hstepB + kstep, voffB);
        PG8_WAIT_V(6); PG8_BAR;
    } else {
        PG8_STAGE(PG8_SB(0, 0), cB, voffB); PG8_STAGE(PG8_SA(0, 0), cA, voffA); PG8_STAGE(PG8_SB(0, 1), cB + hstepB, voffB); PG8_STAGE(PG8_SA(0, 1), cA + hstepA, voffA);
        if (wr == 1) PG8_BAR;
        PG8_WAIT_V(4); PG8_BAR;
        PG8_STAGE(PG8_SB(1, 0), cB + kstep, voffB); PG8_STAGE(PG8_SA(1, 0), cA + kstep, voffA); PG8_STAGE(PG8_SB(1, 1), cB + hstepB + kstep, voffB);
        PG8_WAIT_V(6); PG8_BAR;
    }
    for (;;) {
        const bool has_next = S.next(ui + 1, nxt);
        const char* nA = has_next ? (const char*)g.A + (size_t)nxt.pm * tstepA : cA; const char* nB = has_next ? (const char*)g.Bt + (size_t)nxt.pn * tstepB : cB;
#pragma unroll 1
        for (int t = 0; t < nt; t += 2) {
            const bool last = (t == nt - 2);
            const char* a1 = cA + (size_t)(t + 1) * kstep;
            const char* a2 = last ? nA : cA + (size_t)(t + 2) * kstep; const char* b2 = last ? nB : cB + (size_t)(t + 2) * kstep;
            const char* a3 = a2 + kstep; const char* b3 = b2 + kstep;
            if (last && has_next) S.a_ready(nxt);
            if constexpr (SP2) {
            PG8_LDB(B0, 0, 0); PG8_LDB(B1, 0, 1); PG8_SCHED; PG8_LDA(At, 0, 0); PG8_STAGE(PG8_SA(1, 1), a1 + hstepA, voffA);
            PG8_WAIT_V(8); PG8_WAIT_L(0); PG8_BAR; PG8_MMA(0, 0, At, B0); PG8_MMA(0, 1, At, B1); PG8_BAR; PG8_SCHED;
            PG8_LDA(At, 0, 1); PG8_STAGE(PG8_SB(0, 0), b2, voffB); PG8_STAGE(PG8_SB(0, 1), b2 + hstepB, voffB); PG8_STAGE(PG8_SA(0, 0), a2, voffA);
            PG8_WAIT_V(8); PG8_WAIT_L(0); PG8_BAR; PG8_MMA(1, 0, At, B0); PG8_MMA(1, 1, At, B1); PG8_BAR; PG8_SCHED;
            PG8_LDB(B0, 1, 0); PG8_LDB(B1, 1, 1); PG8_SCHED; PG8_LDA(At, 1, 0); PG8_STAGE(PG8_SA(0, 1), a2 + hstepA, voffA);
            PG8_WAIT_V(8); PG8_WAIT_L(0); PG8_BAR; PG8_MMA(0, 0, At, B0); PG8_MMA(0, 1, At, B1); PG8_BAR; PG8_SCHED;
            PG8_LDA(At, 1, 1); PG8_STAGE(PG8_SB(1, 0), b3, voffB); PG8_STAGE(PG8_SB(1, 1), b3 + hstepB, voffB); PG8_STAGE(PG8_SA(1, 0), a3, voffA);
            PG8_WAIT_V(8); PG8_WAIT_L(0); PG8_BAR; PG8_MMA(1, 0, At, B0); PG8_MMA(1, 1, At, B1); PG8_BAR; PG8_SCHED;
            } else {
            PG8_LDB(B0, 0, 0); PG8_SCHED; PG8_LDA(At, 0, 0); PG8_STAGE(PG8_SA(1, 1), a1 + hstepA, voffA);
            PG8_WAIT_L(8); PG8_BAR; PG8_WAIT_L(0); PG8_MMA(0, 0, At, B0); PG8_BAR; PG8_SCHED;
            PG8_LDB(B1, 0, 1); PG8_STAGE(PG8_SB(0, 0), b2, voffB);
            PG8_BAR; PG8_WAIT_L(0); PG8_MMA(0, 1, At, B1); PG8_BAR;
            PG8_LDA(At, 0, 1); PG8_STAGE(PG8_SA(0, 0), a2, voffA);
            PG8_BAR; PG8_WAIT_L(0); PG8_MMA(1, 0, At, B0); PG8_BAR; PG8_SCHED;
            PG8_STAGE(PG8_SB(0, 1), b2 + hstepB, voffB);
            PG8_WAIT_V(6); PG8_BAR; PG8_MMA(1, 1, At, B1); PG8_BAR;
            PG8_LDB(B0, 1, 0); PG8_SCHED; PG8_LDA(At, 1, 0); PG8_STAGE(PG8_SA(0, 1), a2 + hstepA, voffA);
            PG8_WAIT_L(8); PG8_BAR; PG8_WAIT_L(0); PG8_MMA(0, 0, At, B0); PG8_BAR; PG8_SCHED;
            PG8_LDB(B1, 1, 1); PG8_STAGE(PG8_SB(1, 0), b3, voffB);
            PG8_BAR; PG8_WAIT_L(0); PG8_MMA(0, 1, At, B1); PG8_BAR;
            PG8_LDA(At, 1, 1); PG8_STAGE(PG8_SA(1, 0), a3, voffA);
            PG8_BAR; PG8_WAIT_L(0); PG8_MMA(1, 0, At, B0); PG8_BAR; PG8_SCHED;
            PG8_STAGE(PG8_SB(1, 1), b3 + hstepB, voffB);
            PG8_WAIT_V(6); PG8_BAR; PG8_MMA(1, 1, At, B1); PG8_BAR;
            }
        }
        if constexpr (ALIGN_EPI) { if (wr == 0) PG8_BAR; }
        if constexpr (F8) asm volatile("s_nop 15\n\ts_nop 15" ::: "memory");
        if constexpr (I8) {
#pragma unroll
            for (int a = 0; a < 2; ++a)
#pragma unroll
                for (int b = 0; b < 2; ++b)
#pragma unroll
                    for (int m = 0; m < 4; ++m)
#pragma unroll
                        for (int n = 0; n < 2; ++n)
#pragma unroll
                            for (int e = 0; e < 4; ++e) acc[a][b][m][n][e] = (float)__float_as_int(acc[a][b][m][n][e]);
        }
        E(acc, cur, wr, wc, fr, fq); S.done(cur);
        if (!has_next) break;
#pragma unroll
        for (int a = 0; a < 2; ++a)
#pragma unroll
            for (int b = 0; b < 2; ++b)
#pragma unroll
                for (int m = 0; m < 4; ++m)
#pragma unroll
                    for (int n = 0; n < 2; ++n) acc[a][b][m][n] = (f32x4){0.f, 0.f, 0.f, 0.f};
        cur = nxt; cA = nA; cB = nB; ++ui;
        if constexpr (ALIGN_EPI) { if (wr == 1) PG8_BAR; }
    }
    PG8_WAIT_V(0);
    if constexpr (!ALIGN_EPI) { if (wr == 0) PG8_BAR; }
    PG8_BAR;
#undef PG8_SA
#undef PG8_SB
#undef PG8_STAGE
#undef PG8_LDA
#undef PG8_LDB
#undef PG8_MMA
#undef PG8_WAIT_V
#undef PG8_WAIT_L
#undef PG8_BAR
#undef PG8_SCHED
}
}
template <int MODE> struct EpiRope {
    static constexpr bool PERM = false;
    bf16* O; int ldc; const float* rope; const float* rstd;
    __device__ __forceinline__ void operator()(const f32x4 (&acc)[2][2][4][2], const pg8::Unit& u, int wr, int wc, int fr, int fq) const {
        const int row0 = u.pm * 256 + wr * 64 + fr;
#pragma unroll
        for (int ai = 0; ai < 2; ++ai)
#pragma unroll
            for (int m = 0; m < 4; ++m) {
                const int row = row0 + ai * 128 + m * 16; const bool lat = row < NLAT; const int t = row & 4095, prow = t >> 6, pcol = t & 63;
                bf16* rowp = O + (size_t)row * ldc; float qs = 1.f; if (MODE == 2) qs = rstd[(size_t)row * 2] * (0.10206207261596577f * LOG2E);
#pragma unroll
                for (int bj = 0; bj < 2; ++bj) {
                    const int G = 8 * u.pn + 4 * bj + wc, col = 32 * G + 4 * fq;
                    f32x4 x1 = acc[ai][bj][m][0], x2 = acc[ai][bj][m][1];
                    if (MODE == 1 && G >= 13 && G < 29) { x1 = x1 * (0.125f * LOG2E); x2 = x2 * (0.125f * LOG2E); }
                    if (MODE == 2) { x1 = x1 * qs; x2 = x2 * qs; }
                    int kind = 0, par = 0;
                    if (MODE == 0) { kind = (G >= 48 && G < 68) ? 1 : 0; par = G & 1; }
                    if (MODE == 1) { kind = (G == 12) ? 2 : ((G >= 13 && G < 45) ? 1 : 0); par = (G + 1) & 1; }
                    if (MODE == 2) { kind = (G % 3 == 2) ? 2 : 0; }
                    if (lat && kind == 1) {
                        const int pos = par ? pcol : prow;
                        const f32x4 c = *(const f32x4*)(rope + pos * 16 + 4 * fq), s = *(const f32x4*)(rope + 1024 + pos * 16 + 4 * fq);
                        const f32x4 o1 = x1 * c - x2 * s, o2 = x1 * s + x2 * c; x1 = o1; x2 = o2;
                    } else if (lat && kind == 2) {
                        const int pos = (fq < 2) ? prow : pcol;
                        const f32x4 c = *(const f32x4*)(rope + 2048 + pos * 8 + (4 * fq & 7)), s = *(const f32x4*)(rope + 2560 + pos * 8 + (4 * fq & 7));
                        const f32x4 o1 = x1 * c - x2 * s, o2 = x1 * s + x2 * c; x1 = o1; x2 = o2;
                    }
                    u32x2 w0, w1; w0.x = cvt_pk_bf16(x1[0], x1[1]); w0.y = cvt_pk_bf16(x1[2], x1[3]); w1.x = cvt_pk_bf16(x2[0], x2[1]); w1.y = cvt_pk_bf16(x2[2], x2[3]);
                    const auto sx = __builtin_amdgcn_permlane16_swap(w0.x, w1.x, false, false), sy = __builtin_amdgcn_permlane16_swap(w0.y, w1.y, false, false);
                    u32x4 wv; wv.x = sx[0]; wv.y = sy[0]; wv.z = sx[1]; wv.w = sy[1];
                    *(u32x4*)(rowp + col + ((fq & 1) ? 12 : 0)) = wv;
                }
                __builtin_amdgcn_sched_barrier(0);
            }
    }
};
struct EpiBf16 {
    static constexpr bool PERM = true;
    bf16* O; int ldc; const float* rstd; int ridx;
    __device__ __forceinline__ void operator()(const f32x4 (&acc)[2][2][4][2], const pg8::Unit& u, int wr, int wc, int fr, int fq) const {
        const int row0 = u.pm * 256 + wr * 64 + fr, col0 = u.pn * 256 + wc * 32 + 8 * fq;
#pragma unroll
        for (int ai = 0; ai < 2; ++ai)
#pragma unroll
            for (int m = 0; m < 4; ++m) {
                const int row = row0 + ai * 128 + m * 16; float rs = 1.f; if (rstd) rs = rstd[(size_t)row * 2 + ridx];
                bf16* rowp = O + (size_t)row * ldc + col0;
#pragma unroll
                for (int bj = 0; bj < 2; ++bj) { const f32x4 v0 = acc[ai][bj][m][0] * rs, v1 = acc[ai][bj][m][1] * rs;
                    u32x4 w; w.x = cvt_pk_bf16(v0[0], v0[1]); w.y = cvt_pk_bf16(v0[2], v0[3]); w.z = cvt_pk_bf16(v1[0], v1[1]); w.w = cvt_pk_bf16(v1[2], v1[3]);
                    *(u32x4*)(rowp + bj * 128) = w; }
            }
    }
};
struct EpiScore {
    static constexpr bool PERM = true;
    bf16* O; int ldc; const float* xs; const float* ws;
    __device__ __forceinline__ void operator()(const f32x4 (&acc)[2][2][4][2], const pg8::Unit& u, int wr, int wc, int fr, int fq) const {
        const int row0 = u.pm * 256 + wr * 64 + fr, col0 = u.pn * 256 + wc * 32 + 8 * fq;
        f32x4 cs[2][2];
#pragma unroll
        for (int bj = 0; bj < 2; ++bj) { cs[bj][0] = *(const f32x4*)(ws + col0 + bj * 128); cs[bj][1] = *(const f32x4*)(ws + col0 + bj * 128 + 4); }
#pragma unroll
        for (int ai = 0; ai < 2; ++ai)
#pragma unroll
            for (int m = 0; m < 4; ++m) {
                const int row = row0 + ai * 128 + m * 16; const float rs = xs[row];
                bf16* rowp = O + (size_t)row * ldc + col0;
#pragma unroll
                for (int bj = 0; bj < 2; ++bj) { const f32x4 v0 = acc[ai][bj][m][0] * rs * cs[bj][0], v1 = acc[ai][bj][m][1] * rs * cs[bj][1];
                    u32x4 w; w.x = cvt_pk_bf16(v0[0], v0[1]); w.y = cvt_pk_bf16(v0[2], v0[3]); w.z = cvt_pk_bf16(v1[0], v1[1]); w.w = cvt_pk_bf16(v1[2], v1[3]);
                    *(u32x4*)(rowp + bj * 128) = w; }
            }
    }
};
template <bool F32BASE> struct EpiResid {
    static constexpr bool PERM = true;
    const float* base_lat; const float* base_ctx; bf16* res; const float* gate;
    __device__ __forceinline__ void operator()(const f32x4 (&acc)[2][2][4][2], const pg8::Unit& u, int wr, int wc, int fr, int fq) const {
        const int row0 = u.pm * 256 + wr * 64 + fr, col0 = u.pn * 256 + wc * 32 + 8 * fq;
#pragma unroll
        for (int ai = 0; ai < 2; ++ai)
#pragma unroll
            for (int m = 0; m < 4; ++m) {
                const int row = row0 + ai * 128 + m * 16; const bool lat = row < NLAT; const int rr = lat ? row : row - NLAT, br = lat ? (row >> 12) : 16;
                const float* bp = (lat ? base_lat : base_ctx) + (size_t)rr * DM + col0; bf16* op = res + (size_t)row * DM + col0;
                const float* gp = gate + (size_t)br * 6144 + col0;
#pragma unroll
                for (int bj = 0; bj < 2; ++bj) {
                    const f32x4 g0 = *(const f32x4*)(gp + bj * 128), g1 = *(const f32x4*)(gp + bj * 128 + 4);
                    f32x4 b0, b1;
                    if constexpr (F32BASE) { b0 = *(const f32x4*)(bp + bj * 128); b1 = *(const f32x4*)(bp + bj * 128 + 4); }
                    else { const u32x4 rb = *(const u32x4*)(op + bj * 128); b0 = (f32x4){bf_lo(rb.x), bf_hi(rb.x), bf_lo(rb.y), bf_hi(rb.y)}; b1 = (f32x4){bf_lo(rb.z), bf_hi(rb.z), bf_lo(rb.w), bf_hi(rb.w)}; }
                    const f32x4 v0 = b0 + g0 * acc[ai][bj][m][0], v1 = b1 + g1 * acc[ai][bj][m][1];
                    u32x4 w; w.x = cvt_pk_bf16(v0[0], v0[1]); w.y = cvt_pk_bf16(v0[2], v0[3]); w.z = cvt_pk_bf16(v1[0], v1[1]); w.w = cvt_pk_bf16(v1[2], v1[3]);
                    *(u32x4*)(op + bj * 128) = w;
                }
            }
    }
};
__device__ __forceinline__ int crow(int r, int h) { return (r & 3) + 8 * (r >> 2) + 4 * h; }
__device__ __forceinline__ float fexp2(float x) { return __builtin_amdgcn_exp2f(x); }
__device__ __forceinline__ float max3f(float a, float b, float c) { float r; asm("v_max3_f32 %0, %1, %2, %3" : "=v"(r) : "v"(a), "v"(b), "v"(c)); return r; }
#ifndef ATT_SETPRIO
#define ATT_SETPRIO 0
#endif
#ifndef ATT_STAGGER
#define ATT_STAGGER 0
#endif
#if defined(ATT_PROBE)
#define ABL(k) (ABLV == (k))
#else
#define ABL(k) false
#endif
#ifndef ATT_OVF_TEST
constexpr float ATT_OVF = 1.152921504606847e18f;
#else
constexpr float ATT_OVF = -1.0f;
#endif
constexpr float ATT_THR = 10.0f;

__device__ __forceinline__ float xmax32(float v) { const auto r = __builtin_amdgcn_permlane32_swap(__float_as_uint(v), __float_as_uint(v), false, false); return fmaxf(__uint_as_float(r[0]), __uint_as_float(r[1])); }
__device__ __forceinline__ float xsum32(float v) { const auto r = __builtin_amdgcn_permlane32_swap(__float_as_uint(v), __float_as_uint(v), false, false); return __uint_as_float(r[0]) + __uint_as_float(r[1]); }
template <class P, bool LATE, int ABLV = 0>
__device__ __forceinline__ void attn_tile_a(const LAS unsigned char* Kt, const LAS unsigned char* Vt, const bf16x8 (&qf)[P::DK / 16], f32x16 (&O)[P::DV / 32], float& m, float& l, int lane, const P& p, int t,
                                            bf16x8 (&pf)[2][2], s16x4 (&vq)[P::DV / 32][2][2][2], f32x16& negm) {
    constexpr int DK = P::DK, DV = P::DV, KRS = DK * 2 + 16, NDB = DV / 32;
    const int r32 = lane & 31, h = lane >> 5;
    constexpr int NS = DK / 16;
    bf16x8 kf[NS][2];
#define AT_KREAD(s_) do { kf[s_][0] = *(const LAS bf16x8*)(Kt + r32 * KRS + (16 * (s_) + 8 * h) * 2); kf[s_][1] = *(const LAS bf16x8*)(Kt + (32 + r32) * KRS + (16 * (s_) + 8 * h) * 2); } while (0)
    f32x16 s0, s1; float ps;
    bool exact = (t == 0);
    for (;;) {
    AT_KREAD(0); AT_KREAD(1);
    __builtin_amdgcn_sched_barrier(0);
#pragma unroll
    for (int i = 0; i < 16; ++i) { s0[i] = 0.f; s1[i] = 0.f; }
#if ATT_SETPRIO
    __builtin_amdgcn_s_setprio(1);
#endif
#pragma unroll
    for (int s = 0; s < NS; ++s) {
        if (s + 2 < NS) AT_KREAD(s + 2);
        if (P::PRE && s == 0) { s0 = __builtin_amdgcn_mfma_f32_32x32x16_bf16(kf[s][0], qf[s], negm, 0, 0, 0); s1 = __builtin_amdgcn_mfma_f32_32x32x16_bf16(kf[s][1], qf[s], negm, 0, 0, 0); }
        else if (!ABL(2) && !ABL(3)) { s0 = __builtin_amdgcn_mfma_f32_32x32x16_bf16(kf[s][0], qf[s], s0, 0, 0, 0); s1 = __builtin_amdgcn_mfma_f32_32x32x16_bf16(kf[s][1], qf[s], s1, 0, 0, 0); }
        else { s0[0] += __builtin_bit_cast(float, (int)kf[s][0][0]); s1[0] += __builtin_bit_cast(float, (int)kf[s][1][0]); }
        __builtin_amdgcn_sched_barrier(0);
    }
#if ATT_SETPRIO
    __builtin_amdgcn_s_setprio(0);
#endif
    const int lanebase = ((lane >> 5) * 4 + ((lane >> 2) & 3)) * 64 + ((lane >> 4) & 1) * 32 + (lane & 3) * 8;
    if constexpr (!LATE) {
#pragma unroll
        for (int db = 0; db < (NDB > 2 ? 2 : NDB); ++db)
#pragma unroll
            for (int b = 0; b < 2; ++b)
#pragma unroll
                for (int s2 = 0; s2 < 2; ++s2)
#pragma unroll
                    for (int tq = 0; tq < 2; ++tq) vq[db][b][s2][tq] = __builtin_amdgcn_ds_read_tr16_b64_v4i16((LAS s16x4*)(Vt + ((4 * b + 2 * s2 + tq) * NDB + db) * 512 + lanebase));
    }
    __builtin_amdgcn_sched_barrier(0);
    ps = 0.f;
    if constexpr (P::MASKED) {
        p.mask(t, s0, s1, lane);
        float mx = fmaxf(s0[0], s1[0]);
#pragma unroll
        for (int i = 1; i < 16; ++i) mx = max3f(mx, s0[i], s1[i]);
        mx = xmax32(mx);
        if (__builtin_amdgcn_ballot_w64(mx > m + ATT_THR) != 0ull) {
            const float mn = fmaxf(m, mx), alpha = fexp2(m - mn); m = mn; l *= alpha;
#pragma unroll
            for (int db = 0; db < NDB; ++db) O[db] = O[db] * alpha;
            asm volatile("" ::: "memory");
        }
#pragma unroll
        for (int i = 0; i < 16; ++i) { const float a = fexp2(s0[i] - m), b = fexp2(s1[i] - m); s0[i] = a; s1[i] = b; ps += a + b; }
    } else if constexpr (P::PRE) {
        if (exact) {
            float mx = fmaxf(s0[0], s1[0]);
#pragma unroll
            for (int i = 1; i < 16; ++i) mx = max3f(mx, s0[i], s1[i]);
            mx = xmax32(mx);
            const float d = (t == 0) ? mx : fmaxf(mx, 0.f);
            if (t != 0) { const float alpha = fexp2(-d); l *= alpha;
#pragma unroll
                for (int db = 0; db < NDB; ++db) O[db] = O[db] * alpha; }
            m += d;
#pragma unroll
            for (int i = 0; i < 16; ++i) { s0[i] -= d; s1[i] -= d; negm[i] = -m; }
            asm volatile("" ::: "memory");
        }
#pragma unroll
        for (int i = 0; i < 16; ++i) { const float a = fexp2(s0[i]), b = fexp2(s1[i]); s0[i] = a; s1[i] = b; ps += a + b; }
    } else {
        const float c2 = p.c2;
        float mx = fmaxf(s0[0], s1[0]);
#pragma unroll
        for (int i = 1; i < 16; ++i) mx = max3f(mx, s0[i], s1[i]);
        mx = xmax32(mx) * c2;
        if (__builtin_amdgcn_ballot_w64(mx > m + ATT_THR) != 0ull) {
            const float mn = fmaxf(m, mx), alpha = fexp2(m - mn); m = mn; l *= alpha;
#pragma unroll
            for (int db = 0; db < NDB; ++db) O[db] = O[db] * alpha;
            asm volatile("" ::: "memory");
        }
        const float nm = -m;
        if (!ABL(1) && !ABL(3)) {
#pragma unroll
        for (int i = 0; i < 16; ++i) { const float a = fexp2(fmaf(s0[i], c2, nm)), b = fexp2(fmaf(s1[i], c2, nm)); s0[i] = a; s1[i] = b; ps += a + b; }
        } else ps = 1.f;
    }
    if constexpr (P::PRE) { if (exact || __builtin_amdgcn_ballot_w64(!(ps <= ATT_OVF)) == 0ull) break; exact = true; }
    else break;
    }
    l += ps;
#pragma unroll
    for (int s2 = 0; s2 < 2; ++s2) {
        u32x4 w0, w1;
        w0.x = cvt_pk_bf16(s0[8 * s2 + 0], s0[8 * s2 + 1]); w0.y = cvt_pk_bf16(s0[8 * s2 + 2], s0[8 * s2 + 3]); w0.z = cvt_pk_bf16(s0[8 * s2 + 4], s0[8 * s2 + 5]); w0.w = cvt_pk_bf16(s0[8 * s2 + 6], s0[8 * s2 + 7]);
        w1.x = cvt_pk_bf16(s1[8 * s2 + 0], s1[8 * s2 + 1]); w1.y = cvt_pk_bf16(s1[8 * s2 + 2], s1[8 * s2 + 3]); w1.z = cvt_pk_bf16(s1[8 * s2 + 4], s1[8 * s2 + 5]); w1.w = cvt_pk_bf16(s1[8 * s2 + 6], s1[8 * s2 + 7]);
        pf[0][s2] = __builtin_bit_cast(bf16x8, w0); pf[1][s2] = __builtin_bit_cast(bf16x8, w1);
    }
    __builtin_amdgcn_sched_barrier(0);
#undef AT_KREAD
}
template <class P, bool LATE, int ABLV = 0>
__device__ __forceinline__ void attn_tile_b(f32x16 (&O)[P::DV / 32], const bf16x8 (&pf)[2][2], s16x4 (&vq)[P::DV / 32][2][2][2], const LAS unsigned char* Vt, int lane) {
    constexpr int NDB = P::DV / 32;
    if constexpr (LATE) {
        const int lanebase = ((lane >> 5) * 4 + ((lane >> 2) & 3)) * 64 + ((lane >> 4) & 1) * 32 + (lane & 3) * 8;
#pragma unroll
        for (int db = 0; db < NDB; ++db)
#pragma unroll
            for (int b = 0; b < 2; ++b)
#pragma unroll
                for (int s2 = 0; s2 < 2; ++s2)
#pragma unroll
                    for (int tq = 0; tq < 2; ++tq) vq[db][b][s2][tq] = __builtin_amdgcn_ds_read_tr16_b64_v4i16((LAS s16x4*)(Vt + ((4 * b + 2 * s2 + tq) * NDB + db) * 512 + lanebase));
        __builtin_amdgcn_sched_barrier(0);
    }
    if constexpr (!LATE && NDB > 2) {
        const int lanebase = ((lane >> 5) * 4 + ((lane >> 2) & 3)) * 64 + ((lane >> 4) & 1) * 32 + (lane & 3) * 8;
#pragma unroll
        for (int db = 2; db < NDB; ++db)
#pragma unroll
            for (int b = 0; b < 2; ++b)
#pragma unroll
                for (int s2 = 0; s2 < 2; ++s2)
#pragma unroll
                    for (int tq = 0; tq < 2; ++tq) vq[db][b][s2][tq] = __builtin_amdgcn_ds_read_tr16_b64_v4i16((LAS s16x4*)(Vt + ((4 * b + 2 * s2 + tq) * NDB + db) * 512 + lanebase));
    }
#pragma unroll
    for (int db = 0; db < NDB; ++db)
#pragma unroll
        for (int b = 0; b < 2; ++b)
#pragma unroll
            for (int s2 = 0; s2 < 2; ++s2) {
                if (NDB > 2 && db == 2 && b == 0 && s2 == 0) __builtin_amdgcn_sched_barrier(0);
                const s16x4 v0 = vq[db][b][s2][0], v1 = vq[db][b][s2][1];
                const bf16x8 vf = {v0[0], v0[1], v0[2], v0[3], v1[0], v1[1], v1[2], v1[3]};
                if (!ABL(2) && !ABL(3)) O[db] = __builtin_amdgcn_mfma_f32_32x32x16_bf16(vf, pf[b][s2], O[db], 0, 0, 0);
                else O[db][0] += __builtin_bit_cast(float, (int)vf[0]) + __builtin_bit_cast(float, (int)pf[b][s2][0]);
            }
}

template <class P>
__device__ __forceinline__ void attn_tile_na(const LAS unsigned char* Kt, const LAS unsigned char* Vt, const bf16x8 (&qf)[4], f32x16 (&O)[2], float& m, float& l, int lane, const P& p, int t) {
    constexpr int KRS = 64 * 2 + 16, NDB = 2;
    const int r32 = lane & 31, h = lane >> 5;
    const LAS unsigned char* kb = Kt + (p.cs + r32) * KRS + 16 * h;
    bf16x8 kf[4];
#pragma unroll
    for (int s = 0; s < 4; ++s) kf[s] = *(const LAS bf16x8*)(kb + 32 * s);
    const int lanebase = ((lane >> 5) * 4 + ((lane >> 2) & 3)) * 64 + ((lane >> 4) & 1) * 32 + (lane & 3) * 8;
    const LAS unsigned char* vb = Vt + (p.cs >> 3) * (NDB * 512) + lanebase;
    s16x4 vq[NDB][2][2];
#pragma unroll
    for (int db = 0; db < NDB; ++db)
#pragma unroll
        for (int s2 = 0; s2 < 2; ++s2)
#pragma unroll
            for (int tq = 0; tq < 2; ++tq) vq[db][s2][tq] = __builtin_amdgcn_ds_read_tr16_b64_v4i16((LAS s16x4*)(vb + ((2 * s2 + tq) * NDB + db) * 512));
    const int kr = p.lo + t - 4; const int br = (kr >= p.r0i && kr < p.r0i + 8) ? kr - p.qi + 7 : 15;
    const LAS unsigned char* rb = (const LAS unsigned char*)(p.rpb + br * 32);
    const float c2 = 0.125f * LOG2E;
    f32x16 s0; float ps; bool exact = false;
    for (;;) {
#pragma unroll
        for (int i = 0; i < 16; ++i) s0[i] = 0.f;
#pragma unroll
        for (int s = 0; s < 4; ++s) s0 = __builtin_amdgcn_mfma_f32_32x32x16_bf16(kf[s], qf[s], s0, 0, 0, 0);
#pragma unroll
        for (int i = 0; i < 16; ++i) { const unsigned off = (i & 1) ? (p.dpk[i >> 1] >> 16) : (p.dpk[i >> 1] & 0xffffu); s0[i] = fmaf(s0[i], c2, *(const LAS float*)(rb + off)); }
        if (exact) {
            float mx = s0[0];
#pragma unroll
            for (int i = 1; i < 15; i += 2) mx = max3f(mx, s0[i], s0[i + 1]);
            mx = xmax32(fmaxf(mx, s0[15]));
            const float mn = fmaxf(m, mx), alpha = fexp2(m - mn); m = mn; l *= alpha;
#pragma unroll
            for (int db = 0; db < NDB; ++db) O[db] = O[db] * alpha;
            asm volatile("" ::: "memory");
        }
        ps = 0.f;
#pragma unroll
        for (int i = 0; i < 16; ++i) { const float a = fexp2(s0[i] - m); s0[i] = a; ps += a; }
        if (exact || __builtin_amdgcn_ballot_w64(!(ps <= ATT_OVF)) == 0ull) break;
        exact = true;
    }
    l += ps;
    bf16x8 pf[2];
#pragma unroll
    for (int s2 = 0; s2 < 2; ++s2) { u32x4 w0;
        w0.x = cvt_pk_bf16(s0[8 * s2 + 0], s0[8 * s2 + 1]); w0.y = cvt_pk_bf16(s0[8 * s2 + 2], s0[8 * s2 + 3]); w0.z = cvt_pk_bf16(s0[8 * s2 + 4], s0[8 * s2 + 5]); w0.w = cvt_pk_bf16(s0[8 * s2 + 6], s0[8 * s2 + 7]);
        pf[s2] = __builtin_bit_cast(bf16x8, w0); }
#pragma unroll
    for (int db = 0; db < NDB; ++db)
#pragma unroll
        for (int s2 = 0; s2 < 2; ++s2) { const s16x4 v0 = vq[db][s2][0], v1 = vq[db][s2][1];
            const bf16x8 vf = {v0[0], v0[1], v0[2], v0[3], v1[0], v1[1], v1[2], v1[3]};
            O[db] = __builtin_amdgcn_mfma_f32_32x32x16_bf16(vf, pf[s2], O[db], 0, 0, 0); }
}

template <class P, int ABLV = 0>
__device__ __forceinline__ void attn_unit(LAS unsigned char* lds, const P& p, const bf16* qptr, float m, float l, f32x16 (&O)[P::DV / 32]) {
    constexpr int DK = P::DK, DV = P::DV, KRS = DK * 2 + 16, KBYTES = 64 * KRS, VBYTES = 64 * DV * 2, NDB = DV / 32, NV = DV / 64, VCH = DV / 8;
    const int tid = fresh_tid(), lane = fresh_lane(), h = lane >> 5;
    bf16x8 qf[DK / 16];
#pragma unroll
    for (int s = 0; s < DK / 16; ++s) qf[s] = *(const bf16x8*)(qptr + 16 * s + 8 * h);
#pragma unroll
    for (int db = 0; db < NDB; ++db)
#pragma unroll
        for (int i = 0; i < 16; ++i) O[db][i] = 0.f;
    const int kkey = tid >> 3, kch = tid & 7, k2key = tid >> 2, k2ch = tid & 3;
    u32x4 kr, kr2 = (u32x4){0u, 0u, 0u, 0u}, vr[NV];
#define AT_LOAD(t_) do { const bf16 *kp_, *k2p_, *vp_; p.src((t_), kp_, k2p_, vp_); kr = *(const u32x4*)(kp_ + (size_t)kkey * p.ldk + kch * 8); \
        if (DK == 96) { if (tid < 256) kr2 = *(const u32x4*)(k2p_ + (size_t)k2key * p.ldk2 + k2ch * 8); } \
        _Pragma("unroll") for (int i_ = 0; i_ < NV; ++i_) { const int c_ = tid + 512 * i_, key_ = c_ / VCH, ch_ = c_ % VCH; vr[i_] = *(const u32x4*)(vp_ + (size_t)key_ * p.ldv + ch_ * 8); } } while (0)
#define AT_STORE(buf_, vbuf_) do { LAS unsigned char* kb_ = lds + (buf_) * KBYTES; LAS unsigned char* vb_ = lds + 2 * KBYTES + (vbuf_) * VBYTES; \
        *(LAS u32x4*)(kb_ + kkey * KRS + kch * 16) = kr; if (DK == 96) { if (tid < 256) *(LAS u32x4*)(kb_ + k2key * KRS + 128 + k2ch * 16) = kr2; } \
        _Pragma("unroll") for (int i_ = 0; i_ < NV; ++i_) { const int c_ = tid + 512 * i_, key_ = c_ / VCH, ch_ = c_ % VCH; \
            *(LAS u32x4*)(vb_ + ((key_ >> 3) * NDB + (ch_ >> 2)) * 512 + (key_ & 7) * 64 + (ch_ & 3) * 16) = vr[i_]; } } while (0)
    const int nt = p.nt;
    const bool late = P::STAGGER && __builtin_amdgcn_readfirstlane(tid >> 6) >= 4; bool pend = false;
    bf16x8 pf[2][2]; s16x4 vq[NDB][2][2][2]; f32x16 negm;
    if constexpr (P::PRE) { m = 0.f;
#pragma unroll
        for (int i = 0; i < 16; ++i) negm[i] = 0.f; }
#pragma unroll
    for (int i = 0; i < 2; ++i)
#pragma unroll
        for (int j = 0; j < 2; ++j) pf[i][j] = (bf16x8){0, 0, 0, 0, 0, 0, 0, 0};
#pragma unroll
    for (int db = 0; db < NDB; ++db)
#pragma unroll
        for (int i = 0; i < 8; ++i) vq[db][i >> 2][(i >> 1) & 1][i & 1] = (s16x4){0, 0, 0, 0};
    u32x4 krB, kr2B = (u32x4){0u, 0u, 0u, 0u}, vrB[NV];
#define AT_SWAP_IN_B() do { kr = krB; kr2 = kr2B; _Pragma("unroll") for (int i_ = 0; i_ < NV; ++i_) vr[i_] = vrB[i_]; } while (0)
#define AT_LOADB(t_) do { const bf16 *kp_, *k2p_, *vp_; p.src((t_), kp_, k2p_, vp_); krB = *(const u32x4*)(kp_ + (size_t)kkey * p.ldk + kch * 8); \
        if (DK == 96) { if (tid < 256) kr2B = *(const u32x4*)(k2p_ + (size_t)k2key * p.ldk2 + k2ch * 8); } \
        _Pragma("unroll") for (int i_ = 0; i_ < NV; ++i_) { const int c_ = tid + 512 * i_, key_ = c_ / VCH, ch_ = c_ % VCH; vrB[i_] = *(const u32x4*)(vp_ + (size_t)key_ * p.ldv + ch_ * 8); } } while (0)
    AT_LOAD(0); AT_STORE(0, 0);
    if (nt > 1) AT_LOAD(1);
    __syncthreads();
    for (int t = 0; t < nt; ++t) {
        if (t + 2 < nt) AT_LOADB(t + 2);
        if (p.active(t)) {
            bool done = false;
            if constexpr (P::NAHALF) { if (t >= 4) { attn_tile_na<P>(lds + (t & 1) * KBYTES, lds + 2 * KBYTES + (t & 1) * VBYTES, qf, O, m, l, lane, p, t); done = true; } }
            if (!done) {
                attn_tile_a<P, false, ABLV>(lds + (t & 1) * KBYTES, lds + 2 * KBYTES + (t & 1) * VBYTES, qf, O, m, l, lane, p, t, pf, vq, negm);
                attn_tile_b<P, false, ABLV>(O, pf, vq, lds + 2 * KBYTES + (t & 1) * VBYTES, lane);
            }
        }
        if (t + 1 < nt) AT_STORE((t + 1) & 1, (t + 1) & 1);
        AT_SWAP_IN_B();
        __syncthreads();
    }
#undef AT_SWAP_IN_B
#undef AT_LOADB
#undef AT_LOAD
#undef AT_STORE
    const float lt = xsum32(l), inv = lt > 0.f ? 1.f / lt : 0.f;
#pragma unroll
    for (int db = 0; db < NDB; ++db) O[db] = O[db] * inv;
}
template <int NDB> __device__ __forceinline__ void store_o8(unsigned char* orow, const f32x16 (&O)[NDB], int h) {
#pragma unroll
    for (int db = 0; db < NDB; ++db) {
        unsigned p[4];
#pragma unroll
        for (int g = 0; g < 4; ++g) p[g] = pk_fp8x4(O[db][4 * g] * 16.f, O[db][4 * g + 1] * 16.f, O[db][4 * g + 2] * 16.f, O[db][4 * g + 3] * 16.f);
        const auto s02 = __builtin_amdgcn_permlane32_swap(p[0], p[2], false, false);
        const auto s13 = __builtin_amdgcn_permlane32_swap(p[1], p[3], false, false);
        u32x4 w; w.x = s02[0]; w.y = s02[1]; w.z = s13[0]; w.w = s13[1];
        *(u32x4*)(orow + 32 * db + 16 * h) = w;
    }
}
template <int NDB> __device__ __forceinline__ void store_o(bf16* orow, const f32x16 (&O)[NDB], int h) {
#pragma unroll
    for (int db = 0; db < NDB; ++db)
#pragma unroll
        for (int g = 0; g < 4; ++g) { u32x2 w; w.x = cvt_pk_bf16(O[db][4 * g], O[db][4 * g + 1]); w.y = cvt_pk_bf16(O[db][4 * g + 2], O[db][4 * g + 3]); *(u32x2*)(orow + 32 * db + 8 * g + 4 * h) = w; }
}

template <int DK_, int DV_, bool PRE_ = false> struct PolPlain {
    static constexpr int DK = DK_, DV = DV_; static constexpr bool PRE = PRE_, NAHALF = false, MASKED = false, STAGGER = ATT_STAGGER && (DV_ == 64) && (DK_ == 96);
    const bf16 *kb, *k2b, *vb; int ldk, ldk2, ldv; int lat0, ctx0, nlat, nt; float c2;
    __device__ __forceinline__ void src(int t, const bf16*& k, const bf16*& k2, const bf16*& v) const {
        const int row = (t < nlat) ? lat0 + 64 * t : ctx0 + 64 * (t - nlat);
        k = kb + (size_t)row * ldk; k2 = k2b + (size_t)row * ldk2; v = vb + (size_t)row * ldv; }
    __device__ __forceinline__ bool active(int) const { return true; }
    __device__ __forceinline__ void mask(int, f32x16& s0, f32x16& s1, int) const { s0 = s0 * c2; s1 = s1 * c2; }
};
struct PolNA {
    static constexpr int DK = 64, DV = 64; static constexpr bool MASKED = true, STAGGER = false, PRE = false, NAHALF = true;
    const bf16 *kb, *k2b, *vb; int ldk, ldk2, ldv; int lat0, ctx0, lo, nt; int ra, rb, cs; const LAS float* rpb;
    int qi, r0i, qc;
    __device__ __forceinline__ void src(int t, const bf16*& k, const bf16*& k2, const bf16*& v) const {
        const int row = (t < 4) ? ctx0 + 64 * t : lat0 + 64 * (lo + t - 4);
        k = kb + (size_t)row * ldk; k2 = k; v = vb + (size_t)row * ldv; }
    __device__ __forceinline__ bool active(int t) const { const int kr = lo + t - 4; return t < 4 || (kr >= ra && kr < rb + 8); }
    unsigned dpk[8];
    __device__ __forceinline__ void init_lane(int lane) {
        const int h = lane >> 5, wc = iclamp_(qc - 8, 0, 48);
#pragma unroll
        for (int i = 0; i < 16; ++i) {
            const int kc = cs + crow(i, h); const int d = (kc >= wc && kc < wc + 16) ? min(max(kc - qc + 15, 0), 30) : 31;
            if (i & 1) dpk[i >> 1] |= (unsigned)(d * 4) << 16; else dpk[i >> 1] = (unsigned)(d * 4);
        }
    }
    static __device__ __forceinline__ int iclamp_(int v, int lo_, int hi_) { return v < lo_ ? lo_ : (v > hi_ ? hi_ : v); }
    __device__ __forceinline__ void mask(int, f32x16& s0, f32x16& s1, int) const { const float c2 = 0.125f * LOG2E; s0 = s0 * c2; s1 = s1 * c2; }
};
struct PolSWA {
    static constexpr int DK = 64, DV = 64; static constexpr bool MASKED = true, STAGGER = false, PRE = false, NAHALF = false;
    const bf16 *kb, *k2b, *vb; int ldk, ldk2, ldv; int lat0, ctx0, pos0, nt; int qp;
    __device__ __forceinline__ void src(int t, const bf16*& k, const bf16*& k2, const bf16*& v) const {
        const int row = (t < 4) ? ctx0 + 64 * t : lat0 + pos0 + 64 * (t - 4);
        k = kb + (size_t)row * ldk; k2 = k; v = vb + (size_t)row * ldv; }
    __device__ __forceinline__ bool active(int) const { return true; }
    __device__ __forceinline__ void mask(int t, f32x16& s0, f32x16& s1, int lane) const {
        const float c2 = 0.125f * LOG2E;
        if (t < 4) { s0 = s0 * c2; s1 = s1 * c2; return; }
        const int h = lane >> 5, kp0 = pos0 + 64 * (t - 4) - qp;
#pragma unroll
        for (int i = 0; i < 16; ++i) {
            const int d0 = kp0 + crow(i, h), d1 = d0 + 32;
            s0[i] = (d0 >= -128 && d0 <= 128) ? s0[i] * c2 : NEGBIG; s1[i] = (d1 >= -128 && d1 <= 128) ? s1[i] * c2 : NEGBIG;
        }
    }
};
__device__ __forceinline__ bool attn_unit64(LAS unsigned char* lds, const PolPlain<96, 64, true>& p, const bf16* qp0, const bf16* qp1, f32x16 (&O)[2][2]) {
    constexpr int DK = 96, DV = 64, KRS = DK * 2 + 16, KBYTES = 64 * KRS, VBYTES = 64 * DV * 2, NDB = 2, NS = 6;
    const int tid = fresh_tid(), lane = fresh_lane(), h = lane >> 5, r32 = lane & 31;
    bf16x8 qf[2][NS];
#pragma unroll
    for (int s = 0; s < NS; ++s) { qf[0][s] = *(const bf16x8*)(qp0 + 16 * s + 8 * h); qf[1][s] = *(const bf16x8*)(qp1 + 16 * s + 8 * h); }
#pragma unroll
    for (int g = 0; g < 2; ++g)
#pragma unroll
        for (int db = 0; db < NDB; ++db)
#pragma unroll
            for (int i = 0; i < 16; ++i) O[g][db][i] = 0.f;
    float l0 = 0.f, l1 = 0.f; bool alarm = false;
    const int kkey = tid >> 3, kch = tid & 7, k2key = tid >> 2, k2ch = tid & 3;
    const int lanebase = ((lane >> 5) * 4 + ((lane >> 2) & 3)) * 64 + ((lane >> 4) & 1) * 32 + (lane & 3) * 8;
    u32x4 kr, kr2 = (u32x4){0u, 0u, 0u, 0u}, vr;
#define A6_LOAD(t_) do { const bf16 *kp_, *k2p_, *vp_; p.src((t_), kp_, k2p_, vp_); kr = *(const u32x4*)(kp_ + (size_t)kkey * p.ldk + kch * 8); \
        if (tid < 256) kr2 = *(const u32x4*)(k2p_ + (size_t)k2key * p.ldk2 + k2ch * 8); vr = *(const u32x4*)(vp_ + (size_t)(tid >> 3) * p.ldv + (tid & 7) * 8); } while (0)
#define A6_STORE(buf_) do { LAS unsigned char* kb_ = lds + (buf_) * KBYTES; LAS unsigned char* vb_ = lds + 2 * KBYTES + (buf_) * VBYTES; \
        *(LAS u32x4*)(kb_ + kkey * KRS + kch * 16) = kr; if (tid < 256) *(LAS u32x4*)(kb_ + k2key * KRS + 128 + k2ch * 16) = kr2; \
        { const int key_ = tid >> 3, ch_ = tid & 7; *(LAS u32x4*)(vb_ + ((key_ >> 3) * NDB + (ch_ >> 2)) * 512 + (key_ & 7) * 64 + (ch_ & 3) * 16) = vr; } } while (0)
    const int nt = p.nt;
    A6_LOAD(0); A6_STORE(0);
    __syncthreads();
    for (int t = 0; t < nt; ++t) {
        if (t + 1 < nt) A6_LOAD(t + 1);
        const LAS unsigned char* Kt = lds + (t & 1) * KBYTES; const LAS unsigned char* Vt = lds + 2 * KBYTES + (t & 1) * VBYTES;
        bf16x8 kf[NS][2];
#define A6_KREAD(s_) do { kf[s_][0] = *(const LAS bf16x8*)(Kt + r32 * KRS + (16 * (s_) + 8 * h) * 2); kf[s_][1] = *(const LAS bf16x8*)(Kt + (32 + r32) * KRS + (16 * (s_) + 8 * h) * 2); } while (0)
        A6_KREAD(0);
        __builtin_amdgcn_sched_barrier(0);
        f32x16 sa0, sa1, sb0, sb1;
#pragma unroll
        for (int i = 0; i < 16; ++i) { sa0[i] = 0.f; sa1[i] = 0.f; sb0[i] = 0.f; sb1[i] = 0.f; }
#pragma unroll
        for (int s = 0; s < NS; ++s) {
            if (s + 1 < NS) A6_KREAD(s + 1);
            sa0 = __builtin_amdgcn_mfma_f32_32x32x16_bf16(kf[s][0], qf[0][s], sa0, 0, 0, 0); sa1 = __builtin_amdgcn_mfma_f32_32x32x16_bf16(kf[s][1], qf[0][s], sa1, 0, 0, 0);
            sb0 = __builtin_amdgcn_mfma_f32_32x32x16_bf16(kf[s][0], qf[1][s], sb0, 0, 0, 0); sb1 = __builtin_amdgcn_mfma_f32_32x32x16_bf16(kf[s][1], qf[1][s], sb1, 0, 0, 0);
            __builtin_amdgcn_sched_barrier(0);
        }
#undef A6_KREAD
        float pa = 0.f, pb = 0.f; bf16x8 pfa[2][2], pfb[2][2];
#pragma unroll
        for (int i = 0; i < 16; ++i) { const float a = fexp2(sa0[i]), b = fexp2(sa1[i]); sa0[i] = a; sa1[i] = b; pa += a + b; }
#pragma unroll
        for (int s2 = 0; s2 < 2; ++s2) { u32x4 w0, w1;
            w0.x = cvt_pk_bf16(sa0[8 * s2 + 0], sa0[8 * s2 + 1]); w0.y = cvt_pk_bf16(sa0[8 * s2 + 2], sa0[8 * s2 + 3]); w0.z = cvt_pk_bf16(sa0[8 * s2 + 4], sa0[8 * s2 + 5]); w0.w = cvt_pk_bf16(sa0[8 * s2 + 6], sa0[8 * s2 + 7]);
            w1.x = cvt_pk_bf16(sa1[8 * s2 + 0], sa1[8 * s2 + 1]); w1.y = cvt_pk_bf16(sa1[8 * s2 + 2], sa1[8 * s2 + 3]); w1.z = cvt_pk_bf16(sa1[8 * s2 + 4], sa1[8 * s2 + 5]); w1.w = cvt_pk_bf16(sa1[8 * s2 + 6], sa1[8 * s2 + 7]);
            pfa[0][s2] = __builtin_bit_cast(bf16x8, w0); pfa[1][s2] = __builtin_bit_cast(bf16x8, w1); }
        __builtin_amdgcn_sched_barrier(0);
#pragma unroll
        for (int i = 0; i < 16; ++i) { const float a = fexp2(sb0[i]), b = fexp2(sb1[i]); sb0[i] = a; sb1[i] = b; pb += a + b; }
#pragma unroll
        for (int s2 = 0; s2 < 2; ++s2) { u32x4 w0, w1;
            w0.x = cvt_pk_bf16(sb0[8 * s2 + 0], sb0[8 * s2 + 1]); w0.y = cvt_pk_bf16(sb0[8 * s2 + 2], sb0[8 * s2 + 3]); w0.z = cvt_pk_bf16(sb0[8 * s2 + 4], sb0[8 * s2 + 5]); w0.w = cvt_pk_bf16(sb0[8 * s2 + 6], sb0[8 * s2 + 7]);
            w1.x = cvt_pk_bf16(sb1[8 * s2 + 0], sb1[8 * s2 + 1]); w1.y = cvt_pk_bf16(sb1[8 * s2 + 2], sb1[8 * s2 + 3]); w1.z = cvt_pk_bf16(sb1[8 * s2 + 4], sb1[8 * s2 + 5]); w1.w = cvt_pk_bf16(sb1[8 * s2 + 6], sb1[8 * s2 + 7]);
            pfb[0][s2] = __builtin_bit_cast(bf16x8, w0); pfb[1][s2] = __builtin_bit_cast(bf16x8, w1); }
        alarm = alarm || !(pa <= ATT_OVF) || !(pb <= ATT_OVF);
        l0 += pa; l1 += pb;
        __builtin_amdgcn_sched_barrier(0);
#pragma unroll
        for (int q = 0; q < 4; ++q) {
            const int b = q >> 1, s2 = q & 1; bf16x8 vf[NDB];
#pragma unroll
            for (int db = 0; db < NDB; ++db) {
                const s16x4 v0 = __builtin_amdgcn_ds_read_tr16_b64_v4i16((LAS s16x4*)(Vt + ((2 * q + 0) * NDB + db) * 512 + lanebase)), v1 = __builtin_amdgcn_ds_read_tr16_b64_v4i16((LAS s16x4*)(Vt + ((2 * q + 1) * NDB + db) * 512 + lanebase));
                vf[db] = (bf16x8){v0[0], v0[1], v0[2], v0[3], v1[0], v1[1], v1[2], v1[3]}; }
#pragma unroll
            for (int db = 0; db < NDB; ++db) { O[0][db] = __builtin_amdgcn_mfma_f32_32x32x16_bf16(vf[db], pfa[b][s2], O[0][db], 0, 0, 0); O[1][db] = __builtin_amdgcn_mfma_f32_32x32x16_bf16(vf[db], pfb[b][s2], O[1][db], 0, 0, 0); }
            __builtin_amdgcn_sched_barrier(0);
        }
        if (t + 1 < nt) A6_STORE((t + 1) & 1);
        __syncthreads();
    }
#undef A6_LOAD
#undef A6_STORE
    const float lt0 = xsum32(l0), lt1 = xsum32(l1);
    alarm = alarm || !(lt0 >= 8.67e-19f) || !(lt1 >= 8.67e-19f);
    const float i0 = 1.f / lt0, i1 = 1.f / lt1;
#pragma unroll
    for (int db = 0; db < NDB; ++db) { O[0][db] = O[0][db] * i0; O[1][db] = O[1][db] * i1; }
    return alarm;
}
#define XB_TMO      128
#define XB_XCNT(j)  (256  + 64 * (j))
#define XB_XSUB(j)  (1280 + 64 * (j))
#define XB_XGEN(j)  (2304 + 64 * (j))
#define XB_TOP      3328
#define XB_TOPGEN   3392
#define XCD_BAR_WORDS 3456
#define XB_SPIN_CAP (1u << 22)
__device__ __forceinline__ unsigned xb_ld(unsigned* p)              { return __hip_atomic_load(p, __ATOMIC_RELAXED, __HIP_MEMORY_SCOPE_AGENT); }
__device__ __forceinline__ unsigned xb_add(unsigned* p, unsigned v) { return __hip_atomic_fetch_add(p, v, __ATOMIC_RELAXED, __HIP_MEMORY_SCOPE_AGENT); }
__device__ __forceinline__ unsigned xb_xcc_id() { return (unsigned)__builtin_amdgcn_s_getreg((3 << 11) | 20) & 0xFu; }
#define XB_SPIN(cond, bar) do { unsigned _sp = 0; while (cond) { __builtin_amdgcn_s_sleep(1); \
    if ((++_sp & 255u) == 0u) { if (xb_ld(&(bar)[XB_TMO])) break; if (_sp > XB_SPIN_CAP) { atomicAdd(&(bar)[XB_TMO], 1u); break; } } } } while (0)
struct XcdBarrier { unsigned* bar; unsigned x; volatile LAS unsigned* st; };
__device__ __forceinline__ XcdBarrier xcd_barrier_post(unsigned* bar, volatile LAS unsigned* st) {
    XcdBarrier b; b.bar = bar; b.x = xb_xcc_id(); b.st = st;
    if (threadIdx.x == 0) (void)xb_add(&bar[XB_XCNT(b.x)], 1u);
    return b;
}
__device__ __forceinline__ void xcd_barrier_complete(unsigned* bar, unsigned x, unsigned& nloc, unsigned& nx) {
    const unsigned G = gridDim.x * gridDim.y * gridDim.z;
    unsigned sum, cnt, mine, sp = 0u;
    for (;;) {
        sum = 0u; cnt = 0u; mine = 0u;
#pragma unroll
        for (unsigned j = 0; j < 16; ++j) { const unsigned c = xb_ld(&bar[XB_XCNT(j)]); sum += c; cnt += (c > 0u) ? 1u : 0u; mine = (j == x) ? c : mine; }
        if (sum == G) break;
        __builtin_amdgcn_s_sleep(1);
        if ((++sp & 255u) == 0u) { if (xb_ld(&bar[XB_TMO])) break; if (sp > XB_SPIN_CAP) { atomicAdd(&bar[XB_TMO], 1u); break; } }
    }
    nloc = mine > 0u ? mine : 1u; nx = cnt > 0u ? cnt : 1u;
}
__device__ __forceinline__ void xcd_barrier(const XcdBarrier& b) {
    asm volatile("s_waitcnt vmcnt(0)" ::: "memory");
    __syncthreads();
    if (threadIdx.x == 0) {
        unsigned* bar = b.bar;
        __builtin_amdgcn_s_waitcnt(0);
        unsigned nloc = b.st[0], nx = b.st[1];
        if (nloc == 0u) { xcd_barrier_complete(bar, b.x, nloc, nx); b.st[0] = nloc; b.st[1] = nx; }
        const unsigned old = xb_add(&bar[XB_XSUB(b.x)], 1u);
        const unsigned gen = old / nloc;
        if (old + 1u == (gen + 1u) * nloc) {
            __builtin_amdgcn_fence(__ATOMIC_RELEASE, "agent");
            asm volatile("s_waitcnt vmcnt(0)" ::: "memory");
            const unsigned og = xb_add(&bar[XB_TOP], 1u);
            const unsigned tg = og / nx;
            if (og + 1u == (tg + 1u) * nx) xb_add(&bar[XB_TOPGEN], 1u);
            else XB_SPIN(xb_ld(&bar[XB_TOPGEN]) == tg, bar);
            __builtin_amdgcn_fence(__ATOMIC_ACQUIRE, "agent");
            xb_add(&bar[XB_XGEN(b.x)], 1u);
            asm volatile("s_waitcnt vmcnt(0)" ::: "memory");
        } else {
            XB_SPIN(xb_ld(&bar[XB_XGEN(b.x)]) == gen, bar);
            __builtin_amdgcn_fence(__ATOMIC_ACQUIRE, "agent");
            asm volatile("s_waitcnt vmcnt(0)" ::: "memory");
        }
    }
    __syncthreads();
}

__device__ __forceinline__ void transpose_item(const float* W, int K, int ldw, bf16* WT, const float* kscale, LAS float* scr, int kb, int nb, int srccol, int lane) {
    const int k0 = 64 * kb, n0 = 32 * nb;
    float tv[32];
#pragma unroll
    for (int i = 0; i < 32; ++i) { const int kk = 2 * i + (lane >> 5); float v = (srccol >= 0) ? W[(size_t)(k0 + kk) * ldw + srccol] : 0.f; if (kscale) v *= kscale[k0 + kk]; tv[i] = v; }
#pragma unroll
    for (int i = 0; i < 32; ++i) { const int kk = 2 * i + (lane >> 5); scr[kk * 33 + (lane & 31)] = tv[i]; }
    asm volatile("s_waitcnt lgkmcnt(0)" ::: "memory");
    const int c = lane & 7;
#pragma unroll
    for (int j = 0; j < 4; ++j) { const int n = (lane >> 3) + 8 * j; const LAS float* s = scr + (8 * c) * 33 + n;
        u32x4 o; o.x = cvt_pk_bf16(s[0 * 33], s[1 * 33]); o.y = cvt_pk_bf16(s[2 * 33], s[3 * 33]); o.z = cvt_pk_bf16(s[4 * 33], s[5 * 33]); o.w = cvt_pk_bf16(s[6 * 33], s[7 * 33]);
        *(u32x4*)(WT + (size_t)(n0 + n) * K + k0 + 8 * c) = o; }
    asm volatile("s_waitcnt lgkmcnt(0)" ::: "memory");
}
__device__ __forceinline__ void transpose_item_f8(const float* W, int K, int ldw, unsigned char* WT, float scale, LAS float* scr, int kb, int nb, int srccol, int lane) {
    const int k0 = 64 * kb, n0 = 32 * nb;
    float tv[32];
#pragma unroll
    for (int i = 0; i < 32; ++i) { const int kk = 2 * i + (lane >> 5); tv[i] = (srccol >= 0) ? W[(size_t)(k0 + kk) * ldw + srccol] : 0.f; }
#pragma unroll
    for (int i = 0; i < 32; ++i) { const int kk = 2 * i + (lane >> 5); scr[kk * 33 + (lane & 31)] = tv[i] * scale; }
    asm volatile("s_waitcnt lgkmcnt(0)" ::: "memory");
    const int n = lane & 31, kh = lane >> 5; const LAS float* sp = scr + (32 * kh) * 33 + n; u32x4 o0, o1;
#pragma unroll
    for (int q = 0; q < 4; ++q) { o0[q] = pk_fp8x4(sp[(4 * q) * 33], sp[(4 * q + 1) * 33], sp[(4 * q + 2) * 33], sp[(4 * q + 3) * 33]);
                                  o1[q] = pk_fp8x4(sp[(16 + 4 * q) * 33], sp[(16 + 4 * q + 1) * 33], sp[(16 + 4 * q + 2) * 33], sp[(16 + 4 * q + 3) * 33]); }
    *(u32x4*)(WT + (size_t)(n0 + n) * K + k0 + 32 * kh) = o0; *(u32x4*)(WT + (size_t)(n0 + n) * K + k0 + 32 * kh + 16) = o1;
    asm volatile("s_waitcnt lgkmcnt(0)" ::: "memory");
}
__device__ __forceinline__ int rope_perm(int p) { return p < 8 ? p : (p < 16 ? 8 + p : (p < 24 ? p - 8 : p)); }

template <int V> struct IConst { static constexpr int value = V; };
template <int OUTM, bool SRCB = false>
__device__ __forceinline__ void norm_mod_rows(int nrows, const float* src_lat, const float* src_ctx, const float* gain, const float* mod  , int sh_off, int sc_off, bf16* dst, int gw, int ngw, int lane, signed char* dst8 = nullptr, float* xsc = nullptr) {
    constexpr int NB = 8, DEP = SRCB ? 5 : 3;
    const int R = ((nrows / 4 + ngw - 1) / ngw) * 4, row0 = gw * R, row1 = min(row0 + R, nrows);
    if (row0 >= row1) return;
    u32x2 qb[NB][4]; f32x4 qf[NB][4];
#define NM_LOAD(buf_, r_) do { const int r2_ = min((r_), row1 - 1); \
        if constexpr (SRCB) { const u32x2* xb_ = (const u32x2*)((const bf16*)src_lat + (size_t)r2_ * DM) + lane; _Pragma("unroll") for (int j_ = 0; j_ < 4; ++j_) qb[buf_][j_] = xb_[64 * j_]; } \
        else { const bool lat_ = r2_ < NLAT; const f32x4* xr_ = (const f32x4*)((lat_ ? src_lat : src_ctx) + (size_t)(lat_ ? r2_ : r2_ - NLAT) * DM) + lane; _Pragma("unroll") for (int j_ = 0; j_ < 4; ++j_) qf[buf_][j_] = xr_[64 * j_]; } } while (0)
#pragma unroll
    for (int p = 0; p < DEP; ++p) NM_LOAD(p, row0 + p);
    int brcur = -1; f32x4 A[4], SH[4];
    auto group = [&](auto PAR, const int base) __attribute__((always_inline)) {
#pragma unroll
        for (int i0 = 0; i0 < 4; ++i0) {
            constexpr int P4 = decltype(PAR)::value * 4; const int i = (P4 + i0) & 7;
            const int row = base + i0;
            NM_LOAD((i + DEP) & 7, row + DEP);
            {
                const int br = row < NLAT ? (row >> 12) : 16;
                if (br != brcur) { brcur = br; const float* mp = mod + (size_t)br * 6144;
#pragma unroll
                    for (int j = 0; j < 4; ++j) { const int col = 4 * (lane + 64 * j);
                        const f32x4 g = *(const f32x4*)(gain + col), sc = *(const f32x4*)(mp + sc_off + col); SH[j] = *(const f32x4*)(mp + sh_off + col);
                        A[j] = g * (sc + 1.0f); }
#pragma unroll
                    for (int j = 0; j < 4; ++j) asm volatile("" : "+v"(SH[j])); }
                f32x4 v[4]; float s = 0.f;
#pragma unroll
                for (int j = 0; j < 4; ++j) { if constexpr (SRCB) { const u32x2 w = qb[i][j]; v[j] = (f32x4){bf_lo(w.x), bf_hi(w.x), bf_lo(w.y), bf_hi(w.y)}; } else v[j] = qf[i][j]; }
#pragma unroll
                for (int j = 0; j < 4; ++j) s += (v[j].x * v[j].x + v[j].y * v[j].y) + (v[j].z * v[j].z + v[j].w * v[j].w);
                const float rs = 1.0f / sqrtf(wave_sum(s) * (1.0f / DM) + RMS_EPS);
                f32x4 y[4]; float am = 0.f;
#pragma unroll
                for (int j = 0; j < 4; ++j) {
                    const int col = 4 * (lane + 64 * j);
                    y[j] = v[j] * rs * A[j] + SH[j];
                    if constexpr (OUTM == 1) { *(unsigned*)((unsigned char*)dst + (size_t)row * DM + col) = pk_fp8x4(y[j].x, y[j].y, y[j].z, y[j].w); }
                    else if constexpr (OUTM != 4) { u32x2 w; w.x = cvt_pk_bf16(y[j].x, y[j].y); w.y = cvt_pk_bf16(y[j].z, y[j].w); *(u32x2*)(dst + (size_t)row * DM + col) = w; }
                    if constexpr (OUTM >= 3) am = fmaxf(am, fmaxf(fmaxf(fabsf(y[j].x), fabsf(y[j].y)), fmaxf(fabsf(y[j].z), fabsf(y[j].w))));
                }
                if constexpr (OUTM >= 3) {
                    am = fmaxf(am, dpp_f<0xB1>(am)); am = fmaxf(am, dpp_f<0x4E>(am)); am = fmaxf(am, dpp_f<0x141>(am)); am = fmaxf(am, dpp_f<0x140>(am));
                    { const auto r = __builtin_amdgcn_permlane16_swap(__float_as_uint(am), __float_as_uint(am), false, false); am = fmaxf(__uint_as_float(r[0]), __uint_as_float(r[1])); }
                    { const auto r = __builtin_amdgcn_permlane32_swap(__float_as_uint(am), __float_as_uint(am), false, false); am = fmaxf(__uint_as_float(r[0]), __uint_as_float(r[1])); }
                    const float q = am > 0.f ? 127.f / am : 0.f;
#pragma unroll
                    for (int j = 0; j < 4; ++j) {
                        const int col = 4 * (lane + 64 * j);
                        const int a = (int)rintf(y[j].x * q), b = (int)rintf(y[j].y * q), c = (int)rintf(y[j].z * q), d = (int)rintf(y[j].w * q);
                        *(unsigned*)(dst8 + (size_t)row * DM + col) = (unsigned)(a & 0xff) | ((unsigned)(b & 0xff) << 8) | ((unsigned)(c & 0xff) << 16) | ((unsigned)(d & 0xff) << 24);
                    }
                    if (lane == 0) xsc[row] = am * (1.0f / 127.f);
                }
            }
        }
    };
    for (int cbase = row0; cbase < row1; cbase += 16) {
        group(IConst<0>{}, cbase);
        if (cbase + 4 < row1) { group(IConst<1>{}, cbase + 4); if (cbase + 8 < row1) { group(IConst<0>{}, cbase + 8); if (cbase + 12 < row1) group(IConst<1>{}, cbase + 12); } }
    }
#undef NM_LOAD
}
constexpr int PEER_LST = 0, PEER_SEL = 65536, PEER_WG = 98304;
__device__ __forceinline__ float gelu_erf(float v) {
    const float t = __builtin_amdgcn_rcpf(fabsf(v) * 0.2316418882f + 1.0f);
    float q = t * 0.5307027145f - 0.7265760135f; q = q * t + 0.7107068705f; q = q * t - 0.142248368f; q = q * t + 0.127414796f; q = q * t;
    const float m = v * (q * __builtin_amdgcn_exp2f(v * v * -0.72134752044f));
    return v < 0.f ? m : v - m;
}
#define TOPK_INSERT(L, v_) do { unsigned v__ = (v_); _Pragma("unroll") for (int q_ = 0; q_ < 16; ++q_) { const unsigned hi_ = max(L[q_], v__); v__ = min(L[q_], v__); L[q_] = hi_; } } while (0)


#ifndef PEER_TB_CFG
#define PEER_TB_CFG 16
#endif
constexpr int PEER_TB = PEER_TB_CFG;
constexpr int PEER_NQ = PEER_TB / 4, PEER_M2 = PEER_TB * 256;

typedef short s16x2 __attribute__((ext_vector_type(2)));
#define SEL_NET16(A_) do { \
        SEL_CE(A_, 0, 13); SEL_CE(A_, 1, 12); SEL_CE(A_, 2, 15); SEL_CE(A_, 3, 14); SEL_CE(A_, 4, 8); SEL_CE(A_, 5, 6); SEL_CE(A_, 7, 11); SEL_CE(A_, 9, 10); \
        SEL_CE(A_, 0, 5); SEL_CE(A_, 1, 7); SEL_CE(A_, 2, 9); SEL_CE(A_, 3, 4); SEL_CE(A_, 6, 13); SEL_CE(A_, 8, 14); SEL_CE(A_, 10, 15); SEL_CE(A_, 11, 12); \
        SEL_CE(A_, 0, 1); SEL_CE(A_, 2, 3); SEL_CE(A_, 4, 5); SEL_CE(A_, 6, 8); SEL_CE(A_, 7, 9); SEL_CE(A_, 10, 11); SEL_CE(A_, 12, 13); SEL_CE(A_, 14, 15); \
        SEL_CE(A_, 0, 2); SEL_CE(A_, 1, 3); SEL_CE(A_, 4, 10); SEL_CE(A_, 5, 11); SEL_CE(A_, 6, 7); SEL_CE(A_, 8, 9); SEL_CE(A_, 12, 14); SEL_CE(A_, 13, 15); \
        SEL_CE(A_, 1, 2); SEL_CE(A_, 3, 12); SEL_CE(A_, 4, 6); SEL_CE(A_, 5, 7); SEL_CE(A_, 8, 10); SEL_CE(A_, 9, 11); SEL_CE(A_, 13, 14); \
        SEL_CE(A_, 1, 4); SEL_CE(A_, 2, 6); SEL_CE(A_, 5, 8); SEL_CE(A_, 7, 10); SEL_CE(A_, 9, 13); SEL_CE(A_, 11, 14); \
        SEL_CE(A_, 2, 4); SEL_CE(A_, 3, 6); SEL_CE(A_, 9, 12); SEL_CE(A_, 11, 13); \
        SEL_CE(A_, 3, 5); SEL_CE(A_, 6, 8); SEL_CE(A_, 7, 9); SEL_CE(A_, 10, 12); \
        SEL_CE(A_, 3, 4); SEL_CE(A_, 5, 6); SEL_CE(A_, 7, 8); SEL_CE(A_, 9, 10); SEL_CE(A_, 11, 12); \
        SEL_CE(A_, 6, 7); SEL_CE(A_, 8, 9); } while (0)
__device__ __forceinline__ void peer_select(LAS unsigned char* lds, int nrows, const bf16* SC, unsigned short* SELE, bf16* SELW, int vcu, int G) {
    const int tid = fresh_tid();
    LAS u32x2* LST = (LAS u32x2*)(lds + PEER_LST);
    const int ngroups = nrows / 32;
    u32x4 scq[16];
    if (vcu < ngroups) { const u32x4* sp0 = (const u32x4*)(SC + (size_t)(vcu * 32 + (tid >> 4)) * PQ_N + (tid & 15) * 128);
#pragma unroll
        for (int i = 0; i < 16; ++i) scq[i] = sp0[i]; }
    for (int grp = vcu; grp < ngroups; grp += G) {
        const int row0 = grp * 32;
        const int tt = tid >> 4, hp = tid & 15, pp = tid & 1;
        unsigned L[16];
#define SEL_CE(A_, i_, l_) do { const unsigned hi_ = max(A_[i_], A_[l_]), lo_ = min(A_[i_], A_[l_]); A_[i_] = hi_; A_[l_] = lo_; } while (0)
#define SEL_CEA(A_, i_, l_) do { const unsigned hi_ = max(A_[i_], A_[l_]), lo_ = min(A_[i_], A_[l_]); A_[i_] = lo_; A_[l_] = hi_; } while (0)
#pragma unroll
        for (int cc = 0; cc < 8; ++cc) {
            const u32x4 w0 = scq[cc * 2], w1 = scq[cc * 2 + 1]; unsigned C[16];
            const unsigned ib = 127u - (unsigned)(cc * 16);
#pragma unroll
            for (int d = 0; d < 8; ++d) {
                const unsigned ww = d < 4 ? w0[d & 3] : w1[d & 3];
                const s16x2 sg = __builtin_bit_cast(s16x2, ww) >> 15;
                const unsigned x = ww ^ (__builtin_bit_cast(unsigned, sg) | 0x80008000u);
                C[2 * d] = (x << 16) | (ib - (unsigned)(2 * d)); C[2 * d + 1] = (x & 0xffff0000u) | (ib - (unsigned)(2 * d + 1));
            }
            SEL_NET16(C);
            if (cc == 0) {
#pragma unroll
                for (int q = 0; q < 16; ++q) L[q] = C[q];
            } else {
#pragma unroll
                for (int q = 0; q < 16; ++q) L[q] = max(L[q], C[15 - q]);
#pragma unroll
                for (int j = 8; j > 0; j >>= 1)
#pragma unroll
                    for (int i = 0; i < 16; ++i) { const int l2 = i ^ j; if (l2 > i) SEL_CE(L, i, l2); }
            }
        }
        { const int gn = (grp + G < ngroups) ? grp + G : grp;
          const u32x4* spn = (const u32x4*)(SC + (size_t)(gn * 32 + tt) * PQ_N + hp * 128);
#pragma unroll
          for (int i = 0; i < 16; ++i) scq[i] = spn[i]; }
#undef SEL_CE
#undef SEL_CEA
        float sv[16], pv[16];
#pragma unroll
        for (int q = 0; q < 16; ++q) {
            const unsigned s = L[q] >> 16, b = s ^ ((s & 0x8000u) ? 0x8000u : 0xffffu);
            sv[q] = __uint_as_float(b << 16); const unsigned si = 127u - (L[q] & 0xffffu);
            LST[tid * 16 + q] = (u32x2){b << 16, si};
            pv[q] = xlane1(sv[q]);
        }
        unsigned CK[50];
        { int n = 0;
#pragma unroll
          for (int i = 0; i < 16; ++i)
#pragma unroll
            for (int j = 0; j < 16; ++j)
                if ((i + 1) * (j + 1) <= 16) {
                    const float a = pp ? pv[i] : sv[i], b = pp ? sv[j] : pv[j];
                    const unsigned ub = __float_as_uint(a + b), ks = ub ^ ((ub >> 31) ? 0xffffffffu : 0x80000000u);
                    CK[n++] = (ks & 0xffffff00u) | (unsigned)(255 - (i * 16 + j));
                } }
        unsigned M[16];
#define SEL_CE(A_, i_, l_) do { const unsigned hi_ = max(A_[i_], A_[l_]), lo_ = min(A_[i_], A_[l_]); A_[i_] = hi_; A_[l_] = lo_; } while (0)
#define SEL_CEA(A_, i_, l_) do { const unsigned hi_ = max(A_[i_], A_[l_]), lo_ = min(A_[i_], A_[l_]); A_[i_] = lo_; A_[l_] = hi_; } while (0)
#pragma unroll
        for (int cc = 0; cc < 3; ++cc) {
            unsigned C[16];
#pragma unroll
            for (int q = 0; q < 16; ++q) C[q] = CK[cc * 16 + q];
            SEL_NET16(C);
            if (cc == 0) {
#pragma unroll
                for (int q = 0; q < 16; ++q) M[q] = C[q];
            } else {
#pragma unroll
                for (int q = 0; q < 16; ++q) M[q] = max(M[q], C[15 - q]);
#pragma unroll
                for (int j = 8; j > 0; j >>= 1)
#pragma unroll
                    for (int i = 0; i < 16; ++i) { const int l2 = i ^ j; if (l2 > i) SEL_CE(M, i, l2); }
            }
        }
#undef SEL_CE
#undef SEL_CEA
        TOPK_INSERT(M, CK[48]); TOPK_INSERT(M, CK[49]);
        __syncthreads();
        float fv[16]; unsigned eid[16]; float mx = -3.0e38f;
        const int t0 = tid & ~1;
#pragma unroll
        for (int q = 0; q < 16; ++q) {
            const unsigned code = 255u - (M[q] & 0xffu), i = code >> 4, j = code & 15u;
            const u32x2 e0 = LST[t0 * 16 + i], e1 = LST[(t0 + 1) * 16 + j];
            fv[q] = __uint_as_float(e0.x) + __uint_as_float(e1.x); eid[q] = e0.y * 128u + e1.y; mx = fmaxf(mx, fv[q]);
        }
        float den = 0.f;
#pragma unroll
        for (int q = 0; q < 16; ++q) { fv[q] = __expf(fv[q] - mx); den += fv[q]; }
        const float inv = 1.f / den;
        const size_t ob = (size_t)(row0 + tt) * 128 + (hp >> 1) * 16 + pp * 8;
        const unsigned pm = pp ? 0xffffffffu : 0u;
        u32x4 e4, g4;
#pragma unroll
        for (int q = 0; q < 4; ++q) {
            const unsigned ea = (eid[2 * q] & ~pm) | (eid[8 + 2 * q] & pm), eb2 = (eid[2 * q + 1] & ~pm) | (eid[8 + 2 * q + 1] & pm);
            const float ga = __uint_as_float((__float_as_uint(fv[2 * q]) & ~pm) | (__float_as_uint(fv[8 + 2 * q]) & pm)) * inv, gb = __uint_as_float((__float_as_uint(fv[2 * q + 1]) & ~pm) | (__float_as_uint(fv[8 + 2 * q + 1]) & pm)) * inv;
            e4[q] = ea | (eb2 << 16); g4[q] = cvt_pk_bf16(ga, gb);
        }
        *(u32x4*)(SELE + ob) = e4; *(u32x4*)(SELW + ob) = g4;
        __syncthreads();
    }
}

struct SweepCursor { unsigned* q; int nitems, s, x; };
__device__ __forceinline__ bool sweep_next(SweepCursor& c, int lane, int& slice, int& item) {
    for (;;) {
        if (c.s >= 8) return false;
        slice = (c.x + c.s) & 7;
        unsigned it = 0u;
        if (lane == 0) it = __hip_atomic_fetch_add(c.q + 64 * slice, 1u, __ATOMIC_RELAXED, __HIP_MEMORY_SCOPE_AGENT);
        it = __builtin_amdgcn_readfirstlane(it);
        if ((int)it < c.nitems) { item = (int)it; return true; }
        ++c.s;
    }
}
__device__ __forceinline__ unsigned sweep_pop_async(const SweepCursor& c, int lane) {
    unsigned it = 0u;
    if (lane == 0) it = __hip_atomic_fetch_add(c.q + 64 * ((c.x + c.s) & 7), 1u, __ATOMIC_RELAXED, __HIP_MEMORY_SCOPE_AGENT);
    return it;
}
template <int ABLU = 0>
__device__ __forceinline__ void peer_usweep(LAS unsigned char* lds, int nrows, const signed char* X8, const float* XSC, const unsigned char* U, const unsigned short* SELE, bf16* PA, unsigned* queue) {
    const int lane = fresh_lane(), kk = lane >> 3, sub = lane & 7, wave = __builtin_amdgcn_readfirstlane(threadIdx.x >> 6);
    LAS unsigned char* wl = lds + wave * 16384;
    SweepCursor cur{queue, nrows / PEER_TB, 0, (int)(xb_xcc_id() & 7u)};
    int slice, item;
    bool have = sweep_next(cur, lane, slice, item);
    unsigned tkv = 0u; u32x4 m[PEER_NQ + PEER_NQ / 2];
#define PU_META(sl_, it_) do { const int r0_ = (it_) * PEER_TB; _Pragma("unroll") for (int q = 0; q < PEER_NQ; ++q) m[q] = *(const u32x4*)(SELE + (size_t)r0_ * 128 + (q * 64 + lane) * 8); \
        _Pragma("unroll") for (int q = 0; q < PEER_NQ / 2; ++q) { const int c = q * 64 + lane; m[PEER_NQ + q] = *(const u32x4*)(X8 + (size_t)(r0_ + (c >> 3)) * DM + (sl_) * 128 + (c & 7) * 16); } } while (0)
    if (have) { tkv = sweep_pop_async(cur, lane); PU_META(slice, item); }
    while (have) {
        const int row0 = item * PEER_TB; const unsigned char* Us = U + (size_t)slice * NEXP * 128; const unsigned lo16 = sub * 16;
        {
#pragma unroll
            for (int q = 0; q < PEER_NQ + PEER_NQ / 2; ++q) *(LAS u32x4*)(wl + (q * 64 + lane) * 16) = m[q];
            asm volatile("s_waitcnt lgkmcnt(0)" ::: "memory");
        }
        u32x4 eb[2]; u32x4 uw0[16], uw1[16];
#define PU_IDS(t_) do { eb[0] = *(const LAS u32x4*)(wl + (t_) * 256 + kk * 32); eb[1] = *(const LAS u32x4*)(wl + (t_) * 256 + kk * 32 + 16); } while (0)
#define PU_ROWS(UW_, XS_, t_) do { XS_ = XSC[row0 + (t_)]; _Pragma("unroll") for (int i_ = 0; i_ < 16; ++i_) { const unsigned w_ = eb[i_ >> 3][(i_ >> 1) & 3], e_ = (i_ & 1) ? (w_ >> 16) : (w_ & 0xffffu); UW_[i_] = *(const u32x4*)(Us + ((e_ << 7) + lo16)); } } while (0)
#define PU_COMP(UW_, XS_, t_) do { const u32x4 xq_ = *(const LAS u32x4*)(wl + PEER_M2 + (t_) * 128 + sub * 16); const float xs_ = XS_; \
            f32x4 r_[4]; _Pragma("unroll") for (int i_ = 0; i_ < 16; ++i_) { int a_ = 0; if (ABLU == 0) { _Pragma("unroll") for (int d_ = 0; d_ < 4; ++d_) a_ = __builtin_amdgcn_sdot4((int)UW_[i_][d_], (int)xq_[d_], a_, false); } \
                else a_ = (int)(UW_[i_][0] ^ UW_[i_][1] ^ UW_[i_][2] ^ UW_[i_][3]); \
                r_[i_ >> 2][i_ & 3] = red8_sum((float)a_) * xs_; } \
            if (sub == 0) { bf16* pp_ = PA + ((size_t)(row0 + (t_)) * 8 + slice) * 128 + kk * 16; u32x4 w0_, w1_; \
                w0_.x = cvt_pk_bf16(r_[0][0], r_[0][1]); w0_.y = cvt_pk_bf16(r_[0][2], r_[0][3]); w0_.z = cvt_pk_bf16(r_[1][0], r_[1][1]); w0_.w = cvt_pk_bf16(r_[1][2], r_[1][3]); \
                w1_.x = cvt_pk_bf16(r_[2][0], r_[2][1]); w1_.y = cvt_pk_bf16(r_[2][2], r_[2][3]); w1_.z = cvt_pk_bf16(r_[3][0], r_[3][1]); w1_.w = cvt_pk_bf16(r_[3][2], r_[3][3]); \
                *(u32x4*)pp_ = w0_; *(u32x4*)(pp_ + 8) = w1_; } } while (0)
        float xs0, xs1;
        PU_IDS(0); PU_ROWS(uw0, xs0, 0);
#pragma unroll 1
        for (int t = 0; t < PEER_TB - 2; t += 2) {
            PU_IDS(t + 1); PU_ROWS(uw1, xs1, t + 1);
            PU_COMP(uw0, xs0, t);
            PU_IDS(t + 2); PU_ROWS(uw0, xs0, t + 2);
            PU_COMP(uw1, xs1, t + 1);
        }
        PU_IDS(PEER_TB - 1); PU_ROWS(uw1, xs1, PEER_TB - 1);
        PU_COMP(uw0, xs0, PEER_TB - 2);
        {
            int nitem = (int)__builtin_amdgcn_readfirstlane(tkv), nslice = (cur.x + cur.s) & 7; bool nhave = nitem < cur.nitems;
            if (!nhave) { ++cur.s; nhave = sweep_next(cur, lane, nslice, nitem); }
            tkv = sweep_pop_async(cur, lane); PU_META(nhave ? nslice : 0, nhave ? nitem : 0);
            PU_COMP(uw1, xs1, PEER_TB - 1);
            slice = nslice; item = nitem; have = nhave;
        }
#undef PU_IDS
#undef PU_ROWS
#undef PU_COMP
    }
#undef PU_META
}
__device__ __forceinline__ void peer_combine(LAS unsigned char* lds, int nrows, const bf16* PA, const unsigned short* SELE, bf16* SELW, const float* usc, const float* vsc, float* WSC, int gw, int ngw, int lane) {
    { const int tid = fresh_tid();
#pragma unroll 4
      for (int c = tid; c < 2 * NEXP / 4; c += NTHREADS) { const u32x4 v = (c < NEXP / 4) ? *(const u32x4*)(usc + 4 * c) : *(const u32x4*)(vsc + 4 * (c - NEXP / 4)); *(LAS u32x4*)(lds + (size_t)c * 16) = v; }
      __syncthreads(); }
    const LAS float* lus = (const LAS float*)lds; const LAS float* lvs = (const LAS float*)(lds + NEXP * 4);
    const int R = ((nrows / 4 + ngw - 1) / ngw) * 4, row0 = gw * R, row1 = min(row0 + R, nrows);
    if (row0 >= row1) return;
    unsigned pw[8][8], ew[8], gd[8]; float su0[8], su1[8], sv0[8], sv1[8];
#define PC_LOADA(buf_, r_) do { const size_t r2_ = (size_t)min((r_), row1 - 1); \
        _Pragma("unroll") for (int j_ = 0; j_ < 8; ++j_) pw[buf_][j_] = *(const unsigned*)(PA + (r2_ * 8 + j_) * 128 + 2 * lane); \
        ew[buf_] = *(const unsigned*)(SELE + r2_ * 128 + 2 * lane); gd[buf_] = *(const unsigned*)(SELW + r2_ * 128 + 2 * lane); } while (0)
#define PC_LOADB(buf_) do { const unsigned e0_ = ew[buf_] & 0xffffu, e1_ = ew[buf_] >> 16; su0[buf_] = lus[e0_]; su1[buf_] = lus[e1_]; sv0[buf_] = lvs[e0_]; sv1[buf_] = lvs[e1_]; } while (0)
#pragma unroll
    for (int p = 0; p < 4; ++p) PC_LOADA(p, row0 + p);
#pragma unroll
    for (int p = 0; p < 2; ++p) PC_LOADB(p);
    auto group = [&](auto PAR, const int base) __attribute__((always_inline)) {
        constexpr int P4 = decltype(PAR)::value * 4;
#pragma unroll
        for (int i = 0; i < 4; ++i) {
            const int cb = (P4 + i) & 7;
            const int row = base + i;
            PC_LOADA((cb + 4) & 7, row + 4);
            PC_LOADB((cb + 2) & 7);
            float ax = 0.f, ay = 0.f;
#pragma unroll
            for (int j = 0; j < 8; ++j) { const unsigned w = pw[cb][j]; ax += bf_lo(w); ay += bf_hi(w); }
            const unsigned gwd = gd[cb];
            const float w0 = bf_lo(gwd) * gelu_erf(ax * su0[cb]) * sv0[cb], w1 = bf_hi(gwd) * gelu_erf(ay * su1[cb]) * sv1[cb];
            float am = fmaxf(fabsf(w0), fabsf(w1));
            am = fmaxf(am, dpp_f<0xB1>(am)); am = fmaxf(am, dpp_f<0x4E>(am)); am = fmaxf(am, dpp_f<0x141>(am)); am = fmaxf(am, dpp_f<0x140>(am));
            { const auto r = __builtin_amdgcn_permlane16_swap(__float_as_uint(am), __float_as_uint(am), false, false); am = fmaxf(__uint_as_float(r[0]), __uint_as_float(r[1])); }
            { const auto r = __builtin_amdgcn_permlane32_swap(__float_as_uint(am), __float_as_uint(am), false, false); am = fmaxf(__uint_as_float(r[0]), __uint_as_float(r[1])); }
            const unsigned eb = __float_as_uint(am) >> 23;
            const bool ok = eb >= 16u && eb < 240u;
            const float sc = ok ? __uint_as_float((eb - 7u) << 23) : 1.f, inv = ok ? __uint_as_float((261u - eb) << 23) : 1.f;
            const float s0 = w0 * inv, s1 = w1 * inv;
            const int hi = __builtin_amdgcn_cvt_pk_fp8_f32(s0, s1, 0, false);
            const f32x2 hb = __builtin_amdgcn_cvt_pk_f32_fp8(hi, false);
            const int lo = __builtin_amdgcn_cvt_pk_fp8_f32(s0 - hb.x, s1 - hb.y, 0, false);
            unsigned char* wq = (unsigned char*)(SELW + (size_t)row * 128);
            *(unsigned short*)(wq + 2 * lane) = (unsigned short)(hi & 0xffff);
            *(unsigned short*)(wq + 128 + 2 * lane) = (unsigned short)(lo & 0xffff);
            if (lane == 0) WSC[row] = sc;
        }
    };
    for (int cbase = row0; cbase < row1; cbase += 16) {
        group(IConst<0>{}, cbase);
        if (cbase + 4 < row1) { group(IConst<1>{}, cbase + 4); if (cbase + 8 < row1) { group(IConst<0>{}, cbase + 8); if (cbase + 12 < row1) group(IConst<1>{}, cbase + 12); } }
    }
#undef PC_LOADA
#undef PC_LOADB
}
constexpr int PV_TB = 8, PV_WL = 18432, PV_IDS = 16384;
__device__ __forceinline__ void peer_vsweep(LAS unsigned char* lds, int nrows, const unsigned char* V, const unsigned short* SELE, const unsigned char* WQ, const float* WSC, bf16* RESB, const float* g2mod, unsigned* queue, const unsigned char* ZERO) {
    typedef int i32x8_ __attribute__((ext_vector_type(8))); typedef int i32x4_ __attribute__((ext_vector_type(4))); typedef int i32x2_ __attribute__((ext_vector_type(2)));
    const int lane = fresh_lane(), kk = lane >> 3, sub = lane & 7, wave = __builtin_amdgcn_readfirstlane(threadIdx.x >> 6);
    LAS unsigned char* wl = lds + wave * PV_WL;
    unsigned wa[8], ra[8];
    { const int sx = sub ^ ((kk >> 1) & 1), q = lane >> 4, r = (lane >> 1) & 7, c = lane & 1, xr = r ^ (q & 1);
#pragma unroll
      for (int v = 0; v < 8; ++v) { wa[v] = (unsigned)(kk * 2048 + ((sx ^ v) << 4)); ra[v] = (unsigned)((32 * q + r) * 128 + ((v ^ xr) << 4) + 8 * c); } }
    const bool aon = (lane & 15) < 2; const unsigned aoff = (unsigned)((lane & 1) * 128 + (lane >> 4) * 32);
    SweepCursor cur{queue, nrows / PV_TB, 0, (int)(xb_xcc_id() & 7u)};
    int slice, item;
    bool have = sweep_next(cur, lane, slice, item);
    unsigned tkv = 0u; u32x4 m[2];
#define PV_META(it_) do { _Pragma("unroll") for (int q = 0; q < 2; ++q) m[q] = *(const u32x4*)((const unsigned char*)(SELE + (size_t)((it_) * PV_TB) * 128) + (unsigned)((q * 64 + lane) * 16)); } while (0)
    if (have) { tkv = sweep_pop_async(cur, lane); PV_META(item); }
    while (have) {
        const int row0 = item * PV_TB; const unsigned char* Vs = V + (size_t)slice * NEXP * 128; const unsigned lo16 = sub * 16;
        const float* gp_ = g2mod + (size_t)(row0 < NLAT ? (row0 >> 12) : 16) * 6144 + slice * 128 + 8 * (lane & 15); const f32x4 gq0 = *(const f32x4*)gp_, gq1 = *(const f32x4*)(gp_ + 4);
        const unsigned roff = (unsigned)(slice * 256 + 16 * (lane & 15));
        {
#pragma unroll
            for (int q = 0; q < 2; ++q) *(LAS u32x4*)(wl + PV_IDS + (q * 64 + lane) * 16) = m[q];
            asm volatile("s_waitcnt lgkmcnt(0)" ::: "memory");
        }
        u32x4 eb[2]; u32x4 vw0[16], vw1[16]; i32x4_ aw0[2], aw1[2]; float sc0, sc1; u32x4 rv0, rv1;
#define PV_IDS_(t_) do { eb[0] = *(const LAS u32x4*)(wl + PV_IDS + (t_) * 256 + kk * 32); eb[1] = *(const LAS u32x4*)(wl + PV_IDS + (t_) * 256 + kk * 32 + 16); } while (0)
#define PV_ROWS(VW_, AW_, SC_, RV_, t_) do { SC_ = WSC[row0 + (t_)]; RV_ = *(const u32x4*)((const unsigned char*)(RESB + (size_t)(row0 + (t_)) * DM) + roff); _Pragma("unroll") for (int i_ = 0; i_ < 16; ++i_) { const unsigned w_ = eb[i_ >> 3][(i_ >> 1) & 3], e_ = (i_ & 1) ? (w_ >> 16) : (w_ & 0xffffu); VW_[i_] = *(const u32x4*)(Vs + ((e_ << 7) + lo16)); } \
            { const i32x4_* ap_ = (const i32x4_*)(aon ? WQ + (size_t)(row0 + (t_)) * 256 + aoff : ZERO); AW_[0] = ap_[0]; AW_[1] = ap_[1]; } } while (0)
#define PV_COMP(VW_, AW_, SC_, RV_, t_) do { _Pragma("unroll") for (int i_ = 0; i_ < 16; ++i_) *(LAS u32x4*)(wl + wa[i_ & 7] + i_ * 128) = VW_[i_]; \
            const i32x8_ a8_ = __builtin_shufflevector(AW_[0], AW_[1], 0, 1, 2, 3, 4, 5, 6, 7); const float sc_ = SC_; float fo_[8]; \
            i32x8_ b8_[8]; \
            _Pragma("unroll") for (int g_ = 0; g_ < 5; ++g_) {          \
                if (g_ < 4) { _Pragma("unroll") for (int cb_ = 2 * g_; cb_ < 2 * g_ + 2; ++cb_) _Pragma("unroll") for (int j_ = 0; j_ < 4; ++j_) { \
                    const i32x2_ t2_ = __builtin_amdgcn_ds_read_tr8_b64_v2i32((LAS i32x2_*)(wl + ra[cb_] + j_ * 1024)); b8_[cb_][2 * j_] = t2_.x; b8_[cb_][2 * j_ + 1] = t2_.y; } } \
                if (g_ > 0) { _Pragma("unroll") for (int cb_ = 2 * g_ - 2; cb_ < 2 * g_; ++cb_) { \
                    const f32x4 d_ = __builtin_amdgcn_mfma_scale_f32_16x16x128_f8f6f4(a8_, b8_[cb_], (f32x4){0.f, 0.f, 0.f, 0.f}, 0, 0, 0, 0x7F7F7F7F, 0, 0x7F7F7F7F); fo_[cb_] = (d_[0] + d_[1]) * sc_; asm volatile("" : "+v"(fo_[cb_])); } } \
                __builtin_amdgcn_sched_barrier(0); } \
            if (lane < 16) {                                         \
                _Pragma("unroll") for (int cb_ = 0; cb_ < 8; ++cb_) *(LAS float*)(wl + (16 * cb_ + lane) * 4) = fo_[cb_]; \
                const f32x4 f0_ = *(const LAS f32x4*)(wl + lane * 32), f1_ = *(const LAS f32x4*)(wl + lane * 32 + 16); u32x4 ow_; \
                ow_.x = cvt_pk_bf16(bf_lo(RV_.x) + gq0[0] * f0_[0], bf_hi(RV_.x) + gq0[1] * f0_[1]); ow_.y = cvt_pk_bf16(bf_lo(RV_.y) + gq0[2] * f0_[2], bf_hi(RV_.y) + gq0[3] * f0_[3]); \
                ow_.z = cvt_pk_bf16(bf_lo(RV_.z) + gq1[0] * f1_[0], bf_hi(RV_.z) + gq1[1] * f1_[1]); ow_.w = cvt_pk_bf16(bf_lo(RV_.w) + gq1[2] * f1_[2], bf_hi(RV_.w) + gq1[3] * f1_[3]); \
                *(u32x4*)((unsigned char*)(RESB + (size_t)(row0 + (t_)) * DM) + roff) = ow_; } } while (0)
        PV_IDS_(0); PV_ROWS(vw0, aw0, sc0, rv0, 0);
#pragma unroll 1
        for (int t = 0; t < PV_TB - 2; t += 2) {
            PV_IDS_(t + 1); PV_ROWS(vw1, aw1, sc1, rv1, t + 1);
            PV_COMP(vw0, aw0, sc0, rv0, t);
            PV_IDS_(t + 2); PV_ROWS(vw0, aw0, sc0, rv0, t + 2);
            PV_COMP(vw1, aw1, sc1, rv1, t + 1);
        }
        PV_IDS_(PV_TB - 1); PV_ROWS(vw1, aw1, sc1, rv1, PV_TB - 1);
        PV_COMP(vw0, aw0, sc0, rv0, PV_TB - 2);
        {
            int nitem = (int)__builtin_amdgcn_readfirstlane(tkv), nslice = (cur.x + cur.s) & 7; bool nhave = nitem < cur.nitems;
            if (!nhave) { ++cur.s; nhave = sweep_next(cur, lane, nslice, nitem); }
            tkv = sweep_pop_async(cur, lane); PV_META(nhave ? nitem : 0);
            PV_COMP(vw1, aw1, sc1, rv1, PV_TB - 1);
            slice = nslice; item = nitem; have = nhave;
        }
#undef PV_IDS_
#undef PV_ROWS
#undef PV_COMP
    }
#undef PV_META
}
template <bool LAST>
__device__ __forceinline__ void peer_rows(int nrows, const bf16* res, float* outp, const float* ngain, const float* nmod, bf16* Hn, int gw, int ngw, int lane) {
    constexpr int NB = 8, DEP = 7;
    const int R = ((nrows / 4 + ngw - 1) / ngw) * 4, row0 = gw * R, row1 = min(row0 + R, nrows);
    if (row0 >= row1) return;
    float A[16], SH[16];
    if (LAST) {
#pragma unroll
        for (int q = 0; q < 4; ++q) { const f32x4 ga = *(const f32x4*)(ngain + lane * 16 + q * 4);
#pragma unroll
            for (int e = 0; e < 4; ++e) A[q * 4 + e] = ga[e]; }
    }
    u32x4 q0[NB], q1[NB];
#define PR_LOAD(buf_, r_) do { const bf16* rp_ = res + (size_t)min((r_), row1 - 1) * DM + lane * 16; q0[buf_] = *(const u32x4*)rp_; q1[buf_] = *(const u32x4*)(rp_ + 8); } while (0)
#pragma unroll
    for (int p = 0; p < DEP; ++p) PR_LOAD(p, row0 + p);
    int brcur = -1;
    auto group = [&](auto PAR, const int base) __attribute__((always_inline)) {
#pragma unroll
        for (int i0 = 0; i0 < 4; ++i0) {
            constexpr int P4 = decltype(PAR)::value * 4; const int i = (P4 + i0) & 7;
            const int row = base + i0;
            PR_LOAD((i + DEP) & 7, row + DEP);
            {
                if (!LAST) { const int br = row < NLAT ? (row >> 12) : 16;
                    if (br != brcur) { brcur = br; const float* mp = nmod + (size_t)br * 6144 + lane * 16;
#pragma unroll
                        for (int q = 0; q < 4; ++q) { const f32x4 ga = *(const f32x4*)(ngain + lane * 16 + q * 4), sc = *(const f32x4*)(mp + 1024 + q * 4), sh = *(const f32x4*)(mp + q * 4);
#pragma unroll
                            for (int e = 0; e < 4; ++e) { A[q * 4 + e] = ga[e] * (1.f + sc[e]); SH[q * 4 + e] = sh[e]; } }
#pragma unroll
                        for (int e = 0; e < 16; ++e) asm volatile("" : "+v"(SH[e])); } }
                const u32x4 r0 = q0[i], r1 = q1[i];
                float xn[16]; float ss = 0.f;
#pragma unroll
                for (int d = 0; d < 4; ++d) { xn[2 * d] = bf_lo(r0[d]); xn[2 * d + 1] = bf_hi(r0[d]); xn[8 + 2 * d] = bf_lo(r1[d]); xn[8 + 2 * d + 1] = bf_hi(r1[d]); }
#pragma unroll
                for (int e = 0; e < 16; ++e) ss += xn[e] * xn[e];
                ss = wave_sum(ss);
                const float rs = 1.0f / sqrtf(ss * (1.0f / DM) + RMS_EPS);
                if (LAST) {
                    float* op = outp + (size_t)row * DM + lane * 16;
#pragma unroll
                    for (int q = 0; q < 4; ++q) { f32x4 oa;
#pragma unroll
                        for (int e = 0; e < 4; ++e) oa[e] = xn[q * 4 + e] * rs * A[q * 4 + e];
                        *(f32x4*)(op + q * 4) = oa; }
                } else {
                    float y[16];
#pragma unroll
                    for (int e = 0; e < 16; ++e) y[e] = xn[e] * rs * A[e] + SH[e];
                    u32x4 w0; w0.x = pk_fp8x4(y[0], y[1], y[2], y[3]); w0.y = pk_fp8x4(y[4], y[5], y[6], y[7]); w0.z = pk_fp8x4(y[8], y[9], y[10], y[11]); w0.w = pk_fp8x4(y[12], y[13], y[14], y[15]);
                    *(u32x4*)((unsigned char*)Hn + (size_t)row * DM + lane * 16) = w0;
                }
            }
        }
    };
    for (int cbase = row0; cbase < row1; cbase += 16) {
        group(IConst<0>{}, cbase);
        if (cbase + 4 < row1) { group(IConst<1>{}, cbase + 4); if (cbase + 8 < row1) { group(IConst<0>{}, cbase + 8); if (cbase + 12 < row1) group(IConst<1>{}, cbase + 12); } }
    }
#undef PR_LOAD
}
__device__ __forceinline__ int iclamp(int v, int lo, int hi) { return v < lo ? lo : (v > hi ? hi : v); }
__device__ __forceinline__ void attn_l0_phase(LAS unsigned char* lds, const bf16* Z, unsigned char* OUT, const float* rpb_g, const float* sink_g, int vcu, int G) {
    const int tid = threadIdx.x, lane = fresh_lane(), w = __builtin_amdgcn_readfirstlane(tid >> 6), r32 = lane & 31, h = lane >> 5;
    LAS float* rpbL = (LAS float*)(lds + 65536);
    int rpb_hd = -1;
    for (int u = vcu; u < 4352; u += G) {
        f32x16 O[2];
        if (u < 2048) {
            const int rg = u & 15, hd = (u >> 4) & 7, b = u >> 7;
            if (hd != rpb_hd) { rpb_hd = hd; const int rr = tid >> 5, cc = tid & 31; rpbL[tid] = (rr < 15 && cc < 31) ? rpb_g[hd * 465 + rr * 31 + cc] * LOG2E : NEGBIG; }
            PolNA p; p.kb = Z + 512 + hd * 64; p.k2b = p.kb; p.vb = Z + 1024 + hd * 64; p.ldk = p.ldk2 = p.ldv = AB_IN; p.lat0 = b * SEQ; p.ctx0 = NLAT + b * CTX;
            const int lo = iclamp(4 * rg - 4, 0, 56), hi = iclamp(4 * rg - 1, 0, 56) + 7; p.lo = lo; p.nt = 4 + hi - lo + 1;
            const int q0 = 4 * rg + 2 * (w >> 2), g = w & 3, qi = q0 + (r32 >> 4), qc = 16 * g + (r32 & 15);
            p.ra = iclamp(q0 - 4, 0, 56); p.rb = iclamp(q0 - 3, 0, 56); p.cs = iclamp(16 * g - 8, 0, 32); p.qi = qi; p.r0i = iclamp(qi - 4, 0, 56); p.qc = qc; p.rpb = rpbL; p.init_lane(lane);
            const size_t row = (size_t)b * SEQ + qi * 64 + qc;
            attn_unit<PolNA>(lds, p, Z + row * AB_IN + hd * 64, NEGBIG, 0.f, O);
            store_o8<2>(OUT + row * DM + hd * 64, O, h);
        } else if (u < 4096) {
            const int u2 = u - 2048, qb = u2 & 63, kvh = (u2 >> 6) & 1, b = u2 >> 7, P0 = 64 * qb;
            const int i0 = P0 >= 128 ? 0 : (128 - P0) / 64; int i1 = (4160 - P0) / 64; i1 = i1 > 4 ? 4 : i1;
            PolSWA p; p.kb = Z + 2048 + kvh * 64; p.k2b = p.kb; p.vb = Z + 2176 + kvh * 64; p.ldk = p.ldk2 = p.ldv = AB_IN; p.lat0 = b * SEQ; p.ctx0 = NLAT + b * CTX;
            p.pos0 = P0 - 128 + 64 * i0; p.nt = 4 + (i1 - i0 + 1);
            const int g = w >> 1, half = w & 1, qp = P0 + 32 * half + r32, qh = kvh * 4 + g; p.qp = qp;
            const size_t row = (size_t)b * SEQ + qp;
            attn_unit<PolSWA>(lds, p, Z + row * AB_IN + 1536 + qh * 64, sink_g[qh] * LOG2E, h == 0 ? 1.f : 0.f, O);
            store_o8<2>(OUT + row * DM + 512 + qh * 64, O, h);
        } else {
            const int u3 = u - 4096, ty = u3 >> 7, hd = u3 & 7, b = (u3 >> 3) & 15;
            PolPlain<64, 64> p; p.ldk = p.ldk2 = p.ldv = AB_IN; p.lat0 = 0; p.nlat = 0; p.ctx0 = NLAT + b * CTX; p.nt = 4; p.c2 = 0.125f * LOG2E;
            int qcol, ocol; float m0 = NEGBIG, l0 = 0.f;
            if (ty == 0) { p.kb = Z + 512 + hd * 64; p.vb = Z + 1024 + hd * 64; qcol = hd * 64; ocol = hd * 64; }
            else { p.kb = Z + 2048 + (hd >> 2) * 64; p.vb = Z + 2176 + (hd >> 2) * 64; qcol = 1536 + hd * 64; ocol = 512 + hd * 64; m0 = sink_g[hd] * LOG2E; l0 = h == 0 ? 1.f : 0.f; }
            p.k2b = p.kb;
            const size_t row = (size_t)NLAT + b * CTX + 32 * w + r32;
            attn_unit<PolPlain<64, 64>>(lds, p, Z + row * AB_IN + qcol, m0, l0, O);
            store_o8<2>(OUT + row * DM + ocol, O, h);
        }
    }
}
template <int ABLV>
__device__ __forceinline__ void attn_l1_phase(LAS unsigned char* lds, const bf16* Z, const bf16* QM, const bf16* KV, unsigned char* OUT, bf16* STASH, const float* lamv, const float* subln, const float* rstd, int vcu, int G) {
    const int tid = threadIdx.x, lane = fresh_lane(), w = __builtin_amdgcn_readfirstlane(tid >> 6), r32 = lane & 31, h = lane >> 5;
    const float lam = __uint_as_float(__builtin_amdgcn_readfirstlane(__float_as_uint(expf(wave_sum(lamv[lane] * lamv[64 + lane])) - expf(wave_sum(lamv[128 + lane] * lamv[192 + lane])) + LAM_INIT1)));
    for (int u = vcu; u < 2048; u += G) {
        if (u < 1024) {
            const int qb = u & 7, hd = (u >> 3) & 7, b = u >> 6;
            PolPlain<96, 64, true> p; p.kb = KV + hd * 128; p.ldk = DM; p.k2b = Z + 384; p.ldk2 = AB_IN; p.vb = KV + hd * 128 + 64; p.ldv = DM;
            p.lat0 = b * SEQ; p.ctx0 = NLAT + b * CTX; p.nlat = 64; p.nt = 68; p.c2 = 1.f;
            const size_t row = (size_t)b * SEQ + 512 * qb + 64 * w + (fresh_lane() & 31);
            f32x16 O2[2][2];
            const bool alarm = attn_unit64(lds, p, QM + row * 768 + hd * 96, QM + (row + 32) * 768 + hd * 96, O2);
            { const int l2 = fresh_lane(); const size_t row2 = (size_t)b * SEQ + 512 * qb + 64 * w + (l2 & 31);
              store_o8<2>(OUT + row2 * DM + hd * 64, O2[0], l2 >> 5); store_o8<2>(OUT + (row2 + 32) * DM + hd * 64, O2[1], l2 >> 5); }
            volatile LAS unsigned* aflag = (volatile LAS unsigned*)(lds + 140 * 1024);
            if (tid == 0) *aflag = 0u;
            __syncthreads();
            if (__builtin_amdgcn_ballot_w64(alarm) != 0ull && fresh_lane() == 0) *aflag = 1u;
            __syncthreads();
            if (*aflag != 0u) {
                asm volatile("s_waitcnt vmcnt(0)" ::: "memory");
                for (int hf = 0; hf < 2; ++hf) { const int l3 = fresh_lane(); const size_t rowh = (size_t)b * SEQ + 512 * qb + 256 * hf + 32 * w + (l3 & 31); f32x16 O[2];
                    attn_unit<PolPlain<96, 64, true>, ABLV>(lds, p, QM + rowh * 768 + hd * 96, NEGBIG, 0.f, O);
                    store_o8<2>(OUT + rowh * DM + hd * 64, O, l3 >> 5); }
            }
            __syncthreads();
        } else {
            const int u2 = u - 1024, qb = u2 & 15, hh = (u2 >> 4) & 3, b = u2 >> 6;
            PolPlain<64, 128, true> p; p.ldk = p.ldk2 = p.ldv = AB_IN; p.vb = Z + 1440 + hh * 128; p.lat0 = b * SEQ; p.ctx0 = NLAT + b * CTX; p.nlat = 64; p.nt = 68; p.c2 = 1.f;
            const size_t row = (size_t)b * SEQ + 256 * qb + 32 * w + (fresh_lane() & 31);
            f32x16 O[4]; LAS unsigned char* o1l = lds + 65536 + fresh_tid() * 8;
            p.kb = Z + 928 + (hh * 2) * 64; p.k2b = p.kb;
            attn_unit<PolPlain<64, 128, true>, ABLV>(lds, p, Z + row * AB_IN + 416 + (hh * 2) * 64, NEGBIG, 0.f, O);
#pragma unroll
            for (int db = 0; db < 4; ++db)
#pragma unroll
                for (int g = 0; g < 4; ++g) { u32x2 wv; wv.x = cvt_pk_bf16(O[db][4 * g], O[db][4 * g + 1]); wv.y = cvt_pk_bf16(O[db][4 * g + 2], O[db][4 * g + 3]); *(LAS u32x2*)(o1l + (db * 4 + g) * 4096) = wv; }
            p.kb = Z + 928 + (hh * 2 + 1) * 64; p.k2b = p.kb;
            attn_unit<PolPlain<64, 128, true>, ABLV>(lds, p, Z + row * AB_IN + 416 + (hh * 2 + 1) * 64, NEGBIG, 0.f, O);
            float ss = 0.f;
#pragma unroll
            for (int db = 0; db < 4; ++db)
#pragma unroll
                for (int g = 0; g < 4; ++g) { const u32x2 pw = *(const LAS u32x2*)(o1l + (db * 4 + g) * 4096);
                    const float d0 = bf_lo(pw.x) - lam * O[db][4 * g], d1 = bf_hi(pw.x) - lam * O[db][4 * g + 1], d2 = bf_lo(pw.y) - lam * O[db][4 * g + 2], d3 = bf_hi(pw.y) - lam * O[db][4 * g + 3];
                    O[db][4 * g] = d0; O[db][4 * g + 1] = d1; O[db][4 * g + 2] = d2; O[db][4 * g + 3] = d3; ss += (d0 * d0 + d1 * d1) + (d2 * d2 + d3 * d3); }
            ss = xsum32(ss);
            const float rs = (1.f - LAM_INIT1) / sqrtf(ss * (1.0f / 128.0f) + RMS_EPS);
#pragma unroll
            for (int db = 0; db < 4; ++db)
#pragma unroll
                for (int g = 0; g < 4; ++g) { const f32x4 sg = *(const f32x4*)(subln + 32 * db + 8 * g + 4 * (fresh_lane() >> 5));
#pragma unroll
                    for (int e = 0; e < 4; ++e) O[db][4 * g + e] *= rs * sg[e]; }
            store_o8<4>(OUT + row * DM + 512 + hh * 128, O, h);
        }
    }
}
#ifndef STOP_AFTER
#define STOP_AFTER 23
#endif
#ifndef ONE_LAUNCH
#define ONE_LAUNCH 1
#endif
struct Args { const float* in[24]; float* out; unsigned char* ws; int ph_lo, ph_hi; };
__global__ void __launch_bounds__(NTHREADS, 2) fwd(Args a) {
    extern __shared__ __attribute__((aligned(16))) unsigned char lds_raw[];
    LAS unsigned char* lds = (LAS unsigned char*)lds_raw;
    const int tid = threadIdx.x, wave = __builtin_amdgcn_readfirstlane(tid >> 6);
#define lane fresh_lane()
    const int G = gridDim.x, bx = blockIdx.x, vcu = (G % 8 == 0) ? (bx % 8) * (G / 8) + bx / 8 : bx;
    const int gw = vcu * NWAVES + wave, ngw = G * NWAVES;
    unsigned char* ws = a.ws;
    unsigned* ctl = (unsigned*)(ws + WS_CTL);
    float* MOD = (float*)(ws + WS_MOD); float* ROPE = (float*)(ws + WS_ROPE); float* RSTD = (float*)(ws + WS_RSTD);
    unsigned char* WIN0 = ws + WS_WIN0; unsigned char* WOUT = ws + WS_WOUT; signed char* WPQ = (signed char*)(ws + WS_WPQ); float* WPF = (float*)(ws + WS_Z); float* WPSC = (float*)(ws + WS_SCL + 256 * 1024); unsigned char* WIN1 = ws + WS_WIN1;
    bf16* WUQ = (bf16*)(ws + WS_WUQ); bf16* WUKV = (bf16*)(ws + WS_WUKV);
    unsigned char* UB = ws + WS_U; unsigned char* VB = ws + WS_V; float* USC = (float*)(ws + WS_SCL); float* VSC = USC + 2 * NEXP; bf16* ACT1 = (bf16*)(ws + WS_ACT1); bf16* ACT2 = (bf16*)a.out; bf16* RES = (bf16*)(ws + WS_RES);
    bf16* Z = (bf16*)(ws + WS_Z); bf16* QM = (bf16*)(ws + WS_QM); bf16* KV = (bf16*)(ws + WS_KV);
    unsigned short* SELE = (unsigned short*)(ws + WS_QM); bf16* SELW = (bf16*)(ws + WS_QM + 34 * MiB); bf16* PA = (bf16*)(ws + WS_Z); bf16* FB = (bf16*)(ws + WS_KV);
    float* XSC = (float*)(ws + WS_ROPE + 65536);
    const float* x_in = a.in[0]; const float* c_in = a.in[1]; const float* ctx_in = a.in[2]; const float* cctx_in = a.in[3]; const float* ada_w = a.in[4]; const float* ada_b = a.in[5];
    const float* norm1_g = a.in[6]; const float* norm2_g = a.in[7]; const float* w_out = a.in[8]; const float* peer_wq = a.in[9]; const float* peer_keys = a.in[10];
    const float* peer_u = a.in[11]; const float* peer_v = a.in[12]; const float* ab_w_in = a.in[13]; const float* na_rpb = a.in[14]; const float* swa_sink = a.in[15];
    const float* cd_w_in = a.in[16]; const float* q_norm_g = a.in[17]; const float* w_uq = a.in[18]; const float* kv_norm_g = a.in[19]; const float* w_ukv = a.in[20];
    const float* diff_lambda = a.in[21]; const float* subln_g = a.in[22]; const float* final_g = a.in[23];
    float* out = a.out;

    volatile LAS unsigned* MISC = (volatile LAS unsigned*)(lds + LDS_MISC);
    if (tid < 16) MISC[tid] = 0u;
    __syncthreads();
    const int lo = a.ph_lo, hi = a.ph_hi & 0xff;
    XcdBarrier bar; bar.bar = ctl + CW_BAR; bar.x = 0; bar.st = MISC + 8;
    if (hi - lo > 1) bar = xcd_barrier_post(ctl + CW_BAR, MISC + 8);
#ifndef PHASE_MASK
#define PHASE_MASK 0xffffff
#endif
#define IN(k) ((((PHASE_MASK) >> (k)) & 1) && lo <= (k) && (k) < hi)
#if defined(DEBUG_TIME)
#define STAMP(k) do { if (bx == 0 && tid == 0) ((unsigned long long*)(ws + 980 * MiB))[k] = __builtin_amdgcn_s_memrealtime(); } while (0)
#else
#define STAMP(k) do { } while (0)
#endif
#ifndef REPEAT_MASK
#define REPEAT_MASK 0
#endif
#define SEAM(k) do { if (IN(k) && IN((k) + 1)) xcd_barrier(bar); STAMP((k) + 1); } while (0)
    STAMP(0);

    if (IN(0)) {
        if (bx < 192) {
            const int l = bx / 96, n0 = (bx % 96) * 64;
            LAS float* sil = (LAS float*)lds;
            { f32x4 cv4[9];
#pragma unroll
              for (int j = 0; j < 9; ++j) { const int v4 = tid + NTHREADS * j; cv4[j] = (v4 < 4096) ? *(const f32x4*)(c_in + 4 * v4) : ((v4 < 4352) ? *(const f32x4*)(cctx_in + 4 * (v4 - 4096)) : (f32x4){0.f, 0.f, 0.f, 0.f}); }
#pragma unroll
              for (int j = 0; j < 9; ++j) { const int v4 = tid + NTHREADS * j; f32x4 sv;
#pragma unroll
                  for (int e = 0; e < 4; ++e) sv[e] = cv4[j][e] / (1.f + expf(-cv4[j][e]));
                  if (v4 < 4352) *(LAS f32x4*)(sil + 4 * v4) = sv; } }
            __syncthreads();
            float acc[17];
#pragma unroll
            for (int r = 0; r < 17; ++r) acc[r] = 0.f;
            const float* wp = ada_w + (size_t)l * 1024 * 6144 + n0 + lane;
            for (int k = wave * 128; k < wave * 128 + 128; k += 8) {
                const float w0 = wp[(size_t)k * 6144], w1 = wp[(size_t)(k + 1) * 6144], w2 = wp[(size_t)(k + 2) * 6144], w3 = wp[(size_t)(k + 3) * 6144];
                const float w4 = wp[(size_t)(k + 4) * 6144], w5 = wp[(size_t)(k + 5) * 6144], w6 = wp[(size_t)(k + 6) * 6144], w7 = wp[(size_t)(k + 7) * 6144];
#pragma unroll
                for (int r = 0; r < 17; ++r) { const f32x4 s4 = *(const LAS f32x4*)(sil + r * 1024 + k); acc[r] += (s4.x * w0 + s4.y * w1) + (s4.z * w2 + s4.w * w3); }
                __builtin_amdgcn_sched_barrier(0);
#pragma unroll
                for (int r = 0; r < 17; ++r) { const f32x4 s4 = *(const LAS f32x4*)(sil + r * 1024 + k + 4); acc[r] += (s4.x * w4 + s4.y * w5) + (s4.z * w6 + s4.w * w7); }
            }
            LAS float* part = (LAS float*)(lds + 69632);
#pragma unroll
            for (int r = 0; r < 17; ++r) part[(wave * 17 + r) * 64 + lane] = acc[r];
            __syncthreads();
            for (int idx = tid; idx < 17 * 64; idx += NTHREADS) { const int r = idx >> 6, ln = idx & 63; float s = 0.f;
#pragma unroll
                for (int w8 = 0; w8 < 8; ++w8) s += part[(w8 * 17 + r) * 64 + ln];
                MOD[((size_t)l * 17 + r) * 6144 + n0 + ln] = s + ada_b[l * 6144 + n0 + ln]; }
            __syncthreads();
        }
        LAS float* scr = (LAS float*)(lds + wave * 16384);
        constexpr int T0 = 1152, T1 = T0 + 1024, T2 = T1 + 1024, T3 = T2 + 96, T4 = T3 + 64, T5 = T4 + 4096, T6 = T5 + 4096, T7 = T6 + 24;
        for (int it = gw; it < T7; it += ngw) {
            if (it < T0) { const int kb = it / 72, nb = it % 72; transpose_item_f8(ab_w_in, 1024, AB_IN, WIN0, 64.f, scr, kb, nb, 32 * nb + (lane & 31), lane); }
            else if (it < T1) { const int r = it - T0, l = r >> 9, kb = (r & 511) >> 5, nb = r & 31; transpose_item_f8(w_out + (size_t)l * DM * DM, 1024, DM, WOUT + (size_t)l * DM * DM, 64.f, scr, kb, nb, 32 * nb + (lane & 31), lane); }
            else if (it < T2) { const int r = it - T1, kb = r >> 6, nb = r & 63, n = 32 * nb + (lane & 31);
                const int src = n < CD_IN ? (nb == 12 ? 384 + rope_perm(lane & 31) : n) : -1;
                transpose_item_f8(cd_w_in, 1024, CD_IN, WIN1, 64.f, scr, kb, nb, src, lane); }
            else if (it < T3) { const int r = it - T2, kb = r / 24, nb = r % 24; const int src = (nb % 3 == 2) ? 32 * nb + rope_perm(lane & 31) : 32 * nb + (lane & 31);
                transpose_item(w_uq, 256, 768, WUQ, q_norm_g, scr, kb, nb, src, lane); }
            else if (it < T4) { const int r = it - T3, kb = r >> 5, nb = r & 31; transpose_item(w_ukv, 128, 1024, WUKV, kv_norm_g, scr, kb, nb, 32 * nb + (lane & 31), lane); }
            else if (it < T5) {
                const int r = it - T4, l = r >> 11, hp = (r >> 7) & 15, kb = (r >> 2) & 31, nb = r & 3, i32 = lane & 31, hh = lane >> 5;
                const float* ap = peer_wq + (size_t)l * DM * PQ_N + (size_t)(32 * kb + i32) * PQ_N + hp * 128 + 64 * hh;
                const float* bp = peer_keys + (size_t)l * 2 * 128 * 128 + (size_t)(hp & 1) * 128 * 128 + (size_t)(32 * nb + i32) * 128 + 64 * hh;
                f32x16 acc;
#pragma unroll
                for (int i = 0; i < 16; ++i) acc[i] = 0.f;
#pragma unroll 1
                for (int s8 = 0; s8 < 16; s8 += 8) {
                    f32x4 av[8], bv[8];
#pragma unroll
                    for (int s4 = 0; s4 < 8; ++s4) { av[s4] = *(const f32x4*)(ap + 4 * (s8 + s4)); bv[s4] = *(const f32x4*)(bp + 4 * (s8 + s4)); }
#pragma unroll
                    for (int s4 = 0; s4 < 8; ++s4)
#pragma unroll
                        for (int e = 0; e < 4; ++e) acc = __builtin_amdgcn_mfma_f32_32x32x2f32(av[s4][e], bv[s4][e], acc, 0, 0, 0);
                }
                float* op = WPF + (size_t)l * PQ_N * DM + (size_t)(hp * 128 + 32 * nb + i32) * DM + 32 * kb + 4 * hh;
#pragma unroll
                for (int g = 0; g < 4; ++g) *(f32x4*)(op + 8 * g) = (f32x4){acc[4 * g], acc[4 * g + 1], acc[4 * g + 2], acc[4 * g + 3]};
            }
            else if (it < T6) {
                const int r0 = (it - T5) * 16; const bool isv = r0 >= 2 * NEXP; const int e0 = isv ? r0 - 2 * NEXP : r0;
                const float* src0 = (isv ? peer_v : peer_u) + (size_t)e0 * DM + lane * 16;
#pragma unroll 1
                for (int r4 = 0; r4 < 16; r4 += 8) {
                    f32x4 v[8][4];
#pragma unroll
                    for (int k = 0; k < 8; ++k)
#pragma unroll
                        for (int q = 0; q < 4; ++q) v[k][q] = *(const f32x4*)(src0 + (size_t)(r4 + k) * DM + 4 * q);
#pragma unroll
                    for (int k = 0; k < 8; ++k) {
                        const int er = e0 + r4 + k; float am = 0.f;
#pragma unroll
                        for (int q = 0; q < 4; ++q) am = fmaxf(am, fmaxf(fmaxf(fabsf(v[k][q].x), fabsf(v[k][q].y)), fmaxf(fabsf(v[k][q].z), fabsf(v[k][q].w))));
                        am = fmaxf(am, dpp_f<0xB1>(am)); am = fmaxf(am, dpp_f<0x4E>(am)); am = fmaxf(am, dpp_f<0x141>(am)); am = fmaxf(am, dpp_f<0x140>(am));
                        { const auto r = __builtin_amdgcn_permlane16_swap(__float_as_uint(am), __float_as_uint(am), false, false); am = fmaxf(__uint_as_float(r[0]), __uint_as_float(r[1])); }
                        { const auto r = __builtin_amdgcn_permlane32_swap(__float_as_uint(am), __float_as_uint(am), false, false); am = fmaxf(__uint_as_float(r[0]), __uint_as_float(r[1])); }
                        const float sc = am > 0.f ? (isv ? 240.f : 127.f) / am : 1.f; u32x4 w;
#pragma unroll
                        for (int q = 0; q < 4; ++q) {
                            if (isv) { int t = 0; t = __builtin_amdgcn_cvt_pk_fp8_f32(v[k][q].x * sc, v[k][q].y * sc, t, false); t = __builtin_amdgcn_cvt_pk_fp8_f32(v[k][q].z * sc, v[k][q].w * sc, t, true); w[q] = (unsigned)t; }
                            else { const int a = (int)rintf(v[k][q].x * sc), b = (int)rintf(v[k][q].y * sc), c = (int)rintf(v[k][q].z * sc), d = (int)rintf(v[k][q].w * sc);
                                   w[q] = (unsigned)(a & 0xff) | ((unsigned)(b & 0xff) << 8) | ((unsigned)(c & 0xff) << 16) | ((unsigned)(d & 0xff) << 24); } }
                        *(u32x4*)((isv ? VB : UB) + (size_t)(er >> 14) * NEXP * DM + (size_t)(lane >> 3) * NEXP * 128 + (size_t)(er & (NEXP - 1)) * 128 + (lane & 7) * 16) = w;
                        if (lane == 0) (isv ? VSC : USC)[er] = am > 0.f ? am / (isv ? 240.f : 127.f) : 1.f;
                    }
                }
            }
            else {
                const int idx = (it - T6) * 64 + lane;
                if (idx < 1024) { const int pos = idx >> 4, i = idx & 15; const float ang = (float)pos * powf(10000.f, -(float)i / 16.f); ROPE[idx] = cosf(ang); ROPE[1024 + idx] = sinf(ang); }
                else { const int j = idx - 1024, pos = j >> 3, i = j & 7; const float ang = (float)pos * powf(10000.f, -(float)i / 8.f); ROPE[2048 + j] = cosf(ang); ROPE[2560 + j] = sinf(ang); }
            }
        }
    }
    SEAM(0);
    if (IN(1)) { norm_mod_rows<1>(NROW, x_in, ctx_in, norm1_g, MOD, 0, 1024, ACT1, gw, ngw, lane);
        for (int row = gw; row < 2 * PQ_N; row += ngw) {
            const f32x4* wr4 = (const f32x4*)(WPF + (size_t)row * DM) + lane; f32x4 v[4]; float am = 0.f;
#pragma unroll
            for (int j = 0; j < 4; ++j) { v[j] = wr4[64 * j]; am = fmaxf(am, fmaxf(fmaxf(fabsf(v[j].x), fabsf(v[j].y)), fmaxf(fabsf(v[j].z), fabsf(v[j].w)))); }
            am = fmaxf(am, dpp_f<0xB1>(am)); am = fmaxf(am, dpp_f<0x4E>(am)); am = fmaxf(am, dpp_f<0x141>(am)); am = fmaxf(am, dpp_f<0x140>(am));
            { const auto r = __builtin_amdgcn_permlane16_swap(__float_as_uint(am), __float_as_uint(am), false, false); am = fmaxf(__uint_as_float(r[0]), __uint_as_float(r[1])); }
            { const auto r = __builtin_amdgcn_permlane32_swap(__float_as_uint(am), __float_as_uint(am), false, false); am = fmaxf(__uint_as_float(r[0]), __uint_as_float(r[1])); }
            const float q = am > 0.f ? 127.f / am : 0.f;
#pragma unroll
            for (int j = 0; j < 4; ++j) {
                const int a = (int)rintf(v[j].x * q), b = (int)rintf(v[j].y * q), c = (int)rintf(v[j].z * q), d = (int)rintf(v[j].w * q);
                *(unsigned*)(WPQ + (size_t)row * DM + 4 * (lane + 64 * j)) = (unsigned)(a & 0xff) | ((unsigned)(b & 0xff) << 8) | ((unsigned)(c & 0xff) << 16) | ((unsigned)(d & 0xff) << 24);
            }
            if (lane == 0) WPSC[row] = am * (1.0f / 127.f);
        }
    }
    SEAM(1);
    if (IN(2)) { pg8::Gemm g{ACT1, WIN0, NROW, AB_IN, 1024, 1024, 1024}; pg8::StaticOrder S; S.init(NROW, AB_IN, G, bx); EpiRope<0> E{Z, AB_IN, ROPE};
        pg8::gemm_phase<EpiRope<0>, pg8::StaticOrder, true, 0x79797979u, 0x7F7F7F7Fu>(lds, g, S, E); }
    SEAM(2);
    if (IN(3)) { attn_l0_phase(lds, Z, (unsigned char*)ACT2, na_rpb, swa_sink, vcu, G); }
    SEAM(3);
    if (IN(4)) { pg8::Gemm g{ACT2, WOUT, NROW, DM, 1024, 1024, 1024}; pg8::StaticOrder S; S.init(NROW, DM, G, bx); EpiResid<true> E{x_in, ctx_in, RES, MOD + 2048};
        pg8::gemm_phase<EpiResid<true>, pg8::StaticOrder, true, 0x79797979u, 0x7B7B7B7Bu>(lds, g, S, E); }
    SEAM(4);
    if (IN(5)) { norm_mod_rows<4, true>(NROW, (const float*)RES, nullptr, norm2_g, MOD, 3072, 4096, ACT1, gw, ngw, lane, (signed char*)ACT2, XSC); }
    SEAM(5);
    if (IN(6)) { pg8::Gemm g{ACT2, WPQ, NROW, PQ_N, 1024, 1024, 1024}; pg8::StaticOrder S; S.init(NROW, PQ_N, G, bx); EpiScore E{Z, PQ_N, XSC, WPSC};
        pg8::gemm_phase<EpiScore, pg8::StaticOrder, false, 0x7F7F7F7Fu, 0x7F7F7F7Fu, true, true, true>(lds, g, S, E); }
    SEAM(6);
#ifndef PROBE_DUP
#define PROBE_DUP 0
#endif
    if (IN(7)) { peer_select(lds, NROW, Z, SELE, SELW, vcu, G); if (PROBE_DUP & 1) { xcd_barrier(bar); peer_select(lds, NROW, Z, SELE, SELW, vcu, G); } }
    SEAM(7);
    if (IN(8)) { if (PROBE_DUP & 8) { peer_usweep<1>(lds, NROW, (const signed char*)ACT2, XSC, UB, SELE, PA, ctl + CW_Q + 4 * 512); xcd_barrier(bar); }
        peer_usweep(lds, NROW, (const signed char*)ACT2, XSC, UB, SELE, PA, ctl + CW_Q + 0 * 512); if (PROBE_DUP & 2) { xcd_barrier(bar); peer_usweep(lds, NROW, (const signed char*)ACT2, XSC, UB, SELE, PA, ctl + CW_Q + 4 * 512); } }
    SEAM(8);
    if (IN(9)) peer_combine(lds, NROW, PA, SELE, SELW, USC, VSC, XSC, gw, ngw, lane);
    SEAM(9);
    if (IN(10)) { peer_vsweep(lds, NROW, VB, SELE, (const unsigned char*)SELW, XSC, RES, MOD + 5120, ctl + CW_Q + 1 * 512, ws + 512 * 1024); }
    SEAM(10);
    if (IN(11)) peer_rows<false>(NROW, RES, out, norm1_g + DM, MOD + 17 * 6144, ACT2, gw, ngw, lane);
    SEAM(11);
    if (IN(12)) { pg8::Gemm g{ACT2, WIN1, NROW, CD_PAD, 1024, 1024, 1024}; pg8::StaticOrder S; S.init(NROW, CD_PAD, G, bx); EpiRope<1> E{Z, AB_IN, ROPE};
        pg8::gemm_phase<EpiRope<1>, pg8::StaticOrder, true, 0x79797979u, 0x7F7F7F7Fu>(lds, g, S, E); }
    SEAM(12);
    if (IN(13)) {
        const int R13 = ((NROW / 4 + ngw - 1) / ngw) * 4, r13a = gw * R13, r13b = min(r13a + R13, NROW);
        if (r13a < r13b) {
            u32x2 qa8[8]; unsigned kb8[8];
#define P13_LOAD(buf_, r_) do { const bf16* zr_ = Z + (size_t)min((r_), r13b - 1) * AB_IN; qa8[buf_] = *(const u32x2*)(zr_ + lane * 4); kb8[buf_] = *(const unsigned*)(zr_ + 256 + lane * 2); } while (0)
#pragma unroll
            for (int p = 0; p < 6; ++p) P13_LOAD(p, r13a + p);
            auto group13 = [&](auto PAR, const int base) __attribute__((always_inline)) {
                constexpr int P4 = decltype(PAR)::value * 4;
#pragma unroll
                for (int i = 0; i < 4; ++i) {
                    const int cb = (P4 + i) & 7, row = base + i;
                    P13_LOAD((cb + 6) & 7, row + 6);
                    const u32x2 qa = qa8[cb]; const unsigned kb2 = kb8[cb];
                    float sq = bf_lo(qa.x) * bf_lo(qa.x) + bf_hi(qa.x) * bf_hi(qa.x) + bf_lo(qa.y) * bf_lo(qa.y) + bf_hi(qa.y) * bf_hi(qa.y), sk = bf_lo(kb2) * bf_lo(kb2) + bf_hi(kb2) * bf_hi(kb2);
                    sq = wave_sum(sq); sk = wave_sum(sk);
                    if (lane == 0) { RSTD[(size_t)row * 2] = 1.0f / sqrtf(sq * (1.0f / 256.0f) + RMS_EPS); RSTD[(size_t)row * 2 + 1] = 1.0f / sqrtf(sk * (1.0f / 128.0f) + RMS_EPS); }
                }
            };
            for (int cbase = r13a; cbase < r13b; cbase += 16) {
                group13(IConst<0>{}, cbase);
                if (cbase + 4 < r13b) { group13(IConst<1>{}, cbase + 4); if (cbase + 8 < r13b) { group13(IConst<0>{}, cbase + 8); if (cbase + 12 < r13b) group13(IConst<1>{}, cbase + 12); } }
            }
#undef P13_LOAD
        }
    }
    SEAM(13);
    if (IN(14)) {
        { pg8::Gemm g{Z, WUQ, NLAT, 768, 512, AB_IN * 2, 512}; pg8::StaticOrder S; S.init(NLAT, 768, G, bx); EpiRope<2> E{QM, 768, ROPE, RSTD};
          pg8::gemm_phase<EpiRope<2>, pg8::StaticOrder>(lds, g, S, E); }
        __syncthreads();
        { pg8::Gemm g{Z + 256, WUKV, NROW, 1024, 256, AB_IN * 2, 256}; pg8::StaticOrder S; S.init(NROW, 1024, G, bx); EpiBf16 E{KV, DM, RSTD, 1};
          pg8::gemm_phase<EpiBf16, pg8::StaticOrder>(lds, g, S, E); }
    }
    SEAM(14);
    if (IN(15)) {
#if defined(ATT_PROBE)
        if (a.ph_hi >> 8) attn_l1_phase<ATT_PROBE>(lds, Z, QM, KV, (unsigned char*)ACT2 + 64 * MiB, ACT2, diff_lambda, subln_g, RSTD, vcu, G); else
#endif
        attn_l1_phase<0>(lds, Z, QM, KV, (unsigned char*)ACT1, ACT2, diff_lambda, subln_g, RSTD, vcu, G); }
    SEAM(15);
    if (IN(16)) { pg8::Gemm g{ACT1, WOUT + (size_t)DM * DM, NLAT, DM, 1024, 1024, 1024}; pg8::StaticOrder S; S.init(NLAT, DM, G, bx); EpiResid<false> E{nullptr, nullptr, RES, MOD + 17 * 6144 + 2048};
        pg8::gemm_phase<EpiResid<false>, pg8::StaticOrder, true, 0x79797979u, 0x7B7B7B7Bu>(lds, g, S, E); }
    SEAM(16);
    if (IN(17)) { norm_mod_rows<4, true>(NLAT, (const float*)RES, nullptr, norm2_g + DM, MOD + 17 * 6144, 3072, 4096, ACT2, gw, ngw, lane, (signed char*)ACT1, XSC); }
    SEAM(17);
    if (IN(18)) { pg8::Gemm g{ACT1, WPQ + (size_t)PQ_N * DM, NLAT, PQ_N, 1024, 1024, 1024}; pg8::StaticOrder S; S.init(NLAT, PQ_N, G, bx); EpiScore E{Z, PQ_N, XSC, WPSC + PQ_N};
        pg8::gemm_phase<EpiScore, pg8::StaticOrder, false, 0x7F7F7F7Fu, 0x7F7F7F7Fu, true, true, true>(lds, g, S, E); }
    SEAM(18);
    if (IN(19)) peer_select(lds, NLAT, Z, SELE, SELW, vcu, G);
    SEAM(19);
    if (IN(20)) peer_usweep(lds, NLAT, (const signed char*)ACT1, XSC, UB + (size_t)NEXP * DM, SELE, PA, ctl + CW_Q + 2 * 512);
    SEAM(20);
    if (IN(21)) peer_combine(lds, NLAT, PA, SELE, SELW, USC + NEXP, VSC + NEXP, XSC, gw, ngw, lane);
    SEAM(21);
    if (IN(22)) peer_vsweep(lds, NLAT, VB + (size_t)NEXP * DM, SELE, (const unsigned char*)SELW, XSC, RES, MOD + 17 * 6144 + 5120, ctl + CW_Q + 3 * 512, ws + 512 * 1024);
    SEAM(22);
    if (IN(23)) peer_rows<true>(NLAT, RES, out, final_g, MOD, ACT1, gw, ngw, lane);
    STAMP(24);
#if STOP_AFTER < 23
    if (lo <= 24 && 24 < hi) {
        for (int row = gw; row < NLAT; row += ngw) {
            f32x4* xr = (f32x4*)(out + (size_t)row * DM) + lane; f32x4 v[4]; float s = 0.f;
#pragma unroll
            for (int j = 0; j < 4; ++j) { v[j] = xr[64 * j]; s += (v[j].x * v[j].x + v[j].y * v[j].y) + (v[j].z * v[j].z + v[j].w * v[j].w); }
            const float rs = 1.0f / sqrtf(wave_sum(s) * (1.0f / DM) + RMS_EPS);
#pragma unroll
            for (int j = 0; j < 4; ++j) xr[64 * j] = v[j] * rs * ((const f32x4*)final_g)[lane + 64 * j];
        }
    }
#endif
#undef IN
#undef SEAM
#undef lane
}

#if defined(DEBUG_CHECK) || defined(DEBUG_TIME)
constexpr size_t WS_DBG = 980 * MiB;
__device__ __forceinline__ float bf2f(bf16 v) { return __uint_as_float((unsigned)v << 16); }
__device__ __forceinline__ float wave_max(float v) {
#pragma unroll
    for (int o = 1; o < 64; o <<= 1) v = fmaxf(v, __shfl_xor(v, o));
    return v;
}
__device__ __forceinline__ void wave_argmax(float& v, int& i) {
#pragma unroll
    for (int o = 1; o < 64; o <<= 1) { const float ov = __shfl_xor(v, o); const int oi = __shfl_xor(i, o); if (ov > v || (ov == v && oi < i)) { v = ov; i = oi; } }
}
__global__ void __launch_bounds__(64) dbg_check(Args a, int check) {
    __shared__ float sh[4096]; __shared__ float sv[16][16]; __shared__ int si[16][16];
    const int b = blockIdx.x, lane = threadIdx.x;
    unsigned char* ws = a.ws; float* DBG = (float*)(ws + WS_DBG);
    const float* MOD = (const float*)(ws + WS_MOD);
    const bf16* ACT1 = (const bf16*)(ws + WS_ACT1); const bf16* ACT2 = (const bf16*)(ws + WS_ACT2); const bf16* Z = (const bf16*)(ws + WS_Z);
    const float* FDBG = (const float*)(ws + WS_QM);
    float err = 0.f;
    if (check == 8 || check == 9) return;
    if (check == 1) {
        const int l = b & 1, r = (b >> 1) % 17, n = (b * 97) % 6144; float s = 0.f;
        for (int k = lane; k < 1024; k += 64) { const float cv = r < 16 ? a.in[1][r * 1024 + k] : a.in[3][k]; s += cv / (1.f + expf(-cv)) * a.in[4][((size_t)l * 1024 + k) * 6144 + n]; }
        s = wave_sum(s) + a.in[5][l * 6144 + n]; const float got = MOD[((size_t)l * 17 + r) * 6144 + n]; err = fabsf(got - s) / (fabsf(s) + 0.05f);
    } else if (check == 2) {
        const int row = (b * 1031 + 7) % NROW; const bool lat = row < NLAT; const int br = lat ? row >> 12 : 16;
        const float* xr = lat ? a.in[0] + (size_t)row * DM : a.in[2] + (size_t)(row - NLAT) * DM; float ss = 0.f;
        for (int k = lane; k < 1024; k += 64) ss += xr[k] * xr[k];
        ss = wave_sum(ss); const float rs = 1.f / sqrtf(ss / 1024.f + RMS_EPS); float md = 0.f, mr = 0.f;
        for (int k = lane; k < 1024; k += 64) { const float ref = xr[k] * rs * a.in[6][k] * (1.f + MOD[(size_t)br * 6144 + 1024 + k]) + MOD[(size_t)br * 6144 + k]; md = fmaxf(md, fabsf(ref - bf2f(ACT1[(size_t)row * DM + k]))); mr = fmaxf(mr, fabsf(ref)); }
        err = wave_max(md) / wave_max(mr);
    } else if (check == 3) {
        const int row = (b * 1031 + 7) % NROW; const bool lat = row < NLAT; const int t = row & 4095; float md = 0.f, mr = 0.f;
        for (int j = 0; j < 24; ++j) {
            const int col = (b * 37 + j * 149) % AB_IN; const bool rope = lat && col >= 1536 && col < 2176; const int d = col & 63, first = (d & 31) < 16, pc = rope ? (first ? col + 16 : col - 16) : col;
            float s0 = 0.f, s1 = 0.f;
            for (int k = lane; k < 1024; k += 64) { const float hv = bf2f(ACT1[(size_t)row * DM + k]); s0 += hv * a.in[13][(size_t)k * AB_IN + col]; s1 += hv * a.in[13][(size_t)k * AB_IN + pc]; }
            s0 = wave_sum(s0); s1 = wave_sum(s1); float ref = s0;
            if (rope) { const int pos = d < 32 ? t >> 6 : t & 63, i = d & 15; const float ang = (float)pos * powf(10000.f, -(float)i / 16.f), c = cosf(ang), s = sinf(ang); ref = first ? s0 * c - s1 * s : s1 * s + s0 * c; }
            md = fmaxf(md, fabsf(ref - bf2f(Z[(size_t)row * AB_IN + col]))); mr = fmaxf(mr, fabsf(ref));
        }
        err = md / fmaxf(mr, 0.5f);
    } else if (check == 4) {
        const int hs = b & 15; const int row = (b < 48) ? (((b * 2657 + 11) % NLAT)) : (NLAT + (b * 613) % NCTX); const bool lat = row < NLAT; const int bb = lat ? row >> 12 : (row - NLAT) >> 8, t = row & 4095;
        const int qcol = hs < 8 ? hs * 64 : 1536 + (hs - 8) * 64, kcol = hs < 8 ? 512 + hs * 64 : 2048 + ((hs - 8) >> 2) * 64, vcol = hs < 8 ? 1024 + hs * 64 : 2176 + ((hs - 8) >> 2) * 64;
        const bf16* q = Z + (size_t)row * AB_IN + qcol;
        const int qr = t >> 6, qc = t & 63;
        float* lg = sh; int nk = 0;
        int* kr = (int*)(sh + 1024);
        if (lane == 0) {
            if (lat && hs < 8) { const int r0 = min(max(qr - 4, 0), 56), cs = min(max(qc - 8, 0), 48);
                for (int r = r0; r < r0 + 8; ++r) for (int c = cs; c < cs + 16; ++c) kr[nk++] = bb * 4096 + r * 64 + c; }
            else if (lat) { for (int p = max(t - 128, 0); p <= min(t + 128, 4095); ++p) kr[nk++] = bb * 4096 + p; }
            for (int c = 0; c < 256; ++c) kr[nk++] = NLAT + bb * 256 + c;
            ((int*)sh)[3000] = nk;
        }
        __syncthreads(); nk = ((int*)sh)[3000];
        float mx = -1e30f;
        for (int k = lane; k < nk; k += 64) { const bf16* kp = Z + (size_t)kr[k] * AB_IN + kcol; float s = 0.f; for (int d = 0; d < 64; ++d) s += bf2f(q[d]) * bf2f(kp[d]); s *= 0.125f;
            if (lat && hs < 8 && kr[k] < NLAT) { const int kt = kr[k] & 4095, r = kt >> 6, c = kt & 63; s += a.in[14][hs * 465 + (r - qr + 7) * 31 + min(max(c - qc + 15, 0), 30)]; }
            lg[k] = s; mx = fmaxf(mx, s); }
        if (hs >= 8) mx = fmaxf(mx, a.in[15][hs - 8]);
        mx = wave_max(mx); __syncthreads(); float den = 0.f;
        for (int k = lane; k < nk; k += 64) { lg[k] = expf(lg[k] - mx); den += lg[k]; }
        den = wave_sum(den); if (hs >= 8) den += expf(a.in[15][hs - 8] - mx);
        __syncthreads();
        float o = 0.f; for (int k = 0; k < nk; ++k) o += lg[k] * bf2f(Z[(size_t)kr[k] * AB_IN + vcol + lane]);
        o /= den; const float got = bf2f(ACT2[(size_t)row * DM + (hs < 8 ? hs * 64 : 512 + (hs - 8) * 64) + lane]);
        err = wave_max(fabsf(got - o)) / fmaxf(wave_max(fabsf(o)), 0.02f);
    } else if (check == 5) {
        const int row = (b * 1031 + 7) % NROW; const bool lat = row < NLAT; const int br = lat ? row >> 12 : 16; float md = 0.f;
        for (int j = 0; j < 16; ++j) { const int col = (b * 37 + j * 149) % DM; float s = 0.f;
            for (int k = lane; k < 1024; k += 64) s += bf2f(ACT2[(size_t)row * DM + k]) * a.in[8][(size_t)k * DM + col];
            s = wave_sum(s); const float base = lat ? a.in[0][(size_t)row * DM + col] : a.in[2][(size_t)(row - NLAT) * DM + col];
            const float ref = base + MOD[(size_t)br * 6144 + 2048 + col] * s, got = lat ? a.out[(size_t)row * DM + col] : ((const float*)(ws + WS_CTXRES))[(size_t)(row - NLAT) * DM + col];
            md = fmaxf(md, fabsf(ref - got) / fmaxf(fabsf(MOD[(size_t)br * 6144 + 2048 + col] * s), 0.02f)); }
        err = md;
    } else if (check == 6) {
        const int row = (b * 1031 + 7) % NROW, hp = b & 15; const bf16* h2 = ACT1 + (size_t)row * DM;
        for (int dd = 0; dd < 2; ++dd) { const int d = lane + 64 * dd; float s = 0.f; for (int k = 0; k < 1024; ++k) s += bf2f(h2[k]) * a.in[9][(size_t)k * PQ_N + hp * 128 + d]; sh[d] = s; }
        __syncthreads(); float md = 0.f, mr = 0.f;
        for (int nn = 0; nn < 2; ++nn) { const int n = lane + 64 * nn; float s = 0.f; for (int d = 0; d < 128; ++d) s += sh[d] * a.in[10][((size_t)(hp & 1) * 128 + n) * 128 + d];
            md = fmaxf(md, fabsf(s - bf2f(Z[(size_t)row * PQ_N + hp * 128 + n]))); mr = fmaxf(mr, fabsf(s)); }
        err = wave_max(md) / wave_max(mr);
    } else if (check == 7) {
        const int row = (b * 31 + 3) % 2048; const bf16* h2 = ACT1 + (size_t)row * DM;
        for (int hp = 0; hp < 16; ++hp) {
            float v0 = bf2f(Z[(size_t)row * PQ_N + hp * 128 + lane]), v1 = bf2f(Z[(size_t)row * PQ_N + hp * 128 + 64 + lane]);
            for (int it = 0; it < 16; ++it) { float v = v0; int i = lane; if (v1 > v0) { v = v1; i = lane + 64; } wave_argmax(v, i); if (lane == 0) { sv[hp][it] = v; si[hp][it] = i; } if (i == lane) v0 = -3e38f; if (i == lane + 64) v1 = -3e38f; }
        }
        __syncthreads();
        float f[16]; for (int m = 0; m < 16; ++m) f[m] = 0.f;
        for (int h = 0; h < 8; ++h) {
            float cv[4]; for (int r = 0; r < 4; ++r) { const int c = lane * 4 + r; cv[r] = sv[2 * h][c >> 4] + sv[2 * h + 1][c & 15]; }
            float fv[16]; int fe[16];
            for (int it = 0; it < 16; ++it) { float v = cv[0]; int i = lane * 4; for (int r = 1; r < 4; ++r) if (cv[r] > v) { v = cv[r]; i = lane * 4 + r; } wave_argmax(v, i); fv[it] = v; fe[it] = si[2 * h][i >> 4] * 128 + si[2 * h + 1][i & 15]; if ((i >> 2) == lane) cv[i & 3] = -3e38f; }
            float den = 0.f; for (int it = 0; it < 16; ++it) den += expf(fv[it] - fv[0]);
            const float* sd = FDBG + (size_t)2048 * DM + (size_t)row * 384;
            if (h == 0 && lane == 0) { sh[4000] = 0.f; sh[4001] = 0.f; }
            for (int it = 0; it < 16; ++it) { const int e = fe[it]; float s = 0.f; for (int k = lane; k < 1024; k += 64) s += a.in[11][(size_t)e * DM + k] * bf2f(h2[k]);
                s = wave_sum(s); const float wgt = 0.5f * s * (1.f + erff(s * 0.70710678f)) * expf(fv[it] - fv[0]) / den;
                if (lane == 0) { float best = 1e9f, bw = 1e9f; for (int q = 0; q < 16; ++q) if ((int)sd[h * 16 + q] == e) { best = fabsf(sd[128 + h * 16 + q] - expf(fv[it] - fv[0]) / den); bw = fabsf(sd[256 + h * 16 + q] - wgt) / fmaxf(fabsf(wgt), 1e-3f); }
                    sh[4000] = fmaxf(sh[4000], best); sh[4001] = fmaxf(sh[4001], bw); }
                for (int m = 0; m < 16; ++m) f[m] += wgt * a.in[12][(size_t)e * DM + lane + 64 * m]; }
        }
        float md = 0.f, mr = 0.f; for (int m = 0; m < 16; ++m) { md = fmaxf(md, fabsf(f[m] - FDBG[(size_t)row * DM + lane + 64 * m])); mr = fmaxf(mr, fabsf(f[m])); }
        const float e9 = wave_max(md) / wave_max(mr);
        if (lane == 0) { DBG[9 * 64 + b] = e9; DBG[7 * 64 + b] = sh[4000]; DBG[8 * 64 + b] = sh[4001]; }
        return;
    }
    err = wave_max(err);
    if (lane == 0) DBG[check * 64 + b] = err;
}
__global__ void __launch_bounds__(256) dbg_report(Args a, unsigned mask) {
    const size_t n = (size_t)NLAT * DM; float* out = a.out;
    for (size_t i = (size_t)blockIdx.x * 256 + threadIdx.x; i < n; i += (size_t)gridDim.x * 256) out[i] = 0.f;
    if (blockIdx.x == 0 && threadIdx.x == 0) {
        const float* DBG = (const float*)(a.ws + WS_DBG); int id = 0; float e = 0.f, eall = 0.f;
        for (int c = 1; c < 32 && id == 0; ++c) if (mask >> c & 1) { float m = 0.f; for (int b = 0; b < 64; ++b) { const float v = DBG[c * 64 + b]; m = (v == v) ? fmaxf(m, v) : 1e9f; } eall = fmaxf(eall, m); if (m > 0.03f) { id = c; e = m; } }
        if (id == 0) e = eall;
        float mm = 1.f + 2.2f * (log10f(fmaxf(e, 1e-4f)) + 4.f); mm = fminf(fmaxf(mm, 1.f), 9.8f);
        out[0] = mm * powf(10.f, 3.f + (float)id);
    }
}
#endif

#if defined(DEBUG_TIME)
__global__ void __launch_bounds__(256) time_report(Args a, unsigned maskA, unsigned maskB) {
    const unsigned long long* TS = (const unsigned long long*)(a.ws + 980 * MiB);
    float ta = 0.f, tb = 0.f;
    for (int k = 0; k < 16; ++k) { const float d = (float)(TS[k + 1] - TS[k]) * 0.01f; if (maskA >> k & 1) ta += d; if (maskB >> k & 1) tb += d; }
    const size_t n = (size_t)NLAT * DM, K = (size_t)(tb * 1000.f); float* out = a.out;
    for (size_t i = (size_t)blockIdx.x * 256 + threadIdx.x; i < n; i += (size_t)gridDim.x * 256) out[i] = i < K ? ta : 0.f;
}
#endif
extern "C" void kernel_launch(void* const* d_in, const int* in_sizes, int n_in, void* d_out, int out_size, void* d_ws, size_t ws_size, hipStream_t stream) {
    static int grid = 0;
    if (grid == 0) {
        if (n_in != 24 || out_size != NLAT * DM || ws_size < WS_END) { fprintf(stderr, "kernel_launch: unexpected shapes (n_in %d, out %d, ws %zu)\n", n_in, out_size, ws_size); grid = -1; return; }
        int dev = 0, cus = 0, per_cu = 0;
        if (hipGetDevice(&dev) != hipSuccess || hipDeviceGetAttribute(&cus, hipDeviceAttributeMultiprocessorCount, dev) != hipSuccess) { grid = -1; return; }
        if (hipFuncSetAttribute((const void*)fwd, hipFuncAttributeMaxDynamicSharedMemorySize, LDS_BYTES) != hipSuccess) { fprintf(stderr, "kernel_launch: hipFuncSetAttribute failed\n"); grid = -1; return; }
        if (hipOccupancyMaxActiveBlocksPerMultiprocessor(&per_cu, (const void*)fwd, NTHREADS, LDS_BYTES) != hipSuccess || per_cu < 1) { fprintf(stderr, "kernel_launch: occupancy query says %d blocks per CU\n", per_cu); }
        (void)hipGetLastError();
        grid = cus;
    }
    if (grid < 0) return;
    (void)hipMemsetAsync((char*)d_ws + WS_CTL, 0, CTL_ZERO_BYTES, stream);
    Args a{};
    for (int i = 0; i < 24; ++i) a.in[i] = (const float*)d_in[i];
    a.out = (float*)d_out; a.ws = (unsigned char*)d_ws;
#if ONE_LAUNCH
    a.ph_lo = 0; a.ph_hi = 24;
    hipLaunchKernelGGL(fwd, dim3(grid), dim3(NTHREADS), LDS_BYTES, stream, a);
#if defined(DEBUG_TIME)
    hipLaunchKernelGGL(time_report, dim3(2048), dim3(256), 0, stream, a, (unsigned)(TIME_MASK_A), (unsigned)(TIME_MASK_B));
#endif
#else
    for (int p = 0; p <= STOP_AFTER; ++p) for (int rep = 0; rep <= (((REPEAT_MASK) >> p) & 1); ++rep) { a.ph_lo = p; a.ph_hi = p + 1;
#if defined(ATT_PROBE)
        if (rep == 0 && p == 15 && (((REPEAT_MASK) >> p) & 1)) a.ph_hi |= (ATT_PROBE) << 8;
#endif
        hipLaunchKernelGGL(fwd, dim3(grid), dim3(NTHREADS), LDS_BYTES, stream, a); }
#if defined(DEBUG_CHECK)
    for (int c = 1; c < 32; ++c) if ((unsigned)(DEBUG_CHECK) >> c & 1) hipLaunchKernelGGL(dbg_check, dim3(64), dim3(64), 0, stream, a, c);
    hipLaunchKernelGGL(dbg_report, dim3(2048), dim3(256), 0, stream, a, (unsigned)(DEBUG_CHECK));
#elif STOP_AFTER < 23
    a.ph_lo = 24; a.ph_hi = 25; hipLaunchKernelGGL(fwd, dim3(grid), dim3(NTHREADS), LDS_BYTES, stream, a);
#endif
#endif
}
```
